# Optimizing an MI355X kernel written in HIP

```python
import math
import jax
import jax.numpy as jnp
from jax import lax
import numpy as np

D_MODEL = 2048
BATCH = 4
SEQ = 4096
DEPTH = 4

MIX_WIDTH = D_MODEL // 2
POOL_WINDOWS = (2, 4, 8, 16)
POOL_GROUPS = len(POOL_WINDOWS)
POOL_GROUP_DIM = MIX_WIDTH // POOL_GROUPS
DIFF_HEADS = 8
DIFF_QK_DIM = MIX_WIDTH // (2 * DIFF_HEADS)
DIFF_V_DIM = MIX_WIDTH // DIFF_HEADS
Q_BLOCK = 128
RET_HEADS = 8
RET_K_DIM = MIX_WIDTH // RET_HEADS
RET_V_DIM = MIX_WIDTH // RET_HEADS
RET_CHUNK = 128
ROPE_BASE = 10000.0
N_BRANCHES = 3
D_FF = 4 * D_MODEL
REL_BUCKETS = 32
REL_MAX_DIST = 128
NORM_EPS = 1e-6
NEG_INF = -1e30
IN_SPLITS = (MIX_WIDTH,) * 8 + (N_BRANCHES * D_MODEL,)
IN_COLS = sum(IN_SPLITS)

kernel_name = 'hybrid_gated_pool_diffattn_retention_block'


def rmsnorm(x, gain=None):
    xf = x.astype(jnp.float32)
    y = xf * lax.rsqrt(jnp.mean(xf * xf, axis=-1, keepdims=True) + NORM_EPS)
    if gain is not None:
        y = y * gain.astype(jnp.float32)
    return y.astype(x.dtype)


def t5_causal_bucket(q_pos, k_pos):
    n = jnp.maximum(q_pos[:, None] - k_pos[None, :], 0)
    exact = REL_BUCKETS // 2
    nf = jnp.maximum(n, 1).astype(jnp.float32)
    large = exact + (jnp.log(nf / exact) / math.log(REL_MAX_DIST / exact)
                     * (REL_BUCKETS - exact)).astype(jnp.int32)
    large = jnp.minimum(large, REL_BUCKETS - 1)
    return jnp.where(n < exact, n, large)


def rotary(t):
    S, half = t.shape[1], t.shape[-1] // 2
    inv_freq = 1.0 / (ROPE_BASE ** jnp.linspace(0.0, 1.0, half, dtype=jnp.float32))
    ang = jnp.arange(S, dtype=jnp.float32)[:, None] * inv_freq[None, :]
    cos = jnp.cos(ang)[None, :, None, :]
    sin = jnp.sin(ang)[None, :, None, :]
    t1, t2 = t[..., :half], t[..., half:]
    return jnp.concatenate([t1 * cos - t2 * sin, t2 * cos + t1 * sin], axis=-1)


def pool_mixer(u, pool_w, pool_scale):
    B, S, _ = u.shape
    uf = u.astype(jnp.float32).reshape(B, S, POOL_GROUPS, POOL_GROUP_DIM)
    cs = jnp.pad(jnp.cumsum(uf, axis=1), ((0, 0), (1, 0), (0, 0), (0, 0)))
    t = jnp.arange(S)
    win = jnp.array(POOL_WINDOWS, jnp.int32)
    lo = jnp.maximum(t[:, None] + 1 - win[None, :], 0)
    g_idx = jnp.arange(POOL_GROUPS)[None, :]
    lower = cs[:, lo, g_idx, :]
    count = (t[:, None] + 1 - lo).astype(jnp.float32)
    delta = (cs[:, 1:] - lower) / count[None, :, :, None] - uf
    y = jnp.einsum('bsgc,gcd->bsgd', delta.astype(u.dtype), pool_w)
    return y.reshape(B, S, MIX_WIDTH) * pool_scale


def diff_attention(q, k, v, lam_params, head_gain, rel_bias, lambda_init):
    B, S, _ = q.shape
    nb = S // Q_BLOCK
    q = q.reshape(B, S, DIFF_HEADS, 2, DIFF_QK_DIM).transpose(0, 2, 3, 1, 4)
    k = k.reshape(B, S, DIFF_HEADS, 2, DIFF_QK_DIM).transpose(0, 2, 3, 1, 4)
    v = v.reshape(B, S, DIFF_HEADS, DIFF_V_DIM).transpose(0, 2, 1, 3)
    lp = lam_params.astype(jnp.float32)
    lam = jnp.exp(jnp.sum(lp[0] * lp[1])) - jnp.exp(jnp.sum(lp[2] * lp[3])) + lambda_init
    scale = DIFF_QK_DIM ** -0.5
    k_pos = jnp.arange(S)
    bias_table = rel_bias.astype(jnp.float32)
    q_blocks = q.reshape(B, DIFF_HEADS, 2, nb, Q_BLOCK, DIFF_QK_DIM).transpose(3, 0, 1, 2, 4, 5)

    def block(args):
        qb, blk = args
        q_pos = blk * Q_BLOCK + jnp.arange(Q_BLOCK)
        bias = bias_table[t5_causal_bucket(q_pos, k_pos)].transpose(2, 0, 1)
        logits = jnp.einsum('bhmqd,bhmkd->bhmqk', qb, k).astype(jnp.float32) * scale
        logits = logits + bias[None, :, None]
        causal = k_pos[None, :] <= q_pos[:, None]
        p = jax.nn.softmax(jnp.where(causal, logits, NEG_INF), axis=-1)
        attn = p[:, :, 0] - lam * p[:, :, 1]
        return jnp.einsum('bhqk,bhkd->bhqd', attn.astype(v.dtype), v)

    out = lax.map(block, (q_blocks, jnp.arange(nb)))
    out = out.transpose(1, 2, 0, 3, 4).reshape(B, DIFF_HEADS, S, DIFF_V_DIM)
    out = rmsnorm(out, head_gain) * (1.0 - lambda_init)
    return out.transpose(0, 2, 1, 3).reshape(B, S, MIX_WIDTH)


def retention(q, k, v, g):
    B, S, _ = q.shape
    nc = S // RET_CHUNK
    f32 = jnp.float32
    qh = rotary(q.astype(f32).reshape(B, S, RET_HEADS, RET_K_DIM))
    kh = rotary(k.astype(f32).reshape(B, S, RET_HEADS, RET_K_DIM)) * RET_K_DIM ** -0.5
    vh = v.astype(f32).reshape(B, S, RET_HEADS, RET_V_DIM)

    def chunks(t):
        return t.reshape(B, nc, RET_CHUNK, RET_HEADS, t.shape[-1]).transpose(1, 0, 3, 2, 4)

    log_gamma = jnp.log(1.0 - 2.0 ** (-5.0 - jnp.arange(RET_HEADS, dtype=f32)))
    pos = jnp.arange(RET_CHUNK, dtype=f32)
    rel = pos[:, None] - pos[None, :]
    intra = jnp.where(rel >= 0, jnp.exp(jnp.maximum(rel, 0.0) * log_gamma[:, None, None]), 0.0)
    key_decay = jnp.exp((RET_CHUNK - 1 - pos)[None, :] * log_gamma[:, None])
    query_decay = jnp.exp((pos + 1)[None, :] * log_gamma[:, None])
    chunk_decay = jnp.exp(RET_CHUNK * log_gamma)

    def step(state, qkv):
        qc, kc, vc = qkv
        scores = jnp.einsum('bhid,bhjd->bhij', qc, kc) * intra
        inner = jnp.einsum('bhij,bhje->bhie', scores, vc)
        cross = jnp.einsum('bhid,bhde->bhie', qc, state) * query_decay[..., None]
        state = chunk_decay[:, None, None] * state + jnp.einsum(
            'bhjd,bhje->bhde', kc * key_decay[..., None], vc)
        return state, inner + cross

    state0 = jnp.zeros((B, RET_HEADS, RET_K_DIM, RET_V_DIM), f32)
    _, out = lax.scan(step, state0, (chunks(qh), chunks(kh), chunks(vh)))
    out = out.transpose(1, 0, 3, 2, 4).reshape(B, S, RET_HEADS, RET_V_DIM)
    out = rmsnorm(out).reshape(B, S, MIX_WIDTH)
    return (jax.nn.silu(g.astype(f32)) * out).astype(g.dtype)


def setup_inputs(seed: int = 0) -> dict:
    key = jax.random.key(seed)
    ks = jax.random.split(key, 15)
    f32 = jnp.float32

    def normal(k, shape, scale):
        return jax.random.normal(k, shape, f32) * scale

    def gain(k, shape):
        return 1.0 + 0.02 * jax.random.normal(k, shape, f32)

    return {
        'x': normal(ks[0], (BATCH, SEQ, D_MODEL), 1.0),
        'rel_bias': normal(ks[1], (REL_BUCKETS, DIFF_HEADS), 0.5),
        'norm_pre_mix': gain(ks[2], (DEPTH, D_MODEL)),
        'norm_post_mix': gain(ks[3], (DEPTH, D_MODEL)),
        'norm_pre_mlp': gain(ks[4], (DEPTH, D_MODEL)),
        'norm_post_mlp': gain(ks[5], (DEPTH, D_MODEL)),
        'w_in': normal(ks[6], (DEPTH, D_MODEL, IN_COLS), D_MODEL ** -0.5),
        'pool_w': normal(ks[7], (DEPTH, POOL_GROUPS, POOL_GROUP_DIM, POOL_GROUP_DIM), POOL_GROUP_DIM ** -0.5),
        'pool_scale': gain(ks[8], (DEPTH, MIX_WIDTH)),
        'diff_lambda': normal(ks[9], (DEPTH, 4, DIFF_QK_DIM), 0.1),
        'diff_head_norm': gain(ks[10], (DEPTH, DIFF_V_DIM)),
        'w_branch': normal(ks[11], (DEPTH, N_BRANCHES, MIX_WIDTH, D_MODEL), MIX_WIDTH ** -0.5),
        'w_out': normal(ks[12], (DEPTH, D_MODEL, D_MODEL), D_MODEL ** -0.5),
        'w_up': normal(ks[13], (DEPTH, D_MODEL, D_FF), D_MODEL ** -0.5),
        'w_down': normal(ks[14], (DEPTH, D_FF, D_MODEL), D_FF ** -0.5),
    }


def reference(x, rel_bias, norm_pre_mix, norm_post_mix, norm_pre_mlp, norm_post_mlp,
              w_in, pool_w, pool_scale, diff_lambda, diff_head_norm, w_branch, w_out,
              w_up, w_down):
    B, S, _ = x.shape
    split_at = [int(i) for i in np.cumsum(IN_SPLITS)[:-1]]
    for l in range(DEPTH):
        lambda_init = 0.8 - 0.6 * math.exp(-0.3 * l)
        a = rmsnorm(x, norm_pre_mix[l])
        proj = jnp.einsum('bsd,dc->bsc', a, w_in[l])
        u_pool, q_d, k_d, v_d, q_r, k_r, v_r, g_r, gate_logits = jnp.split(proj, split_at, axis=-1)
        y_pool = pool_mixer(u_pool, pool_w[l], pool_scale[l])
        y_diff = diff_attention(q_d, k_d, v_d, diff_lambda[l], diff_head_norm[l], rel_bias, lambda_init)
        y_ret = retention(q_r, k_r, v_r, g_r)
        branches = jnp.stack([y_pool, y_diff, y_ret], axis=2)
        widened = jnp.einsum('bsnc,ncd->bsnd', branches, w_branch[l])
        gates = jax.nn.sigmoid(gate_logits.reshape(B, S, N_BRANCHES, D_MODEL))
        merged = jnp.sum(gates * widened, axis=2)
        mix = jnp.einsum('bsd,de->bse', merged, w_out[l])
        x = x + rmsnorm(mix, norm_post_mix[l])
        h = rmsnorm(x, norm_pre_mlp[l])
        ff = jnp.square(jax.nn.relu(jnp.einsum('bsd,df->bsf', h, w_up[l])))
        ff = jnp.einsum('bsf,fd->bsd', ff, w_down[l])
        x = x + rmsnorm(ff, norm_post_mlp[l])
    return x
```

```cpp
#include <hip/hip_runtime.h>
#include <cstdio>
#include <cstdint>
namespace pg8 {
#define PG8_LAS __attribute__((address_space(3)))
typedef unsigned short bf16_t;
typedef short bf16x8 __attribute__((ext_vector_type(8)));
typedef float f32x4 __attribute__((ext_vector_type(4)));
typedef unsigned u32x4 __attribute__((ext_vector_type(4)));
constexpr int BM = 256, BK = 64, HALF = 128, HTB = HALF * BK * 2  , STAGE_BYTES = 8 * HTB, NXCD = 8, WGM = 8;

__host__ __device__ __forceinline__ int lds_byte(int r, int c) { const int st = (r >> 4) * 2 + (c >> 5), rr = r & 15, cc = c & 31, ob = rr * 64 + cc * 2; return st * 1024 + (ob ^ (((ob >> 9) & 1) << 5)); }
__host__ __device__ __forceinline__ void stage_rc(int b, int& R, int& C) { const int st = b / 1024, sb = b % 1024, swz = sb ^ (((sb >> 9) & 1) << 5); R = (st >> 1) * 16 + swz / 64; C = (st & 1) * 32 + (swz % 64) / 2; }
__host__ __device__ __forceinline__ int perm32(int rho) { const int n = rho >> 4, i = rho & 15; return 8 * (i >> 2) + 4 * n + (i & 3); }

struct Unit { int pm, pn; };
struct Gemm { const bf16_t* A; const bf16_t* Bt; int M, N, K; };

struct StaticOrder {
    int nM, nN, nwg, G, c;
    __host__ __device__ void init(int M, int N, int G_, int c_) { nM = M / BM; nN = N / BM; nwg = nM * nN; G = G_; c = c_; }
    __host__ __device__ bool next(int i, Unit& u) const {
        const long L = (long)i * G + c; if (L >= nwg) return false;
        int wgid = (int)L; { const int q = nwg / NXCD, r = nwg % NXCD, xcd = wgid % NXCD, off = wgid / NXCD; wgid = (xcd < r ? xcd * (q + 1) : r * (q + 1) + (xcd - r) * q) + off; }
        const int nig = WGM * nN, gid = wgid / nig, fm = gid * WGM, gsz = (nM - fm) < WGM ? (nM - fm) : WGM;
        u.pm = fm + ((wgid % nig) % gsz); u.pn = (wgid % nig) / gsz; return true;
    }
    __device__ __forceinline__ void a_ready(const Unit&) const {}
    __device__ __forceinline__ void done(const Unit&) const {}
};

typedef float f32x2c __attribute__((ext_vector_type(2))); typedef __bf16 bf16x2c __attribute__((ext_vector_type(2)));
__device__ __forceinline__ unsigned cvt_pk_bf16(float lo, float hi) { f32x2c v = {lo, hi}; bf16x2c b = __builtin_convertvector(v, bf16x2c); return __builtin_bit_cast(unsigned, b); }
typedef float f32x2 __attribute__((ext_vector_type(2)));

template <class Epi, class Sched, bool ALIGN_EPI = false, bool SP2 = false>
__device__ __forceinline__ void gemm_phase(PG8_LAS unsigned char* lds, const Gemm g, const Sched& S, const Epi& E) {
    int tid_ = threadIdx.x; asm volatile("" : "+v"(tid_));
    const int tid = tid_, wid = __builtin_amdgcn_readfirstlane(tid >> 6), lane = tid & 63, wr = wid >> 2, wc = wid & 3, fr = lane & 15, fq = lane >> 4;
    const int K = g.K, nt = K / BK;
    unsigned voffA[2], voffB[2];
#pragma unroll
    for (int i = 0; i < 2; ++i) { int R, C; stage_rc(tid * 16 + i * 8192, R, C); const int Rb = Epi::PERM ? ((R & ~31) + perm32(R & 31)) : R;
        voffA[i] = (unsigned)(R * K + C) * 2u; voffB[i] = (unsigned)(Rb * K + C) * 2u; }
    const size_t kstep = (size_t)(BK * 2);
    const size_t hstep = (size_t)HALF * K * 2;
    const size_t tstep = 2 * hstep;
    const unsigned ldsw = (unsigned)wid * 1024u;
    const int aoff = lds_byte(wr * 64 + fr, fq * 8), boff = lds_byte(wc * 32 + fr, fq * 8);
#define PG8_SA(b, h) (((b) * 2 + (h)) * HTB)
#define PG8_SB(b, h) ((4 + (b) * 2 + (h)) * HTB)
#define PG8_STAGE(bufoff, gbase, voff) do { _Pragma("unroll") for (int _i = 0; _i < 2; ++_i) \
        __builtin_amdgcn_global_load_lds((const unsigned*)((const char*)(gbase) + (voff)[_i]), (PG8_LAS unsigned*)(lds + (bufoff) + ldsw + _i * 8192), 16, 0, 0); } while (0)
#define PG8_LDA(dst, b, h) do { _Pragma("unroll") for (int m = 0; m < 4; ++m) _Pragma("unroll") for (int k = 0; k < 2; ++k) dst[m][k] = *(const PG8_LAS bf16x8*)(lds + PG8_SA(b, h) + aoff + m * 2048 + k * 1024); } while (0)
#define PG8_LDB(dst, b, h) do { _Pragma("unroll") for (int n = 0; n < 2; ++n) _Pragma("unroll") for (int k = 0; k < 2; ++k) dst[n][k] = *(const PG8_LAS bf16x8*)(lds + PG8_SB(b, h) + boff + n * 2048 + k * 1024); } while (0)
#define PG8_MMA(ai, bj, At, Bt) do { __builtin_amdgcn_s_setprio(1); _Pragma("unroll") for (int m = 0; m < 4; ++m) _Pragma("unroll") for (int n = 0; n < 2; ++n) _Pragma("unroll") for (int k = 0; k < 2; ++k) \
        acc[ai][bj][m][n] = __builtin_amdgcn_mfma_f32_16x16x32_bf16(Bt[n][k], At[m][k], acc[ai][bj][m][n], 0, 0, 0); __builtin_amdgcn_s_setprio(0); } while (0)
#define PG8_WAIT_V(n) asm volatile("s_waitcnt vmcnt(" #n ")" ::: "memory")
#define PG8_WAIT_L(n) asm volatile("s_waitcnt lgkmcnt(" #n ")" ::: "memory")
#define PG8_BAR __builtin_amdgcn_s_barrier()
#define PG8_SCHED __builtin_amdgcn_sched_barrier(0)
    Unit cur, nxt; int ui = 0;
    if (!S.next(0, cur)) return;
    f32x4 acc[2][2][4][2];
#pragma unroll
    for (int a = 0; a < 2; ++a)
#pragma unroll
        for (int b = 0; b < 2; ++b)
#pragma unroll
            for (int m = 0; m < 4; ++m)
#pragma unroll
                for (int n = 0; n < 2; ++n) acc[a][b][m][n] = (f32x4){0.f, 0.f, 0.f, 0.f};
    bf16x8 At[4][2], B0[2][2], B1[2][2];
    const char* cA = (const char*)g.A + (size_t)cur.pm * tstep; const char* cB = (const char*)g.Bt + (size_t)cur.pn * tstep;
    S.a_ready(cur);
    if constexpr (SP2) {
        PG8_STAGE(PG8_SB(0, 0), cB, voffB); PG8_STAGE(PG8_SB(0, 1), cB + hstep, voffB); PG8_STAGE(PG8_SA(0, 0), cA, voffA); PG8_STAGE(PG8_SA(0, 1), cA + hstep, voffA);
        if (wr == 1) PG8_BAR;
        PG8_WAIT_V(2); PG8_BAR;
        PG8_STAGE(PG8_SB(1, 0), cB + kstep, voffB); PG8_STAGE(PG8_SA(1, 0), cA + kstep, voffA); PG8_STAGE(PG8_SB(1, 1), cB + hstep + kstep, voffB);
        PG8_WAIT_V(6); PG8_BAR;
    } else {
        PG8_STAGE(PG8_SB(0, 0), cB, voffB); PG8_STAGE(PG8_SA(0, 0), cA, voffA); PG8_STAGE(PG8_SB(0, 1), cB + hstep, voffB); PG8_STAGE(PG8_SA(0, 1), cA + hstep, voffA);
        if (wr == 1) PG8_BAR;
        PG8_WAIT_V(4); PG8_BAR;
        PG8_STAGE(PG8_SB(1, 0), cB + kstep, voffB); PG8_STAGE(PG8_SA(1, 0), cA + kstep, voffA); PG8_STAGE(PG8_SB(1, 1), cB + hstep + kstep, voffB);
        PG8_WAIT_V(6); PG8_BAR;
    }
    for (;;) {
        const bool has_next = S.next(ui + 1, nxt);
        const char* nA = has_next ? (const char*)g.A + (size_t)nxt.pm * tstep : cA; const char* nB = has_next ? (const char*)g.Bt + (size_t)nxt.pn * tstep : cB;
        for (int t = 0; t < nt; t += 2) {
            if constexpr (Epi::MID) { if (t == Epi::MID_T0 || t == Epi::MID_T1) E.mid(acc, cur, t, wr, wc, fr, fq); }
            const bool last = (t == nt - 2);
            const char* a1 = cA + (size_t)(t + 1) * kstep;
            const char* a2 = last ? nA : cA + (size_t)(t + 2) * kstep; const char* b2 = last ? nB : cB + (size_t)(t + 2) * kstep;
            const char* a3 = a2 + kstep; const char* b3 = b2 + kstep;
            if (last && has_next) S.a_ready(nxt);
            if constexpr (SP2) {
            PG8_LDB(B0, 0, 0); PG8_LDB(B1, 0, 1); PG8_SCHED; PG8_LDA(At, 0, 0); PG8_STAGE(PG8_SA(1, 1), a1 + hstep, voffA);
            PG8_WAIT_V(8); PG8_WAIT_L(0); PG8_BAR; PG8_MMA(0, 0, At, B0); PG8_MMA(0, 1, At, B1); PG8_BAR; PG8_SCHED;
            PG8_LDA(At, 0, 1); PG8_STAGE(PG8_SB(0, 0), b2, voffB); PG8_STAGE(PG8_SB(0, 1), b2 + hstep, voffB); PG8_STAGE(PG8_SA(0, 0), a2, voffA);
            PG8_WAIT_V(8); PG8_WAIT_L(0); PG8_BAR; PG8_MMA(1, 0, At, B0); PG8_MMA(1, 1, At, B1); PG8_BAR; PG8_SCHED;
            PG8_LDB(B0, 1, 0); PG8_LDB(B1, 1, 1); PG8_SCHED; PG8_LDA(At, 1, 0); PG8_STAGE(PG8_SA(0, 1), a2 + hstep, voffA);
            PG8_WAIT_V(8); PG8_WAIT_L(0); PG8_BAR; PG8_MMA(0, 0, At, B0); PG8_MMA(0, 1, At, B1); PG8_BAR; PG8_SCHED;
            PG8_LDA(At, 1, 1); PG8_STAGE(PG8_SB(1, 0), b3, voffB); PG8_STAGE(PG8_SB(1, 1), b3 + hstep, voffB); PG8_STAGE(PG8_SA(1, 0), a3, voffA);
            PG8_WAIT_V(8); PG8_WAIT_L(0); PG8_BAR; PG8_MMA(1, 0, At, B0); PG8_MMA(1, 1, At, B1); PG8_BAR; PG8_SCHED;
            } else {
            PG8_LDB(B0, 0, 0); PG8_SCHED; PG8_LDA(At, 0, 0); PG8_STAGE(PG8_SA(1, 1), a1 + hstep, voffA);
            PG8_WAIT_L(8); PG8_BAR; PG8_WAIT_L(0); PG8_MMA(0, 0, At, B0); PG8_BAR; PG8_SCHED;
            PG8_LDB(B1, 0, 1); PG8_STAGE(PG8_SB(0, 0), b2, voffB);
            PG8_BAR; PG8_WAIT_L(0); PG8_MMA(0, 1, At, B1); PG8_BAR;
            PG8_LDA(At, 0, 1); PG8_STAGE(PG8_SA(0, 0), a2, voffA);
            PG8_BAR; PG8_WAIT_L(0); PG8_MMA(1, 0, At, B0); PG8_BAR; PG8_SCHED;
            PG8_STAGE(PG8_SB(0, 1), b2 + hstep, voffB);
            PG8_WAIT_V(6); PG8_BAR; PG8_MMA(1, 1, At, B1); PG8_BAR;
            PG8_LDB(B0, 1, 0); PG8_SCHED; PG8_LDA(At, 1, 0); PG8_STAGE(PG8_SA(0, 1), a2 + hstep, voffA);
            PG8_WAIT_L(8); PG8_BAR; PG8_WAIT_L(0); PG8_MMA(0, 0, At, B0); PG8_BAR; PG8_SCHED;
            PG8_LDB(B1, 1, 1); PG8_STAGE(PG8_SB(1, 0), b3, voffB);
            PG8_BAR; PG8_WAIT_L(0); PG8_MMA(0, 1, At, B1); PG8_BAR;
            PG8_LDA(At, 1, 1); PG8_STAGE(PG8_SA(1, 0), a3, voffA);
            PG8_BAR; PG8_WAIT_L(0); PG8_MMA(1, 0, At, B0); PG8_BAR; PG8_SCHED;
            PG8_STAGE(PG8_SB(1, 1), b3 + hstep, voffB);
            PG8_WAIT_V(6); PG8_BAR; PG8_MMA(1, 1, At, B1); PG8_BAR;
            }
        }
        if constexpr (ALIGN_EPI) { if (wr == 0) PG8_BAR; }
        if constexpr (!Epi::AFTER_DRAIN) { E(acc, cur, wr, wc, fr, fq); S.done(cur); }
        if (!has_next) break;
#pragma unroll
        for (int a = 0; a < 2; ++a)
#pragma unroll
            for (int b = 0; b < 2; ++b)
#pragma unroll
                for (int m = 0; m < 4; ++m)
#pragma unroll
                    for (int n = 0; n < 2; ++n) acc[a][b][m][n] = (f32x4){0.f, 0.f, 0.f, 0.f};
        cur = nxt; cA = nA; cB = nB; ++ui;
        if constexpr (ALIGN_EPI) { if (wr == 1) PG8_BAR; }
    }
    PG8_WAIT_V(0);
    if constexpr (!ALIGN_EPI) { if (wr == 0) PG8_BAR; }
    PG8_BAR;
    if constexpr (Epi::AFTER_DRAIN) { E.fused(acc, cur, wr, wc, fr, fq, lds, wid, lane); S.done(cur); }
#undef PG8_SA
#undef PG8_SB
#undef PG8_STAGE
#undef PG8_LDA
#undef PG8_LDB
#undef PG8_MMA
#undef PG8_WAIT_V
#undef PG8_WAIT_L
#undef PG8_BAR
#undef PG8_SCHED
}
}
namespace pg8 {
__device__ __forceinline__ float sigm(float v) { return __builtin_amdgcn_rcpf(1.0f + __builtin_amdgcn_exp2f(-1.4426950408889634f * v)); }
struct EpiProj {
    static constexpr bool PERM = true, AFTER_DRAIN = false, MID = false; static constexpr int MID_T0 = -1, MID_T1 = -1;
    bf16_t* O; int ldc; float qscale; const float* rs;
    __device__ __forceinline__ void operator()(const f32x4 (&acc)[2][2][4][2], const Unit& u, int wr, int wc, int fr, int fq) const {
        const int row0 = u.pm * BM + wr * 64 + fr, col0 = u.pn * BM + wc * 32 + 8 * fq;
        const int mode = (u.pn >= 32) ? 3 : (u.pn >= 28 ? 2 : ((u.pn >= 4 && u.pn < 8) ? 1 : 0));
        const float sc = mode == 1 ? qscale : 1.f;
#pragma unroll
        for (int ai = 0; ai < 2; ++ai)
#pragma unroll
            for (int m = 0; m < 4; ++m) { bf16_t* rowp = O + (size_t)(row0 + ai * HALF + m * 16) * ldc + col0; const float rr = rs[row0 + ai * HALF + m * 16];
#pragma unroll
                for (int bj = 0; bj < 2; ++bj) { f32x4 v0 = acc[ai][bj][m][0] * rr, v1 = acc[ai][bj][m][1] * rr;
                    if (mode >= 2) {
#pragma unroll
                        for (int j = 0; j < 4; ++j) { const float s0 = sigm(v0[j]), s1 = sigm(v1[j]); v0[j] = mode == 3 ? s0 : v0[j] * s0; v1[j] = mode == 3 ? s1 : v1[j] * s1; }
                    } else { v0 = v0 * sc; v1 = v1 * sc; }
                    u32x4 w; w.x = cvt_pk_bf16(v0[0], v0[1]); w.y = cvt_pk_bf16(v0[2], v0[3]); w.z = cvt_pk_bf16(v1[0], v1[1]); w.w = cvt_pk_bf16(v1[2], v1[3]);
                    *(u32x4*)(rowp + bj * HALF) = w; } }
    }
};
struct EpiRelu2 {
    static constexpr bool PERM = true, AFTER_DRAIN = false, MID = false; static constexpr int MID_T0 = -1, MID_T1 = -1;
    bf16_t* O; int ldc; const float* rs;
    __device__ __forceinline__ void operator()(const f32x4 (&acc)[2][2][4][2], const Unit& u, int wr, int wc, int fr, int fq) const {
        const int row0 = u.pm * BM + wr * 64 + fr, col0 = u.pn * BM + wc * 32 + 8 * fq;
#pragma unroll
        for (int ai = 0; ai < 2; ++ai)
#pragma unroll
            for (int m = 0; m < 4; ++m) { bf16_t* rowp = O + (size_t)(row0 + ai * HALF + m * 16) * ldc + col0; const float rr = rs[row0 + ai * HALF + m * 16];
#pragma unroll
                for (int bj = 0; bj < 2; ++bj) { f32x4 v0 = acc[ai][bj][m][0], v1 = acc[ai][bj][m][1];
#pragma unroll
                    for (int j = 0; j < 4; ++j) { const float a = __builtin_fmaxf(v0[j], 0.f) * rr, b = __builtin_fmaxf(v1[j], 0.f) * rr; v0[j] = a * a; v1[j] = b * b; }
                    u32x4 w; w.x = cvt_pk_bf16(v0[0], v0[1]); w.y = cvt_pk_bf16(v0[2], v0[3]); w.z = cvt_pk_bf16(v1[0], v1[1]); w.w = cvt_pk_bf16(v1[2], v1[3]);
                    *(u32x4*)(rowp + bj * HALF) = w; } }
    }
};
struct EpiSq {
    static constexpr bool PERM = true, AFTER_DRAIN = false, MID = false; static constexpr int MID_T0 = -1, MID_T1 = -1;
    bf16_t* O; int ldc; float* part;
    __device__ __forceinline__ void operator()(const f32x4 (&acc)[2][2][4][2], const Unit& u, int wr, int wc, int fr, int fq) const {
        const int row0 = u.pm * BM + wr * 64 + fr, col0 = u.pn * BM + wc * 32 + 8 * fq;
#pragma unroll
        for (int ai = 0; ai < 2; ++ai)
#pragma unroll
            for (int m = 0; m < 4; ++m) { const int row = row0 + ai * HALF + m * 16; bf16_t* rowp = O + (size_t)row * ldc + col0; float ss = 0.f;
#pragma unroll
                for (int bj = 0; bj < 2; ++bj) { const f32x4 v0 = acc[ai][bj][m][0], v1 = acc[ai][bj][m][1];
                    ss += (v0[0] * v0[0] + v0[1] * v0[1]) + (v0[2] * v0[2] + v0[3] * v0[3]) + (v1[0] * v1[0] + v1[1] * v1[1]) + (v1[2] * v1[2] + v1[3] * v1[3]);
                    u32x4 w; w.x = cvt_pk_bf16(v0[0], v0[1]); w.y = cvt_pk_bf16(v0[2], v0[3]); w.z = cvt_pk_bf16(v1[0], v1[1]); w.w = cvt_pk_bf16(v1[2], v1[3]);
                    *(u32x4*)(rowp + bj * HALF) = w; }
                ss += __shfl_xor(ss, 16); ss += __shfl_xor(ss, 32);
                if (fq == 0) part[(size_t)row * 32 + u.pn * 4 + wc] = ss; }
    }
};
struct EpiWiden {
    static constexpr bool PERM = true, AFTER_DRAIN = false, MID = true; static constexpr int MID_T0 = 16, MID_T1 = 32;
    bf16_t* O; int ldc; const bf16_t* G; int ldg;
    __device__ __forceinline__ void mid(f32x4 (&acc)[2][2][4][2], const Unit& u, int t, int wr, int wc, int fr, int fq) const {
        const int row0 = u.pm * BM + wr * 64 + fr, col0 = u.pn * BM + wc * 32 + 8 * fq;
        const bf16_t* gp = G + (t == MID_T0 ? 0 : 2048) + col0 + (size_t)row0 * ldg;
#pragma unroll
        for (int ai = 0; ai < 2; ++ai)
#pragma unroll
            for (int m = 0; m < 4; ++m) {
#pragma unroll
                for (int bj = 0; bj < 2; ++bj) { const bf16_t* p = gp + (size_t)(ai * HALF + m * 16) * ldg + bj * HALF; const u32x4 ga = *(const u32x4*)p, gb = *(const u32x4*)(p + 2048);
#pragma unroll
                    for (int k = 0; k < 4; ++k) { const float a0 = __builtin_bit_cast(float, ga[k] << 16), a1 = __builtin_bit_cast(float, ga[k] & 0xffff0000u);
                        const float b0 = __builtin_fmaxf(__builtin_bit_cast(float, gb[k] << 16), 1e-30f), b1 = __builtin_fmaxf(__builtin_bit_cast(float, gb[k] & 0xffff0000u), 1e-30f);
                        const float r0 = a0 * __builtin_amdgcn_rcpf(b0), r1 = a1 * __builtin_amdgcn_rcpf(b1);
                        acc[ai][bj][m][k >> 1][(k & 1) * 2] *= r0; acc[ai][bj][m][k >> 1][(k & 1) * 2 + 1] *= r1; }
                    asm volatile("" : "+v"(acc[ai][bj][m][0]), "+v"(acc[ai][bj][m][1]) :: "memory"); } }
    }
    __device__ __forceinline__ void operator()(const f32x4 (&acc)[2][2][4][2], const Unit& u, int wr, int wc, int fr, int fq) const {
        const int row0 = u.pm * BM + wr * 64 + fr, col0 = u.pn * BM + wc * 32 + 8 * fq;
        const bf16_t* Gc = G + 4096 + col0;
#pragma unroll
        for (int ai = 0; ai < 2; ++ai)
#pragma unroll
            for (int m = 0; m < 4; ++m) { const size_t ro = (size_t)(row0 + ai * HALF + m * 16) * ldg; bf16_t* rowp = O + (size_t)(row0 + ai * HALF + m * 16) * ldc + col0;
#pragma unroll
                for (int bj = 0; bj < 2; ++bj) { const u32x4 gc = *(const u32x4*)(Gc + ro + bj * HALF); f32x4 v0 = acc[ai][bj][m][0], v1 = acc[ai][bj][m][1];
                    v0[0] *= __builtin_bit_cast(float, gc[0] << 16); v0[1] *= __builtin_bit_cast(float, gc[0] & 0xffff0000u); v0[2] *= __builtin_bit_cast(float, gc[1] << 16); v0[3] *= __builtin_bit_cast(float, gc[1] & 0xffff0000u);
                    v1[0] *= __builtin_bit_cast(float, gc[2] << 16); v1[1] *= __builtin_bit_cast(float, gc[2] & 0xffff0000u); v1[2] *= __builtin_bit_cast(float, gc[3] << 16); v1[3] *= __builtin_bit_cast(float, gc[3] & 0xffff0000u);
                    u32x4 w; w.x = cvt_pk_bf16(v0[0], v0[1]); w.y = cvt_pk_bf16(v0[2], v0[3]); w.z = cvt_pk_bf16(v1[0], v1[1]); w.w = cvt_pk_bf16(v1[2], v1[3]);
                    *(u32x4*)(rowp + bj * HALF) = w; } }
    }
};
}
#define DUPMASK 0
#ifndef GEMM_ALIGN
#define GEMM_ALIGN true
#endif
#ifndef GEMM_SP2
#define GEMM_SP2 true
#endif
constexpr int NWAVES = 8;
constexpr bool SINGLE_LAUNCH = 1;
constexpr int BATCH = 4, SEQ = 4096, DM = 2048, DEPTH = 4, MIXW = 1024, M = BATCH * SEQ, INC = 14336, DFF = 8192;
constexpr int LDP = INC;
constexpr int C_POOL = 0, C_QD = 1024, C_KD = 2048, C_VD = 3072, C_QR = 4096, C_KR = 5120, C_VR = 6144, C_GR = 7168, C_GATE = 8192;
constexpr int LDY = 3072;
constexpr float NORM_EPS = 1e-6f;
constexpr float LOG2E = 1.4426950408889634f;
constexpr float QSCALE = 0.125f * 1.4426950408889634f;
constexpr float RET_KSCALE = 0.08838834764831845f;

constexpr size_t MiB = 1u << 20;
constexpr size_t WS_CTL = 0, CTL_ZERO_BYTES = 1 * MiB;
constexpr size_t WS_ROT = 1 * MiB;
constexpr size_t WS_STAT = 3 * MiB;
constexpr size_t WS_POOLT = 5 * MiB;
constexpr size_t WS_RS = 7 * MiB;
constexpr size_t WS_WIN = 8 * MiB;
constexpr size_t WS_WB = WS_WIN + 224 * MiB;
constexpr size_t WS_WO = WS_WB + 48 * MiB;
constexpr size_t WS_WUP = WS_WO + 32 * MiB;
constexpr size_t WS_WDN = WS_WUP + 128 * MiB;
constexpr size_t WS_XN = WS_WDN + 128 * MiB;
constexpr size_t WS_MRG = WS_XN + 64 * MiB;
constexpr size_t WS_MIX = WS_MRG + 64 * MiB;
constexpr size_t WS_Y = WS_MIX + 64 * MiB;
constexpr size_t WS_KV = WS_Y + 96 * MiB;
constexpr size_t WS_SST = WS_KV + 64 * MiB;
constexpr size_t WS_PROJ = WS_SST + 32 * MiB;
constexpr size_t WS_END = WS_PROJ + 448 * MiB;

constexpr int CW_BAR = 4096;

constexpr int RING_BYTES = 131072;
constexpr int LDSCTL_OFF = 135168, MISC_OFF = LDSCTL_OFF + 320;
constexpr int LDS_BYTES = 147456;

#define GAS __attribute__((address_space(1)))
#define LAS __attribute__((address_space(3)))
typedef unsigned short bf16;
typedef unsigned v4u __attribute__((ext_vector_type(4)));
typedef unsigned v2u __attribute__((ext_vector_type(2)));
typedef float f32x4 __attribute__((ext_vector_type(4)));
typedef float f32x2 __attribute__((ext_vector_type(2)));
typedef float f32x16 __attribute__((ext_vector_type(16)));
typedef short bf16x8 __attribute__((ext_vector_type(8)));
typedef short s16x4 __attribute__((ext_vector_type(4)));
typedef GAS unsigned gu32;
#define RLX_AGENT __ATOMIC_RELAXED, __HIP_MEMORY_SCOPE_AGENT
#define LDS_WAIT() asm volatile("s_waitcnt lgkmcnt(0)" ::: "memory")
#define VM_WAIT() asm volatile("s_waitcnt vmcnt(0)" ::: "memory")
#define WG_BAR() do { asm volatile("s_waitcnt vmcnt(0) lgkmcnt(0)" ::: "memory"); __builtin_amdgcn_s_barrier(); asm volatile("" ::: "memory"); } while (0)

typedef float f32x2_t_ __attribute__((ext_vector_type(2))); typedef __bf16 bf16x2_t_ __attribute__((ext_vector_type(2)));
__device__ __forceinline__ unsigned pk2(float lo, float hi) { f32x2_t_ v = {lo, hi}; bf16x2_t_ b = __builtin_convertvector(v, bf16x2_t_); return __builtin_bit_cast(unsigned, b); }
__device__ __forceinline__ float bflo(unsigned w) { return __builtin_bit_cast(float, w << 16); }
__device__ __forceinline__ float bfhi(unsigned w) { return __builtin_bit_cast(float, w & 0xffff0000u); }
__device__ __forceinline__ float wave_sum(float v) {
#pragma unroll
    for (int o = 1; o < 64; o <<= 1) v += __shfl_xor(v, o);
    return v;
}
__device__ __forceinline__ void half_swap(unsigned& a, unsigned& b) { asm volatile("s_nop 1\n\tv_permlane32_swap_b32 %0, %1\n\ts_nop 1" : "+v"(a), "+v"(b)); }
__device__ __forceinline__ float half_swap_max(float m) { unsigned a = __builtin_bit_cast(unsigned, m), b = a; half_swap(a, b); return __builtin_fmaxf(__builtin_bit_cast(float, a), __builtin_bit_cast(float, b)); }
__device__ __forceinline__ float half_swap_sum(float m) { unsigned a = __builtin_bit_cast(unsigned, m), b = a; half_swap(a, b); return __builtin_bit_cast(float, a) + __builtin_bit_cast(float, b); }
__device__ __forceinline__ int crow(int r, int hi) { return (r & 3) + 8 * (r >> 2) + 4 * hi; }
__device__ __forceinline__ int swap23(int i) { return (i & 0x13) | ((i & 4) << 1) | ((i & 8) >> 1); }
__device__ __forceinline__ unsigned offb(int row, int ch) { return 256u * (unsigned)row + 16u * (unsigned)(ch ^ (((row & 3) << 2) | ((row >> 2) & 3))); }
__device__ __forceinline__ unsigned tr_off(int lane, int c, int t) { const int h = lane >> 5, blk = (lane >> 4) & 1, q = (lane & 15) >> 2, p = lane & 3; return offb(8 * h + 4 * t + q, 4 * c + 2 * blk + (p >> 1)) + 8u * (unsigned)(p & 1); }
typedef short v4i16_t __attribute__((ext_vector_type(4)));
__device__ __forceinline__ s16x4 ldtr(LAS unsigned char* p) { return __builtin_bit_cast(s16x4, __builtin_amdgcn_ds_read_tr16_b64_v4i16((LAS v4i16_t*)p)); }
__device__ __forceinline__ bf16x8 trfrag(LAS unsigned char* tile, unsigned o0, unsigned o1) { const s16x4 a = ldtr(tile + o0), b = ldtr(tile + o1); return (bf16x8){a[0], a[1], a[2], a[3], b[0], b[1], b[2], b[3]}; }
__device__ __forceinline__ void glds16(const void* gsrc, LAS unsigned char* dst) { __builtin_amdgcn_global_load_lds((const unsigned*)gsrc, (LAS unsigned*)dst, 16, 0, 0); }
__device__ __forceinline__ void glds16_asm(const void* gsrc, LAS unsigned char* dst) { unsigned keep; const unsigned d = (unsigned)__builtin_amdgcn_readfirstlane((int)(unsigned)(size_t)dst);
    asm volatile("s_mov_b32 %0, m0\n\ts_mov_b32 m0, %2\n\ts_nop 0\n\tglobal_load_lds_dwordx4 %1, off\n\ts_mov_b32 m0, %0" : "=&s"(keep) : "v"(gsrc), "s"(d) : "memory"); }
__device__ __forceinline__ f32x16 splat16(float v) { f32x16 r;
#pragma unroll
    for (int i = 0; i < 16; ++i) r[i] = v; return r; }
#define MFMA32(a, b, c) __builtin_amdgcn_mfma_f32_32x32x16_bf16((a), (b), (c), 0, 0, 0)

__device__ __constant__ const float kLog2Gamma[8] = {-0.04580368961312479f, -0.02272007650008353f, -0.011315313227834146f, -0.005646563141142063f, -0.0028205190623786626f, -0.0014095702546713536f, -0.0007046129765893727f, -0.0003522634716290214f};
__device__ __forceinline__ int t5_bucket(int n) {
    if (n < 16) return n;
    if (n >= 113) return 31;
    int b = 16;
    b += (n >= 19); b += (n >= 21); b += (n >= 24); b += (n >= 27); b += (n >= 31); b += (n >= 35); b += (n >= 40); b += (n >= 46);
    b += (n >= 52); b += (n >= 59); b += (n >= 67); b += (n >= 77); b += (n >= 87); b += (n >= 99);
    return b;
}

__device__ __forceinline__ void p0_transpose_item(const float* W, int N, bf16* WT, int ldt, int koff, LAS float* scr, int item, int lane, const float* gain = nullptr) {
    const int nblk = N / 32, kb = item / nblk, nb = item % nblk, k0 = 64 * kb, n0 = 32 * nb;
#pragma unroll 8
    for (int i = 0; i < 32; ++i) { const int kk = 2 * i + (lane >> 5); scr[kk * 33 + (lane & 31)] = W[(size_t)(k0 + kk) * N + n0 + (lane & 31)]; }
    LDS_WAIT(); asm volatile("" ::: "memory");
    const int c = lane & 7;
    f32x4 ga = {1.f, 1.f, 1.f, 1.f}, gb = ga; if (gain) { ga = *(const GAS f32x4*)(gain + k0 + 8 * c); gb = *(const GAS f32x4*)(gain + k0 + 8 * c + 4); }
#pragma unroll
    for (int j = 0; j < 4; ++j) { const int n = (lane >> 3) + 8 * j; const LAS float* s = scr + (8 * c) * 33 + n;
        v4u o; o.x = pk2(s[0 * 33] * ga.x, s[1 * 33] * ga.y); o.y = pk2(s[2 * 33] * ga.z, s[3 * 33] * ga.w); o.z = pk2(s[4 * 33] * gb.x, s[5 * 33] * gb.y); o.w = pk2(s[6 * 33] * gb.z, s[7 * 33] * gb.w);
        *(GAS v4u*)(WT + (size_t)(n0 + n) * ldt + koff + k0 + 8 * c) = o; }
    LDS_WAIT(); asm volatile("" ::: "memory");
}
__device__ __forceinline__ void prep_row(const float* xrow, bf16* orow, float* rs, int lane) {
    const GAS f32x4* xr = (const GAS f32x4*)xrow + lane;
    f32x4 v[8]; float s = 0.f;
#pragma unroll
    for (int j = 0; j < 8; ++j) { v[j] = xr[64 * j]; s += (v[j].x * v[j].x + v[j].y * v[j].y) + (v[j].z * v[j].z + v[j].w * v[j].w); }
    s = wave_sum(s);
    GAS v2u* o8 = (GAS v2u*)orow + lane;
#pragma unroll
    for (int j = 0; j < 8; ++j) { v2u w; w.x = pk2(v[j].x, v[j].y); w.y = pk2(v[j].z, v[j].w); o8[64 * j] = w; }
    if (lane == 0) *rs = 1.f / sqrtf(s * (1.f / DM) + NORM_EPS);
}
__device__ __forceinline__ void resid_row(bf16* xrow, const bf16* yrow, const float* part, const float* gpost, float* rs, float* fout, int lane, bf16* xdst = nullptr) {
    GAS v2u* xr = (GAS v2u*)xrow + lane; GAS v2u* xw = xdst ? (GAS v2u*)xdst + lane : xr; const GAS v2u* yr = (const GAS v2u*)yrow + lane; const GAS f32x4* gp = (const GAS f32x4*)gpost + lane;
    float ps = (lane < 32) ? part[lane] : 0.f; ps = wave_sum(ps);
    const float rs1 = 1.f / sqrtf(ps * (1.f / DM) + NORM_EPS);
    f32x4 v[8]; float s = 0.f;
#pragma unroll
    for (int j = 0; j < 8; ++j) { const v2u x = xr[64 * j]; const v2u y = yr[64 * j]; const f32x4 g = gp[64 * j];
        v[j].x = bflo(x.x) + bflo(y.x) * rs1 * g.x; v[j].y = bfhi(x.x) + bfhi(y.x) * rs1 * g.y; v[j].z = bflo(x.y) + bflo(y.y) * rs1 * g.z; v[j].w = bfhi(x.y) + bfhi(y.y) * rs1 * g.w;
        s += (v[j].x * v[j].x + v[j].y * v[j].y) + (v[j].z * v[j].z + v[j].w * v[j].w); }
    if (fout) { GAS f32x4* xo = (GAS f32x4*)fout + lane;
#pragma unroll
        for (int j = 0; j < 8; ++j) xo[64 * j] = v[j]; }
    else { s = wave_sum(s);
#pragma unroll
        for (int j = 0; j < 8; ++j) { v2u w; w.x = pk2(v[j].x, v[j].y); w.y = pk2(v[j].z, v[j].w); xw[64 * j] = w; }
        if (lane == 0) *rs = 1.f / sqrtf(s * (1.f / DM) + NORM_EPS); }
}

__device__ __forceinline__ void pool_unit(LAS unsigned char* lds, const bf16* proj, const bf16* poolT, const float* pscale, bf16* Y, int tb, int g, int tid, int lane, int wid) {
    asm volatile("" : "+v"(tid)); lane = tid & 63;
    const int win = 2 << g, hi = lane >> 5, r32 = lane & 31;
    const int t0 = tb * 128;
    bf16x8 bfr[16];
    { const bf16* bp = poolT + ((size_t)g * 256 + 32 * wid + r32) * 256 + 8 * hi;
#pragma unroll
      for (int s = 0; s < 16; ++s) bfr[s] = *(const GAS bf16x8*)(bp + 16 * s); }
    { const int cc = tid & 31, tsb = tid >> 5;
      const bf16* up = proj + (size_t)t0 * LDP + C_POOL + g * 256 + cc * 8;
      const int pos0 = (t0 & (SEQ - 1)) + tsb * 8;
      float aw[8];
#pragma unroll
      for (int e = 0; e < 8; ++e) aw[e] = 0.f;
      for (int j = 1; j < win; ++j) { if (pos0 - j >= 0) { const v4u w = *(const GAS v4u*)(up + (long)(tsb * 8 - j) * LDP);
          aw[0] += bflo(w.x); aw[1] += bfhi(w.x); aw[2] += bflo(w.y); aw[3] += bfhi(w.y); aw[4] += bflo(w.z); aw[5] += bfhi(w.z); aw[6] += bflo(w.w); aw[7] += bfhi(w.w); } }
#pragma unroll
      for (int tt = 0; tt < 8; ++tt) {
          const int pos = pos0 + tt; const v4u w = *(const GAS v4u*)(up + (long)(tsb * 8 + tt) * LDP);
          float cu[8] = {bflo(w.x), bfhi(w.x), bflo(w.y), bfhi(w.y), bflo(w.z), bfhi(w.z), bflo(w.w), bfhi(w.w)};
#pragma unroll
          for (int e = 0; e < 8; ++e) aw[e] += cu[e];
          const float inv = 1.f / (float)(pos + 1 < win ? pos + 1 : win);
          v4u o; o.x = pk2(aw[0] * inv - cu[0], aw[1] * inv - cu[1]); o.y = pk2(aw[2] * inv - cu[2], aw[3] * inv - cu[3]); o.z = pk2(aw[4] * inv - cu[4], aw[5] * inv - cu[5]); o.w = pk2(aw[6] * inv - cu[6], aw[7] * inv - cu[7]);
          *(LAS v4u*)(lds + cc * 2048 + (tsb * 8 + tt) * 16) = o;
          if (pos - (win - 1) >= 0) { const v4u z = *(const GAS v4u*)(up + (long)(tsb * 8 + tt - (win - 1)) * LDP);
              aw[0] -= bflo(z.x); aw[1] -= bfhi(z.x); aw[2] -= bflo(z.y); aw[3] -= bfhi(z.y); aw[4] -= bflo(z.z); aw[5] -= bfhi(z.z); aw[6] -= bflo(z.w); aw[7] -= bfhi(z.w); }
      } }
    WG_BAR();
    f32x16 acc[4];
#pragma unroll
    for (int k = 0; k < 4; ++k) acc[k] = splat16(0.f);
#pragma unroll
    for (int s = 0; s < 16; ++s)
#pragma unroll
        for (int k = 0; k < 4; ++k) { const bf16x8 a = *(const LAS bf16x8*)(lds + (2 * s + hi) * 2048 + (32 * k + r32) * 16); acc[k] = MFMA32(a, bfr[s], acc[k]); }
    const int oc = g * 256 + 32 * wid + r32; const float ps = pscale[oc];
#pragma unroll
    for (int k = 0; k < 4; ++k)
#pragma unroll
        for (int r = 0; r < 16; ++r) { const int tok = 32 * k + crow(r, hi); Y[(size_t)(t0 + tok) * LDY + oc] = (bf16)(pk2(acc[k][r] * ps, 0.f) & 0xffffu); }
    WG_BAR();
}

#ifndef ATT_UNROLL2
#define ATT_UNROLL2 0
#endif
__device__ __forceinline__ void attn_unit(LAS unsigned char* lds, const bf16* proj, bf16* Y, const float* relb, const float* hgain, float lam, float oscale, int b, int h, int qb, int tid, int lane, int wid) {
    asm volatile("" : "+v"(tid)); lane = tid & 63;
    const int r32 = lane & 31, hi = lane >> 5, mp = wid >> 2, wq = wid & 3;
    const int q0 = qb * 128, qw = q0 + 32 * wq;
    const size_t rowbase = (size_t)b * SEQ;
    LAS float* tab = (LAS float*)(lds + 98304);
    if (tid < 129) tab[tid] = relb[t5_bucket(tid) * 8 + h] * LOG2E;
    const float bias31 = relb[31 * 8 + h] * LOG2E;
    LAS unsigned char* qlds = lds + 100352 + wid * 4096 + hi * 512 + r32 * 16;
    { const bf16* qp = proj + (rowbase + qw + r32) * LDP + C_QD + h * 128 + mp * 64 + hi * 8;
#pragma unroll
      for (int d0 = 0; d0 < 4; ++d0) *(LAS bf16x8*)(qlds + d0 * 1024) = *(const GAS bf16x8*)(qp + d0 * 16); }
    const bf16* k0src = proj + (rowbase + (lane & 32) + swap23(r32)) * LDP + C_KD + h * 128 + wid * 8;
    const bf16* k1src = k0src + 64;
    const bf16* vsrc[2];
#pragma unroll
    for (int i = 0; i < 2; ++i) { const int vrow = 8 * wid + 4 * i + (lane >> 4); const int ch = (lane & 15) ^ (((vrow & 3) << 2) | ((vrow >> 2) & 3)); vsrc[i] = proj + (rowbase + vrow) * LDP + C_VD + h * 128 + ch * 8; }
#define ATT_DMA(t, sb_) do { const size_t ko_ = (size_t)(t) * 64 * LDP; \
        glds16_asm(k0src + ko_, (sb_) + wid * 1024); glds16_asm(k1src + ko_, (sb_) + 8192 + wid * 1024); glds16_asm(vsrc[0] + ko_, (sb_) + 16384 + wid * 2048); glds16_asm(vsrc[1] + ko_, (sb_) + 16384 + wid * 2048 + 1024); } while (0)
    unsigned va[4][2];
#pragma unroll
    for (int c = 0; c < 4; ++c) { va[c][0] = 16384u + tr_off(lane, c, 0); va[c][1] = 16384u + tr_off(lane, c, 1); }
    const unsigned kboff = mp * 8192 + hi * 1024 + r32 * 16;
    const int NT = 2 * qb + 2;
    ATT_DMA(0, lds); ATT_DMA(1, lds + 32768);
    float m_run = -1e30f, l_run = 0.f;
    f32x16 o[4];
#pragma unroll
    for (int c = 0; c < 4; ++c) o[c] = splat16(0.f);
    const int qi = qw + r32;
#define ATT_QK(S0, S1, sbp, cin) do { S0 = splat16(cin); S1 = S0; \
        _Pragma("unroll") for (int d0 = 0; d0 < 4; ++d0) { const bf16x8 kf0_ = *(const LAS bf16x8*)((sbp) + kboff + d0 * 2048), kf1_ = *(const LAS bf16x8*)((sbp) + kboff + d0 * 2048 + 512), q_ = *(const LAS bf16x8*)(qlds + d0 * 1024); \
            S0 = MFMA32(kf0_, q_, S0); S1 = MFMA32(kf1_, q_, S1); } } while (0)
    WG_BAR();
    f32x16 sA0, sA1, sB0, sB1;
    typedef __bf16 bf2_t_ __attribute__((ext_vector_type(2)));
    const bf2_t_ one2 = __builtin_bit_cast(bf2_t_, 0x3F803F80u);
    { const bool far0 = (63 + 128 <= qw); ATT_QK(sA0, sA1, lds, far0 ? bias31 : 0.f);
      if (!far0) {
#pragma unroll
          for (int r = 0; r < 16; ++r) { const int key = 16 * (r >> 3) + 8 * hi + (r & 7); const int d0_ = qi - key, d1_ = d0_ - 32;
              const float b0 = tab[d0_ < 0 ? 0 : (d0_ > 128 ? 128 : d0_)], b1 = tab[d1_ < 0 ? 0 : (d1_ > 128 ? 128 : d1_)];
              sA0[r] = d0_ < 0 ? -1e30f : sA0[r] + b0; sA1[r] = d1_ < 0 ? -1e30f : sA1[r] + b1; } }
      float mt = __builtin_fmaxf(sA0[0], sA1[0]);
#pragma unroll
      for (int r = 1; r < 16; ++r) mt = __builtin_fmaxf(mt, __builtin_fmaxf(sA0[r], sA1[r]));
      mt = half_swap_max(mt); m_run = mt;
#pragma unroll
      for (int r = 0; r < 16; ++r) { sA0[r] -= mt; sA1[r] -= mt; } }
    int sc = 0, sn = 32768, sn2 = 65536;
#define SB() __builtin_amdgcn_sched_barrier(0)
#define EX2(P, i) do { P[i] = __builtin_amdgcn_exp2f(P[i]); P[(i) + 1] = __builtin_amdgcn_exp2f(P[(i) + 1]); } while (0)
#define MX4(P, i) __builtin_fmaxf(__builtin_fmaxf(P[i], P[(i) + 1]), __builtin_fmaxf(P[(i) + 2], P[(i) + 3]))
#define PK8(P, i) ({ v4u w_; w_.x = pk2(P[i], P[(i) + 1]); w_.y = pk2(P[(i) + 2], P[(i) + 3]); w_.z = pk2(P[(i) + 4], P[(i) + 5]); w_.w = pk2(P[(i) + 6], P[(i) + 7]); __builtin_bit_cast(bf16x8, w_); })
#define VRD(dst, ks) do { _Pragma("unroll") for (int c_ = 0; c_ < 4; ++c_) dst[c_] = trfrag(sb, va[c_][0] + 4096u * (ks), va[c_][1] + 4096u * (ks)); } while (0)
#define PVM(vf_, pk_) do { _Pragma("unroll") for (int c_ = 0; c_ < 4; ++c_) o[c_] = MFMA32(vf_[c_], pk_, o[c_]); } while (0)
#define DSUM(pk_) do { } while (0)
#define ATT_TILE(P0, P1, N0, N1, T) do { \
        if ((T) + 2 < NT) ATT_DMA((T) + 2, lds + sn2); \
        const int k0 = 64 * (T); \
        if (k0 <= qw + 31) { \
            LAS unsigned char* sb = lds + sc; LAS unsigned char* sbn = lds + sn; \
            if ((T) > 0 && !(k0 + 63 + 128 <= qw)) { \
                _Pragma("unroll") for (int r = 0; r < 16; ++r) { const int key = k0 + 16 * (r >> 3) + 8 * hi + (r & 7); const int d0_ = qi - key, d1_ = d0_ - 32; \
                    const float b0 = tab[d0_ < 0 ? 0 : (d0_ > 128 ? 128 : d0_)], b1 = tab[d1_ < 0 ? 0 : (d1_ > 128 ? 128 : d1_)]; \
                    P0[r] = d0_ < 0 ? -1e30f : P0[r] + b0; P1[r] = d1_ < 0 ? -1e30f : P1[r] + b1; } } \
            const bool farn = (k0 + 64 + 63 + 128 <= qw); const float cin = (farn ? bias31 : 0.f) - m_run; \
            N0 = splat16(cin); N1 = N0; bf16x8 kf[4], qf[2], vfA[4], vfB[4], pw0, pw1, pw2, pw3; \
            SB(); \
            _Pragma("unroll") for (int d0 = 0; d0 < 2; ++d0) { kf[2 * d0] = *(const LAS bf16x8*)(sbn + kboff + d0 * 2048); kf[2 * d0 + 1] = *(const LAS bf16x8*)(sbn + kboff + d0 * 2048 + 512); qf[d0] = *(const LAS bf16x8*)(qlds + d0 * 1024); } \
            SB(); \
            N0 = MFMA32(kf[0], qf[0], N0); EX2(P0, 0); EX2(P0, 2); SB(); \
            N1 = MFMA32(kf[1], qf[0], N1); EX2(P0, 4); EX2(P0, 6); SB(); \
            N0 = MFMA32(kf[2], qf[1], N0); EX2(P0, 8); EX2(P0, 10); SB(); \
            N1 = MFMA32(kf[3], qf[1], N1); EX2(P0, 12); EX2(P0, 14); SB(); \
            _Pragma("unroll") for (int d0 = 0; d0 < 2; ++d0) { kf[2 * d0] = *(const LAS bf16x8*)(sbn + kboff + (d0 + 2) * 2048); kf[2 * d0 + 1] = *(const LAS bf16x8*)(sbn + kboff + (d0 + 2) * 2048 + 512); qf[d0] = *(const LAS bf16x8*)(qlds + (d0 + 2) * 1024); } \
            EX2(P1, 0); EX2(P1, 2); SB(); \
            N0 = MFMA32(kf[0], qf[0], N0); EX2(P1, 4); EX2(P1, 6); SB(); \
            N1 = MFMA32(kf[1], qf[0], N1); EX2(P1, 8); EX2(P1, 10); SB(); \
            N0 = MFMA32(kf[2], qf[1], N0); EX2(P1, 12); EX2(P1, 14); SB(); \
            N1 = MFMA32(kf[3], qf[1], N1); VRD(vfA, 0); VRD(vfB, 1); SB(); \
            float mx = __builtin_fmaxf(__builtin_fmaxf(__builtin_fmaxf(MX4(P0, 0), MX4(P0, 4)), __builtin_fmaxf(MX4(P0, 8), MX4(P0, 12))), __builtin_fmaxf(__builtin_fmaxf(MX4(P1, 0), MX4(P1, 4)), __builtin_fmaxf(MX4(P1, 8), MX4(P1, 12)))); \
            if (__any(mx > 256.f)) {                                              \
                mx = half_swap_max(mx); const float big = __builtin_fmaxf(mx, 1.f); const float dl = __builtin_amdgcn_logf(big), f = __builtin_amdgcn_rcpf(big); m_run += dl; \
                _Pragma("unroll") for (int c = 0; c < 4; ++c) _Pragma("unroll") for (int r = 0; r < 16; ++r) o[c][r] *= f; \
                l_run *= f; _Pragma("unroll") for (int r = 0; r < 16; ++r) { P0[r] *= f; P1[r] *= f; N0[r] -= dl; N1[r] -= dl; } } \
            { float sm_ = 0.f; _Pragma("unroll") for (int r = 0; r < 16; ++r) sm_ += P0[r] + P1[r]; l_run += sm_; } \
            pw0 = PK8(P0, 0); pw1 = PK8(P0, 8); pw2 = PK8(P1, 0); pw3 = PK8(P1, 8); DSUM(pw0); DSUM(pw1); DSUM(pw2); DSUM(pw3); SB(); \
            PVM(vfA, pw0); SB(); \
            VRD(vfA, 2); SB(); \
            PVM(vfB, pw1); SB(); \
            VRD(vfB, 3); SB(); \
            PVM(vfA, pw2); SB(); \
            PVM(vfB, pw3); SB(); \
        } \
        { const int tmp = sc; sc = sn; sn = sn2; sn2 = tmp; } \
        WG_BAR(); } while (0)
#if ATT_UNROLL2
    for (int t = 0; t < NT; t += 2) { ATT_TILE(sA0, sA1, sB0, sB1, t); ATT_TILE(sB0, sB1, sA0, sA1, t + 1); }
#else
    for (int t = 0; t < NT; ++t) { ATT_TILE(sA0, sA1, sB0, sB1, t); sA0 = sB0; sA1 = sB1; }
#endif
#undef ATT_TILE
#undef SB
#undef EX2
#undef MX4
#undef PK8
#undef VRD
#undef PVM
#undef DSUM
#undef ATT_DMA
#undef ATT_QK
    l_run = half_swap_sum(l_run);
    const float inv = 1.f / l_run;
    LAS float* xch = (LAS float*)lds;
    if (mp == 1) {
#pragma unroll
        for (int c = 0; c < 4; ++c)
#pragma unroll
            for (int r = 0; r < 16; ++r) xch[((wq * 64 + c * 16 + r) << 6) + lane] = o[c][r] * inv;
    }
    WG_BAR();
    if (mp == 0) {
        float ss = 0.f;
#pragma unroll
        for (int c = 0; c < 4; ++c)
#pragma unroll
            for (int r = 0; r < 16; ++r) { const float d = o[c][r] * inv - lam * xch[((wq * 64 + c * 16 + r) << 6) + lane]; o[c][r] = d; ss += d * d; }
        ss = half_swap_sum(ss);
        const float rs = oscale / sqrtf(ss * (1.f / 128.f) + NORM_EPS);
        bf16* yp = Y + (rowbase + qi) * LDY + 1024 + h * 128;
#pragma unroll
        for (int c = 0; c < 4; ++c)
#pragma unroll
            for (int r4 = 0; r4 < 4; ++r4) { const int dv = 32 * c + 8 * r4 + 4 * hi; const f32x4 g = *(const GAS f32x4*)(hgain + dv);
                v2u w; w.x = pk2(o[c][4 * r4] * rs * g.x, o[c][4 * r4 + 1] * rs * g.y); w.y = pk2(o[c][4 * r4 + 2] * rs * g.z, o[c][4 * r4 + 3] * rs * g.w);
                *(GAS v2u*)(yp + dv) = w; }
    }
    WG_BAR();
}

template <int MODE  > __device__ __forceinline__ void ret_stage_rot(LAS unsigned char* tile, const bf16* src  , const f32x2* rot  , float sc, float l2g, int tid) {
#pragma unroll
    for (int i = 0; i < 2; ++i) { const int item = tid + 512 * i, j = item >> 3, cc = item & 7;
        const v4u lo = *(const GAS v4u*)(src + (size_t)j * LDP + 8 * cc), hh = *(const GAS v4u*)(src + (size_t)j * LDP + 64 + 8 * cc);
        const GAS f32x4* rp = (const GAS f32x4*)(rot + (size_t)j * 64 + 8 * cc);
        const f32x4 c0 = rp[0], c1 = rp[1], c2 = rp[2], c3 = rp[3];
        const float cs[8] = {c0.x, c0.z, c1.x, c1.z, c2.x, c2.z, c3.x, c3.z}, sn[8] = {c0.y, c0.w, c1.y, c1.w, c2.y, c2.w, c3.y, c3.w};
        const float a[8] = {bflo(lo.x), bfhi(lo.x), bflo(lo.y), bfhi(lo.y), bflo(lo.z), bfhi(lo.z), bflo(lo.w), bfhi(lo.w)};
        const float bb[8] = {bflo(hh.x), bfhi(hh.x), bflo(hh.y), bfhi(hh.y), bflo(hh.z), bfhi(hh.z), bflo(hh.w), bfhi(hh.w)};
        const float s = MODE == 1 ? sc * __builtin_amdgcn_exp2f((float)(127 - j) * l2g) : sc;
        float o1[8], o2[8];
#pragma unroll
        for (int e = 0; e < 8; ++e) { o1[e] = (a[e] * cs[e] - bb[e] * sn[e]) * s; o2[e] = (bb[e] * cs[e] + a[e] * sn[e]) * s; }
        v4u w; w.x = pk2(o1[0], o1[1]); w.y = pk2(o1[2], o1[3]); w.z = pk2(o1[4], o1[5]); w.w = pk2(o1[6], o1[7]); *(LAS v4u*)(tile + offb(j, cc)) = w;
        w.x = pk2(o2[0], o2[1]); w.y = pk2(o2[2], o2[3]); w.z = pk2(o2[4], o2[5]); w.w = pk2(o2[6], o2[7]); *(LAS v4u*)(tile + offb(j, cc + 8)) = w; }
}
__device__ __forceinline__ void ret_stage_plain(LAS unsigned char* tile, const bf16* src, int ld, int tid) {
#pragma unroll
    for (int i = 0; i < 4; ++i) { const int item = tid + 512 * i, row = item >> 4, ch = item & 15; *(LAS v4u*)(tile + offb(row, ch)) = *(const GAS v4u*)(src + (size_t)row * ld + 8 * ch); }
}
__device__ __forceinline__ void retA_unit(LAS unsigned char* lds, const bf16* proj, const f32x2* rot, float* KV, int u, int tid, int lane, int wid) {
    asm volatile("" : "+v"(tid)); lane = tid & 63;
    const int bh = u >> 5, c = u & 31, b = bh >> 3, h = bh & 7, hi = lane >> 5, r32 = lane & 31;
    const size_t t0 = (size_t)b * SEQ + c * 128; const float l2g = kLog2Gamma[h];
    ret_stage_rot<1>(lds, proj + t0 * LDP + C_KR + h * 128, rot + (size_t)c * 128 * 64, RET_KSCALE, l2g, tid);
    ret_stage_plain(lds + 32768, proj + t0 * LDP + C_VR + h * 128, LDP, tid);
    WG_BAR();
    const int db = wid & 3, eb0 = 2 * (wid >> 2);
    const unsigned a0 = tr_off(lane, db, 0), a1 = tr_off(lane, db, 1);
    unsigned b0[2], b1[2];
#pragma unroll
    for (int k = 0; k < 2; ++k) { b0[k] = 32768u + tr_off(lane, eb0 + k, 0); b1[k] = 32768u + tr_off(lane, eb0 + k, 1); }
    f32x16 acc[2] = {splat16(0.f), splat16(0.f)};
#pragma unroll
    for (int ks = 0; ks < 8; ++ks) { const bf16x8 A = trfrag(lds, a0 + 4096u * ks, a1 + 4096u * ks);
#pragma unroll
        for (int k = 0; k < 2; ++k) { const bf16x8 B = trfrag(lds, b0[k] + 4096u * ks, b1[k] + 4096u * ks); acc[k] = MFMA32(A, B, acc[k]); } }
    float* kvp = KV + (size_t)u * 16384;
#pragma unroll
    for (int k = 0; k < 2; ++k)
#pragma unroll
        for (int r = 0; r < 16; ++r) kvp[(32 * db + crow(r, hi)) * 128 + 32 * (eb0 + k) + r32] = acc[k][r];
    WG_BAR();
}
__device__ __forceinline__ void retC_unit(LAS unsigned char* lds, const bf16* proj, const f32x2* rot, const bf16* SST, bf16* Y, int u, int tid, int lane, int wid) {
    asm volatile("" : "+v"(tid)); lane = tid & 63;
    const int bh = u >> 5, c = u & 31, b = bh >> 3, h = bh & 7, hi = lane >> 5, r32 = lane & 31;
    const size_t t0 = (size_t)b * SEQ + c * 128; const float l2g = kLog2Gamma[h];
    ret_stage_rot<0>(lds, proj + t0 * LDP + C_QR + h * 128, rot + (size_t)c * 128 * 64, 1.f, 0.f, tid);
    ret_stage_rot<0>(lds + 32768, proj + t0 * LDP + C_KR + h * 128, rot + (size_t)c * 128 * 64, RET_KSCALE, 0.f, tid);
    ret_stage_plain(lds + 65536, proj + t0 * LDP + C_VR + h * 128, LDP, tid);
    if (c > 0) ret_stage_plain(lds + 98304, SST + (size_t)u * 16384, 128, tid);
    WG_BAR();
    const int ib = wid & 3, eh = wid >> 2, il = 32 * ib + r32;
    bf16x8 qf[8];
#pragma unroll
    for (int ks = 0; ks < 8; ++ks) qf[ks] = *(const LAS bf16x8*)(lds + offb(il, 2 * ks + hi));
    unsigned v0[2], v1[2];
#pragma unroll
    for (int k = 0; k < 2; ++k) { v0[k] = tr_off(lane, 2 * eh + k, 0); v1[k] = tr_off(lane, 2 * eh + k, 1); }
    f32x16 acc[2] = {splat16(0.f), splat16(0.f)};
    if (c > 0) {
#pragma unroll
        for (int ks = 0; ks < 8; ++ks)
#pragma unroll
            for (int k = 0; k < 2; ++k) { const bf16x8 A = trfrag(lds + 98304, v0[k] + 4096u * ks, v1[k] + 4096u * ks); acc[k] = MFMA32(A, qf[ks], acc[k]); }
        const float qd = __builtin_amdgcn_exp2f((float)(il + 1) * l2g);
#pragma unroll
        for (int k = 0; k < 2; ++k)
#pragma unroll
            for (int r = 0; r < 16; ++r) acc[k][r] *= qd;
    }
    for (int jb = 0; jb <= ib; ++jb) {
        f32x16 sc = splat16(0.f);
        const int krow = 32 * jb + swap23(r32);
#pragma unroll
        for (int ks = 0; ks < 8; ++ks) { const bf16x8 A = *(const LAS bf16x8*)(lds + 32768 + offb(krow, 2 * ks + hi)); sc = MFMA32(A, qf[ks], sc); }
#pragma unroll
        for (int r = 0; r < 16; ++r) { const int j = 32 * jb + 16 * (r >> 3) + 8 * hi + (r & 7); const int dj = il - j; sc[r] = dj >= 0 ? sc[r] * __builtin_amdgcn_exp2f((float)dj * l2g) : 0.f; }
        bf16x8 pk[2];
        { v4u w; w.x = pk2(sc[0], sc[1]); w.y = pk2(sc[2], sc[3]); w.z = pk2(sc[4], sc[5]); w.w = pk2(sc[6], sc[7]); pk[0] = __builtin_bit_cast(bf16x8, w);
          w.x = pk2(sc[8], sc[9]); w.y = pk2(sc[10], sc[11]); w.z = pk2(sc[12], sc[13]); w.w = pk2(sc[14], sc[15]); pk[1] = __builtin_bit_cast(bf16x8, w); }
#pragma unroll
        for (int s = 0; s < 2; ++s)
#pragma unroll
            for (int k = 0; k < 2; ++k) { const unsigned ko = 4096u * (unsigned)(2 * jb + s); const bf16x8 A = trfrag(lds + 65536, v0[k] + ko, v1[k] + ko); acc[k] = MFMA32(A, pk[s], acc[k]); }
    }
    float ss = 0.f;
#pragma unroll
    for (int k = 0; k < 2; ++k)
#pragma unroll
        for (int r = 0; r < 16; ++r) ss += acc[k][r] * acc[k][r];
    ss = half_swap_sum(ss);
    LAS float* xs = (LAS float*)(lds + 131072);
    if (hi == 0) xs[eh * 128 + il] = ss;
    WG_BAR();
    const float rs = 1.f / sqrtf((xs[il] + xs[128 + il]) * (1.f / 128.f) + NORM_EPS);
    const bf16* gp = proj + (t0 + il) * LDP + C_GR + h * 128; bf16* yp = Y + (t0 + il) * LDY + 2048 + h * 128;
#pragma unroll
    for (int k = 0; k < 2; ++k)
#pragma unroll
        for (int r4 = 0; r4 < 4; ++r4) { const int e = 32 * (2 * eh + k) + 8 * r4 + 4 * hi; const v2u gw = *(const GAS v2u*)(gp + e);
            v2u w; w.x = pk2(acc[k][4 * r4] * rs * bflo(gw.x), acc[k][4 * r4 + 1] * rs * bfhi(gw.x)); w.y = pk2(acc[k][4 * r4 + 2] * rs * bflo(gw.y), acc[k][4 * r4 + 3] * rs * bfhi(gw.y));
            *(GAS v2u*)(yp + e) = w; }
    WG_BAR();
}
#define XB_TMO      128
#define XB_XCNT(j)  (256  + 64 * (j))
#define XB_XSUB(j)  (1280 + 64 * (j))
#define XB_XGEN(j)  (2304 + 64 * (j))
#define XB_TOP      3328
#define XB_TOPGEN   3392
#define XCD_BAR_WORDS 3456
#define XB_SPIN_CAP (1u << 18)

__device__ __forceinline__ unsigned xb_ld(unsigned* p)              { return __hip_atomic_load(p, __ATOMIC_RELAXED, __HIP_MEMORY_SCOPE_AGENT); }
__device__ __forceinline__ unsigned xb_add(unsigned* p, unsigned v) { return __hip_atomic_fetch_add(p, v, __ATOMIC_RELAXED, __HIP_MEMORY_SCOPE_AGENT); }
__device__ __forceinline__ unsigned xb_xcc_id() { return (unsigned)__builtin_amdgcn_s_getreg((3 << 11) | 20) & 0xFu; }
#define XB_SPIN(cond, bar) do { unsigned _sp = 0; while (cond) { __builtin_amdgcn_s_sleep(1); \
    if ((++_sp & 255u) == 0u) { if (xb_ld(&(bar)[XB_TMO])) break; if (_sp > XB_SPIN_CAP) { atomicAdd(&(bar)[XB_TMO], 1u); break; } } } } while (0)

struct XcdBarrier {
    unsigned* bar; unsigned x;
    volatile LAS unsigned* st;
};

__device__ __forceinline__ XcdBarrier xcd_barrier_post(unsigned* bar, volatile LAS unsigned* st) {
    XcdBarrier b; b.bar = bar; b.x = xb_xcc_id(); b.st = st;
    if (threadIdx.x == 0) (void)xb_add(&bar[XB_XCNT(b.x)], 1u);
    return b;
}
__device__ __forceinline__ void xcd_barrier_complete(unsigned* bar, unsigned x, unsigned& nloc, unsigned& nx) {
    const unsigned G = gridDim.x * gridDim.y * gridDim.z;
    unsigned sum, cnt, mine, sp = 0u;
    for (;;) {
        sum = 0u; cnt = 0u; mine = 0u;
#pragma unroll
        for (unsigned j = 0; j < 16; ++j) { const unsigned c = xb_ld(&bar[XB_XCNT(j)]); sum += c; cnt += (c > 0u) ? 1u : 0u; mine = (j == x) ? c : mine; }
        if (sum == G) break;
        __builtin_amdgcn_s_sleep(1);
        if ((++sp & 255u) == 0u) { if (xb_ld(&bar[XB_TMO])) break; if (sp > XB_SPIN_CAP) { atomicAdd(&bar[XB_TMO], 1u); break; } }
    }
    nloc = mine > 0u ? mine : 1u; nx = cnt > 0u ? cnt : 1u;
}

__device__ __forceinline__ void xcd_barrier(const XcdBarrier& b) {
    asm volatile("s_waitcnt vmcnt(0)" ::: "memory");
    __syncthreads();
    if (threadIdx.x == 0) {
        unsigned* bar = b.bar;
        __builtin_amdgcn_s_waitcnt(0);
        unsigned nloc = b.st[0], nx = b.st[1];
        if (nloc == 0u) { xcd_barrier_complete(bar, b.x, nloc, nx); b.st[0] = nloc; b.st[1] = nx; }
        const unsigned old = xb_add(&bar[XB_XSUB(b.x)], 1u);
        const unsigned gen = old / nloc;
        if (old + 1u == (gen + 1u) * nloc) {
            __builtin_amdgcn_fence(__ATOMIC_RELEASE, "agent");
            asm volatile("s_waitcnt vmcnt(0)" ::: "memory");
            const unsigned og = xb_add(&bar[XB_TOP], 1u);
            const unsigned tg = og / nx;
            if (og + 1u == (tg + 1u) * nx) xb_add(&bar[XB_TOPGEN], 1u);
            else XB_SPIN(xb_ld(&bar[XB_TOPGEN]) == tg, bar);
            __builtin_amdgcn_fence(__ATOMIC_ACQUIRE, "agent");
            xb_add(&bar[XB_XGEN(b.x)], 1u);
            asm volatile("s_waitcnt vmcnt(0)" ::: "memory");
        } else {
            XB_SPIN(xb_ld(&bar[XB_XGEN(b.x)]) == gen, bar);
            __builtin_amdgcn_fence(__ATOMIC_ACQUIRE, "agent");
            asm volatile("s_waitcnt vmcnt(0)" ::: "memory");
        }
    }
    __syncthreads();
}
#ifndef NAIVE
#define NAIVE 0
#endif
__device__ __forceinline__ void naive_pool(LAS unsigned char* lds, const bf16* proj, const float* poolw  , const float* pscale, bf16* Y, int vcu, int G, int tid) {
    LAS float* dl = (LAS float*)lds; LAS float* part = dl + 256;
    for (int it = vcu; it < M * 4; it += G) { const int t = it >> 2, g = it & 3, win = 2 << g, pos = t & (SEQ - 1);
        if (tid < 256) { const int lo = pos + 1 - win < 0 ? 0 : pos + 1 - win; float s = 0.f;
            for (int p = lo; p <= pos; ++p) s += bflo((unsigned)proj[(size_t)(t - (pos - p)) * LDP + C_POOL + g * 256 + tid]);
            const float cur = bflo((unsigned)proj[(size_t)t * LDP + C_POOL + g * 256 + tid]);
            dl[tid] = s / (float)(pos + 1 - lo) - cur; }
        __syncthreads();
        const int o = tid & 255, hf = tid >> 8; float a = 0.f;
        for (int c = hf * 128; c < hf * 128 + 128; ++c) a += dl[c] * poolw[((size_t)g * 256 + c) * 256 + o];
        if (hf) part[o] = a;
        __syncthreads();
        if (!hf) Y[(size_t)t * LDY + g * 256 + o] = (bf16)(pk2((a + part[o]) * pscale[g * 256 + o], 0.f) & 0xffffu);
        __syncthreads(); }
}
__device__ __forceinline__ void naive_ret(LAS unsigned char* lds, const bf16* proj, bf16* Y, int vcu, int G, int tid) {
    LAS float* qs = (LAS float*)lds; LAS float* ks = qs + 128; LAS float* vs = ks + 128; LAS float* po = vs + 128; LAS float* red = po + 512;
    for (int bh = vcu; bh < 32; bh += G) { const int b = bh >> 3, h = bh & 7; const float gam = 1.0f - exp2f(-5.0f - (float)h);
        float S[32];
#pragma unroll
        for (int i = 0; i < 32; ++i) S[i] = 0.f;
        const int e = tid & 127, dg = tid >> 7;
        for (int pos = 0; pos < SEQ; ++pos) { const size_t row = (size_t)b * SEQ + pos; const bf16* pr = proj + row * LDP + h * 128;
            if (tid < 128) { const int i = tid & 63; const float invf = exp2f(-((float)i / 63.0f) * 13.287712379549449f); const float ang = (float)pos * invf;
                const double rev = (double)ang * 0.15915494309189535; const float fr = (float)(rev - __builtin_rint(rev)); const float cs = __builtin_amdgcn_cosf(fr), sn = __builtin_amdgcn_sinf(fr);
                const float q1 = bflo((unsigned)pr[C_QR + i]), q2 = bflo((unsigned)pr[C_QR + 64 + i]), k1 = bflo((unsigned)pr[C_KR + i]), k2 = bflo((unsigned)pr[C_KR + 64 + i]);
                if (tid < 64) { qs[i] = q1 * cs - q2 * sn; ks[i] = (k1 * cs - k2 * sn) * RET_KSCALE; } else { qs[64 + i] = q2 * cs + q1 * sn; ks[64 + i] = (k2 * cs + k1 * sn) * RET_KSCALE; }
                vs[tid] = bflo((unsigned)pr[C_VR + tid]); }
            __syncthreads();
            float a = 0.f; const float ve = vs[e];
#pragma unroll
            for (int i = 0; i < 32; ++i) { const int d = dg * 32 + i; S[i] = gam * S[i] + ks[d] * ve; a += qs[d] * S[i]; }
            po[dg * 128 + e] = a;
            __syncthreads();
            if (tid < 128) { const float o = po[e] + po[128 + e] + po[256 + e] + po[384 + e]; const float s2 = wave_sum(o * o); if ((tid & 63) == 0) red[tid >> 6] = s2; po[e] = o; }
            __syncthreads();
            if (tid < 128) { const float rs = 1.0f / sqrtf((red[0] + red[1]) * (1.f / 128.f) + NORM_EPS); const float gt = bflo((unsigned)pr[C_GR + e]);
                Y[row * LDY + 2048 + h * 128 + e] = (bf16)(pk2(po[e] * rs * gt, 0.f) & 0xffffu); }
            __syncthreads(); } }
}
__device__ __forceinline__ void naive_attn(const bf16* proj, bf16* Y, const float* relb, const float* hgain, float lam, float oscale, int gw, int NGW, int lane) {
    for (int it = gw; it < 32 * SEQ; it += NGW) { const int bh = it / SEQ, q = it % SEQ, b = bh >> 3, h = bh & 7; const size_t rowbase = (size_t)b * SEQ;
        const bf16* qp = proj + (rowbase + q) * LDP + C_QD + h * 128;
        const float qa = bflo((unsigned)qp[lane]), qb = bflo((unsigned)qp[64 + lane]);
        float mx0 = -1e30f, mx1 = -1e30f;
        const int nkb = q / 64 + 1;
        for (int pass = 0; pass < 2; ++pass) {
            float l0 = 0.f, l1 = 0.f, o0a = 0.f, o0b = 0.f, o1a = 0.f, o1b = 0.f;
            for (int kb = 0; kb < nkb; ++kb) { const int key = kb * 64 + lane; const bool valid = key <= q; const int kc = valid ? key : q;
                const bf16* kp = proj + (rowbase + kc) * LDP + C_KD + h * 128; float s0 = 0.f, s1 = 0.f;
#pragma unroll
                for (int d8 = 0; d8 < 8; ++d8) { const v4u w0 = *(const GAS v4u*)(kp + 8 * d8), w1 = *(const GAS v4u*)(kp + 64 + 8 * d8);
#pragma unroll
                    for (int j = 0; j < 4; ++j) { const int d = 8 * d8 + 2 * j;
                        const float q0a = __builtin_bit_cast(float, __builtin_amdgcn_readlane(__builtin_bit_cast(int, qa), d)), q0b = __builtin_bit_cast(float, __builtin_amdgcn_readlane(__builtin_bit_cast(int, qa), d + 1));
                        const float q1a = __builtin_bit_cast(float, __builtin_amdgcn_readlane(__builtin_bit_cast(int, qb), d)), q1b = __builtin_bit_cast(float, __builtin_amdgcn_readlane(__builtin_bit_cast(int, qb), d + 1));
                        s0 += q0a * bflo(w0[j]) + q0b * bfhi(w0[j]); s1 += q1a * bflo(w1[j]) + q1b * bfhi(w1[j]); } }
                const float bs = relb[t5_bucket(q - kc) * 8 + h] * LOG2E; s0 += bs; s1 += bs;
                if (pass == 0) { if (valid) { mx0 = fmaxf(mx0, s0); mx1 = fmaxf(mx1, s1); } }
                else { const float p0 = valid ? exp2f(s0 - mx0) : 0.f, p1 = valid ? exp2f(s1 - mx1) : 0.f; l0 += p0; l1 += p1;
                    for (int kk = 0; kk < 64; ++kk) { const int k2 = kb * 64 + kk; if (k2 > q) break; const float a0 = __shfl(p0, kk), a1 = __shfl(p1, kk);
                        const bf16* vp = proj + (rowbase + k2) * LDP + C_VD + h * 128; const float va = bflo((unsigned)vp[lane]), vb = bflo((unsigned)vp[64 + lane]);
                        o0a += a0 * va; o0b += a0 * vb; o1a += a1 * va; o1b += a1 * vb; } } }
            if (pass == 0) {
#pragma unroll
                for (int o = 1; o < 64; o <<= 1) { mx0 = fmaxf(mx0, __shfl_xor(mx0, o)); mx1 = fmaxf(mx1, __shfl_xor(mx1, o)); } }
            else { l0 = wave_sum(l0); l1 = wave_sum(l1);
                const float da = o0a / l0 - lam * o1a / l1, db = o0b / l0 - lam * o1b / l1; const float ss = wave_sum(da * da + db * db);
                const float rs = oscale / sqrtf(ss * (1.f / 128.f) + NORM_EPS); bf16* yp = Y + (rowbase + q) * LDY + 1024 + h * 128;
                yp[lane] = (bf16)(pk2(da * rs * hgain[lane], 0.f) & 0xffffu); yp[64 + lane] = (bf16)(pk2(db * rs * hgain[64 + lane], 0.f) & 0xffffu); } } }
}
constexpr int NPH_LAYER = 10, NPH = 1 + DEPTH * NPH_LAYER;
struct Args { const float* in[15]; float* out; unsigned char* ws; int p_lo, p_hi; };
__global__ void __launch_bounds__(NWAVES * 64, 2) fwd(Args args) {
    extern __shared__ __attribute__((aligned(16))) unsigned char lds_raw[];
    LAS unsigned char* lds = (LAS unsigned char*)lds_raw;
#define LTID() ({ int t_ = threadIdx.x; asm volatile("" : "+v"(t_)); t_; })
    const int tid0 = threadIdx.x, wave = __builtin_amdgcn_readfirstlane(tid0 >> 6);
    const int G = gridDim.x; const int bx = blockIdx.x; const int vcu = (G % 8 == 0) ? (bx % 8) * (G / 8) + bx / 8 : bx;
    unsigned char* ws = args.ws;
    gu32* ctl = (gu32*)(ws + WS_CTL);
    for (int u = tid0; u < (LDS_BYTES - LDSCTL_OFF) / 4; u += NWAVES * 64) ((LAS unsigned*)(lds + LDSCTL_OFF))[u] = 0u;
    __syncthreads();
    volatile LAS unsigned* MISC = (volatile LAS unsigned*)(lds + MISC_OFF);
    XcdBarrier bar; bar.bar = (unsigned*)(ctl + CW_BAR); bar.x = 0; bar.st = nullptr;
    if (SINGLE_LAUNCH) bar = xcd_barrier_post((unsigned*)(ctl + CW_BAR), MISC + 8);
    const int lo = args.p_lo, hi_ph = args.p_hi;
#define IN(k) (lo <= (k) && (k) < hi_ph)
#ifndef PHMASK
#define PHMASK 0xffff
#endif
#define PHM(i) (((PHMASK) >> (i)) & 1)
#ifndef UMASK
#define UMASK 7
#endif
#define UEN(i) (((UMASK) >> (i)) & 1)
#ifndef DUPMASK
#define DUPMASK 0
#endif
#define REPS(i) ((((DUPMASK) >> (i)) & 1) ? 2 : 1)
#define SEAM(k) do { if (SINGLE_LAUNCH && IN(k) && IN((k) + 1)) xcd_barrier(bar); } while (0)

    const float* x_in = args.in[0]; const float* rel_bias = args.in[1];
    const float* g_pre_mix = args.in[2]; const float* g_post_mix = args.in[3]; const float* g_pre_mlp = args.in[4]; const float* g_post_mlp = args.in[5];
    const float* w_in = args.in[6]; const float* pool_w = args.in[7]; const float* pool_scale = args.in[8]; const float* diff_lambda = args.in[9]; const float* diff_hn = args.in[10];
    const float* w_branch = args.in[11]; const float* w_out = args.in[12]; const float* w_up = args.in[13]; const float* w_down = args.in[14];
    float* xres = args.out;
    bf16* WIN = (bf16*)(ws + WS_WIN); bf16* WB = (bf16*)(ws + WS_WB); bf16* WO = (bf16*)(ws + WS_WO); bf16* WUP = (bf16*)(ws + WS_WUP); bf16* WDN = (bf16*)(ws + WS_WDN); bf16* POOLT = (bf16*)(ws + WS_POOLT);
    bf16* XN = (bf16*)(ws + WS_XN); bf16* MRG = (bf16*)(ws + WS_MRG); bf16* MIX = (bf16*)(ws + WS_MIX); bf16* Y = (bf16*)(ws + WS_Y); bf16* PROJ = (bf16*)(ws + WS_PROJ); bf16* FF = PROJ;
    float* RS = (float*)(ws + WS_RS); float* KV = (float*)(ws + WS_KV); bf16* SST = (bf16*)(ws + WS_SST); float* STAT = (float*)(ws + WS_STAT); f32x2* ROT = (f32x2*)(ws + WS_ROT);
    const int gw = vcu * NWAVES + wave, NGW = G * NWAVES;

    if (PHM(0) && IN(0)) for (int rep_ = 0; rep_ < REPS(0); ++rep_) {
        const int tid = LTID(), lane = tid & 63;
        LAS float* scr = (LAS float*)(lds + wave * 16384);
        constexpr int I_IN = (DM / 64) * (INC / 32), I_B = (MIXW / 64) * (DM / 32), I_O = (DM / 64) * (DM / 32), I_UP = (DM / 64) * (DFF / 32), I_DN = (DFF / 64) * (DM / 32), I_P = (256 / 64) * (256 / 32);
        constexpr int I_LAYER = I_IN + 3 * I_B + I_O + I_UP + I_DN + 4 * I_P;
        for (int it = gw; it < DEPTH * I_LAYER; it += NGW) {
            const int l = it / I_LAYER; int r = it - l * I_LAYER;
            if (r < I_IN) { p0_transpose_item(w_in + (size_t)l * DM * INC, INC, WIN + (size_t)l * INC * DM, DM, 0, scr, r, lane, g_pre_mix + l * DM); continue; } r -= I_IN;
            if (r < 3 * I_B) { const int n = r / I_B; r -= n * I_B; p0_transpose_item(w_branch + ((size_t)l * 3 + n) * MIXW * DM, DM, WB + (size_t)l * DM * 3072, 3072, n * MIXW, scr, r, lane); continue; } r -= 3 * I_B;
            if (r < I_O) { p0_transpose_item(w_out + (size_t)l * DM * DM, DM, WO + (size_t)l * DM * DM, DM, 0, scr, r, lane); continue; } r -= I_O;
            if (r < I_UP) { p0_transpose_item(w_up + (size_t)l * DM * DFF, DFF, WUP + (size_t)l * DFF * DM, DM, 0, scr, r, lane, g_pre_mlp + l * DM); continue; } r -= I_UP;
            if (r < I_DN) { p0_transpose_item(w_down + (size_t)l * DFF * DM, DM, WDN + (size_t)l * DM * DFF, DFF, 0, scr, r, lane); continue; } r -= I_DN;
            { const int g = r / I_P; r -= g * I_P; p0_transpose_item(pool_w + ((size_t)l * 4 + g) * 65536, 256, POOLT + ((size_t)l * 4 + g) * 65536, 256, 0, scr, r, lane); }
        }
        for (int i = vcu * 512 + tid; i < SEQ * 64; i += G * 512) { const int pos = i >> 6, f = i & 63;
            const float invf = __builtin_amdgcn_exp2f(-(float)f * (13.287712379549449f / 63.0f));
            const float ang = (float)pos * invf; const double rev = (double)ang * 0.15915494309189535; const float fr = (float)(rev - __builtin_rint(rev));
            ROT[i] = (f32x2){__builtin_amdgcn_cosf(fr), __builtin_amdgcn_sinf(fr)}; }
        for (int m = gw; m < M; m += NGW) prep_row(x_in + (size_t)m * DM, XN + (size_t)m * DM, RS + m, lane);
    }
    SEAM(0);

    for (int l = 0; l < DEPTH; ++l) {
        const int pb = 1 + l * NPH_LAYER;
        const float lambda_init = 0.8f - 0.6f * __expf(-0.3f * (float)l);
#ifndef GREP1
#define GREP1 1
#endif
        for (int gr_ = 0; gr_ < GREP1; ++gr_) {
        if (PHM(1) && IN(pb + 0)) for (int rep_ = 0; rep_ < REPS(1); ++rep_) {
            pg8::Gemm g{XN, WIN + (size_t)l * INC * DM, M, INC, DM}; pg8::StaticOrder S; S.init(M, INC, G, bx);
            pg8::EpiProj E{PROJ, LDP, QSCALE, RS};
            pg8::gemm_phase<pg8::EpiProj, pg8::StaticOrder, GEMM_ALIGN, GEMM_SP2>(lds, g, S, E);
#ifdef DUPBAR
            if (rep_ + 1 < REPS(1)) xcd_barrier(bar);
#endif
        }
        SEAM(pb + 0);
        if (PHM(2) && IN(pb + 1)) for (int rep_ = 0; rep_ < REPS(2); ++rep_) {
            const int tid = LTID(), lane = tid & 63;
            if (NAIVE & 1) naive_pool(lds, PROJ, pool_w + (size_t)l * 4 * 65536, pool_scale + l * MIXW, Y, vcu, G, tid);
            else if (UEN(0)) for (int r2_ = 0; r2_ < REPS(11); ++r2_) for (int u = vcu; u < 512; u += G) pool_unit(lds, PROJ, POOLT + (size_t)l * 4 * 65536, pool_scale + l * MIXW, Y, u >> 2, u & 3, tid, lane, wave);
            if (NAIVE & 4) naive_ret(lds, PROJ, Y, vcu, G, tid);
            else if (UEN(1)) for (int r2_ = 0; r2_ < REPS(12); ++r2_) for (int u = vcu; u < 1024; u += G) retA_unit(lds, PROJ, ROT, KV, u, tid, lane, wave);
            if (UEN(2)) { const float* lp = diff_lambda + l * 256;
              const float s1 = wave_sum(lp[lane] * lp[64 + lane]), s2 = wave_sum(lp[128 + lane] * lp[192 + lane]);
              const float lam = __expf(s1) - __expf(s2) + lambda_init;
              if (NAIVE & 2) naive_attn(PROJ, Y, rel_bias, diff_hn + l * 128, lam, 1.f - lambda_init, gw, NGW, lane);
              else for (int r2_ = 0; r2_ < REPS(13); ++r2_) for (int i = 0; i < 4 * ((256 + G - 1) / G); ++i) { const int v = vcu + (i >> 2) * G; if (v >= 256) break;
                  const int bh = v >> 3, s = v & 7, k = i & 3; const int qb = (k == 0) ? 31 - s : (k == 1) ? 16 + s : (k == 2) ? 15 - s : s;
                  attn_unit(lds, PROJ, Y, rel_bias, diff_hn + l * 128, lam, 1.f - lambda_init, bh >> 3, bh & 7, qb, tid, lane, wave); } }
        }
        SEAM(pb + 1);
        if (!(NAIVE & 4) && PHM(3) && IN(pb + 2)) for (int rep_ = 0; rep_ < REPS(3); ++rep_) {
            const int tid = LTID();
            for (int gid = vcu * 512 + tid; gid < 32 * 4096; gid += G * 512) { const int bh = gid >> 12, i4 = gid & 4095; const float dec = __builtin_amdgcn_exp2f(128.f * kLog2Gamma[bh & 7]);
                f32x4 S = {0.f, 0.f, 0.f, 0.f};
                const GAS f32x4* kp = (const GAS f32x4*)(KV + (size_t)bh * 32 * 16384) + i4; GAS v2u* sp = (GAS v2u*)(SST + (size_t)bh * 32 * 16384) + i4;
#pragma unroll 4
                for (int c = 0; c < 31; ++c) { const f32x4 kv = kp[(size_t)c * 4096]; S = S * dec + kv; v2u w; w.x = pk2(S.x, S.y); w.y = pk2(S.z, S.w); sp[(size_t)(c + 1) * 4096] = w; } }
        }
        SEAM(pb + 2);
        if (!(NAIVE & 4) && PHM(4) && IN(pb + 3)) for (int rep_ = 0; rep_ < REPS(4); ++rep_) { const int tid = LTID(), lane = tid & 63; for (int u = vcu; u < 1024; u += G) retC_unit(lds, PROJ, ROT, SST, Y, u, tid, lane, wave); }
        SEAM(pb + 3);
        if (PHM(5) && IN(pb + 4)) for (int rep_ = 0; rep_ < REPS(5); ++rep_) {
            pg8::Gemm g{Y, WB + (size_t)l * DM * 3072, M, DM, 3072}; pg8::StaticOrder S; S.init(M, DM, G, bx);
            pg8::EpiWiden E{MRG, DM, PROJ + C_GATE, LDP};
            pg8::gemm_phase<pg8::EpiWiden, pg8::StaticOrder, GEMM_ALIGN, GEMM_SP2>(lds, g, S, E);
        }
        SEAM(pb + 4);
        if (PHM(6) && IN(pb + 5)) for (int rep_ = 0; rep_ < REPS(6); ++rep_) {
            pg8::Gemm g{MRG, WO + (size_t)l * DM * DM, M, DM, DM}; pg8::StaticOrder S; S.init(M, DM, G, bx);
            pg8::EpiSq E{MIX, DM, STAT};
            pg8::gemm_phase<pg8::EpiSq, pg8::StaticOrder, GEMM_ALIGN, GEMM_SP2>(lds, g, S, E);
        }
        if (gr_ + 1 < GREP1) xcd_barrier(bar);
        }
        SEAM(pb + 5);
        if (PHM(7) && IN(pb + 6)) {
            const int lane = LTID() & 63;
            for (int rep_ = REPS(7) - 1; rep_ >= 0; --rep_)
            for (int m = gw; m < M; m += NGW) resid_row(XN + (size_t)m * DM, MIX + (size_t)m * DM, STAT + (size_t)m * 32, g_post_mix + l * DM, rep_ ? KV + m : RS + m, (float*)nullptr, lane, rep_ ? MRG + (size_t)m * DM : (bf16*)nullptr);
        }
        SEAM(pb + 6);
        if (PHM(8) && IN(pb + 7)) for (int rep_ = 0; rep_ < REPS(8); ++rep_) {
            pg8::Gemm g{XN, WUP + (size_t)l * DFF * DM, M, DFF, DM}; pg8::StaticOrder S; S.init(M, DFF, G, bx);
            pg8::EpiRelu2 E{FF, DFF, RS};
            pg8::gemm_phase<pg8::EpiRelu2, pg8::StaticOrder, GEMM_ALIGN, GEMM_SP2>(lds, g, S, E);
        }
        SEAM(pb + 7);
        if (PHM(9) && IN(pb + 8)) for (int rep_ = 0; rep_ < REPS(9); ++rep_) {
            pg8::Gemm g{FF, WDN + (size_t)l * DM * DFF, M, DM, DFF}; pg8::StaticOrder S; S.init(M, DM, G, bx);
            pg8::EpiSq E{MIX, DM, STAT};
            pg8::gemm_phase<pg8::EpiSq, pg8::StaticOrder, GEMM_ALIGN, GEMM_SP2>(lds, g, S, E);
        }
        SEAM(pb + 8);
        if (PHM(10) && IN(pb + 9)) {
            const int lane = LTID() & 63;
            const bool lastl = (l == DEPTH - 1);
            for (int m = gw; m < M; m += NGW) resid_row(XN + (size_t)m * DM, MIX + (size_t)m * DM, STAT + (size_t)m * 32, g_post_mlp + l * DM, RS + m, lastl ? xres + (size_t)m * DM : (float*)nullptr, lane);
        }
        SEAM(pb + 9);
    }
#undef IN
#undef SEAM
}

extern "C" void kernel_launch(void* const* d_in, const int* in_sizes, int n_in, void* d_out, int out_size, void* d_ws, size_t ws_size, hipStream_t stream) {
    static int grid = 0;
    if (grid == 0) {
        if (n_in != 15 || in_sizes[0] != M * DM || out_size != M * DM || ws_size < WS_END) { fprintf(stderr, "kernel_launch: unexpected shapes / workspace (n_in %d, ws %zu, need %zu); nothing launched\n", n_in, ws_size, (size_t)WS_END); grid = -1; return; }
        int dev = 0, cus = 0, per_cu = 0;
        if (hipGetDevice(&dev) != hipSuccess || hipDeviceGetAttribute(&cus, hipDeviceAttributeMultiprocessorCount, dev) != hipSuccess) { grid = -1; return; }
        if (hipFuncSetAttribute((const void*)fwd, hipFuncAttributeMaxDynamicSharedMemorySize, LDS_BYTES) != hipSuccess) { fprintf(stderr, "kernel_launch: hipFuncSetAttribute failed\n"); grid = -1; return; }
        if (hipOccupancyMaxActiveBlocksPerMultiprocessor(&per_cu, (const void*)fwd, NWAVES * 64, LDS_BYTES) != hipSuccess || per_cu < 1) fprintf(stderr, "kernel_launch: note: occupancy query reports %d workgroups per CU\n", per_cu);
        (void)hipGetLastError();
        grid = cus;
    }
    if (grid < 0) return;
    if (hipMemsetAsync((char*)d_ws + WS_CTL, 0, CTL_ZERO_BYTES, stream) != hipSuccess) return;
    Args a{};
    for (int i = 0; i < 15; ++i) a.in[i] = (const float*)d_in[i];
    a.out = (float*)d_out; a.ws = (unsigned char*)d_ws;
    if (SINGLE_LAUNCH) {
        a.p_lo = 0; a.p_hi = NPH;
        hipLaunchKernelGGL(fwd, dim3(grid), dim3(NWAVES * 64), LDS_BYTES, stream, a);
    } else {
        for (int p = 0; p < NPH; ++p) { a.p_lo = p; a.p_hi = p + 1; hipLaunchKernelGGL(fwd, dim3(grid), dim3(NWAVES * 64), LDS_BYTES, stream, a); }
    }
    const hipError_t le = hipPeekAtLastError();
    if (le != hipSuccess) fprintf(stderr, "kernel_launch: launch failed: %s\n", hipGetErrorName(le));
}
```

```cpp
#include <hip/hip_runtime.h>
#include <cstdio>
#include <cstdint>
namespace pg8 {
#define PG8_LAS __attribute__((address_space(3)))
typedef unsigned short bf16_t;
typedef short bf16x8 __attribute__((ext_vector_type(8)));
typedef float f32x4 __attribute__((ext_vector_type(4)));
typedef unsigned u32x4 __attribute__((ext_vector_type(4)));
constexpr int BM = 256, BK = 64, HALF = 128, HTB = HALF * BK * 2  , STAGE_BYTES = 8 * HTB, NXCD = 8, WGM = 8;

__host__ __device__ __forceinline__ int lds_byte(int r, int c) { const int st = (r >> 4) * 2 + (c >> 5), rr = r & 15, cc = c & 31, ob = rr * 64 + cc * 2; return st * 1024 + (ob ^ (((ob >> 9) & 1) << 5)); }
__host__ __device__ __forceinline__ void stage_rc(int b, int& R, int& C) { const int st = b / 1024, sb = b % 1024, swz = sb ^ (((sb >> 9) & 1) << 5); R = (st >> 1) * 16 + swz / 64; C = (st & 1) * 32 + (swz % 64) / 2; }
__host__ __device__ __forceinline__ int perm32(int rho) { const int n = rho >> 4, i = rho & 15; return 8 * (i >> 2) + 4 * n + (i & 3); }

struct Unit { int pm, pn; };
struct Gemm { const bf16_t* A; const bf16_t* Bt; int M, N, K; };

struct StaticOrder {
    int nM, nN, nwg, G, c;
    __host__ __device__ void init(int M, int N, int G_, int c_) { nM = M / BM; nN = N / BM; nwg = nM * nN; G = G_; c = c_; }
    __host__ __device__ bool next(int i, Unit& u) const {
        const long L = (long)i * G + c; if (L >= nwg) return false;
        int wgid = (int)L; { const int q = nwg / NXCD, r = nwg % NXCD, xcd = wgid % NXCD, off = wgid / NXCD; wgid = (xcd < r ? xcd * (q + 1) : r * (q + 1) + (xcd - r) * q) + off; }
        const int nig = WGM * nN, gid = wgid / nig, fm = gid * WGM, gsz = (nM - fm) < WGM ? (nM - fm) : WGM;
        u.pm = fm + ((wgid % nig) % gsz); u.pn = (wgid % nig) / gsz; return true;
    }
    __device__ __forceinline__ void a_ready(const Unit&) const {}
    __device__ __forceinline__ void done(const Unit&) const {}
};

typedef float f32x2c __attribute__((ext_vector_type(2))); typedef __bf16 bf16x2c __attribute__((ext_vector_type(2)));
__device__ __forceinline__ unsigned cvt_pk_bf16(float lo, float hi) { f32x2c v = {lo, hi}; bf16x2c b = __builtin_convertvector(v, bf16x2c); return __builtin_bit_cast(unsigned, b); }
typedef float f32x2 __attribute__((ext_vector_type(2)));

template <class Epi, class Sched, bool ALIGN_EPI = false, bool SP2 = false>
__device__ __forceinline__ void gemm_phase(PG8_LAS unsigned char* lds, const Gemm g, const Sched& S, const Epi& E) {
    int tid_ = threadIdx.x; asm volatile("" : "+v"(tid_));
    const int tid = tid_, wid = __builtin_amdgcn_readfirstlane(tid >> 6), lane = tid & 63, wr = wid >> 2, wc = wid & 3, fr = lane & 15, fq = lane >> 4;
    const int K = g.K, nt = K / BK;
    unsigned voffA[2], voffB[2];
#pragma unroll
    for (int i = 0; i < 2; ++i) { int R, C; stage_rc(tid * 16 + i * 8192, R, C); const int Rb = Epi::PERM ? ((R & ~31) + perm32(R & 31)) : R;
        voffA[i] = (unsigned)(R * K + C) * 2u; voffB[i] = (unsigned)(Rb * K + C) * 2u; }
    const size_t kstep = (size_t)(BK * 2);
    const size_t hstep = (size_t)HALF * K * 2;
    const size_t tstep = 2 * hstep;
    const unsigned ldsw = (unsigned)wid * 1024u;
    const int aoff = lds_byte(wr * 64 + fr, fq * 8), boff = lds_byte(wc * 32 + fr, fq * 8);
#define PG8_SA(b, h) (((b) * 2 + (h)) * HTB)
#define PG8_SB(b, h) ((4 + (b) * 2 + (h)) * HTB)
#define PG8_STAGE(bufoff, gbase, voff) do { _Pragma("unroll") for (int _i = 0; _i < 2; ++_i) \
        __builtin_amdgcn_global_load_lds((const unsigned*)((const char*)(gbase) + (voff)[_i]), (PG8_LAS unsigned*)(lds + (bufoff) + ldsw + _i * 8192), 16, 0, 0); } while (0)
#define PG8_LDA(dst, b, h) do { _Pragma("unroll") for (int m = 0; m < 4; ++m) _Pragma("unroll") for (int k = 0; k < 2; ++k) dst[m][k] = *(const PG8_LAS bf16x8*)(lds + PG8_SA(b, h) + aoff + m * 2048 + k * 1024); } while (0)
#define PG8_LDB(dst, b, h) do { _Pragma("unroll") for (int n = 0; n < 2; ++n) _Pragma("unroll") for (int k = 0; k < 2; ++k) dst[n][k] = *(const PG8_LAS bf16x8*)(lds + PG8_SB(b, h) + boff + n * 2048 + k * 1024); } while (0)
#define PG8_MMA(ai, bj, At, Bt) do { __builtin_amdgcn_s_setprio(1); _Pragma("unroll") for (int m = 0; m < 4; ++m) _Pragma("unroll") for (int n = 0; n < 2; ++n) _Pragma("unroll") for (int k = 0; k < 2; ++k) \
        acc[ai][bj][m][n] = __builtin_amdgcn_mfma_f32_16x16x32_bf16(Bt[n][k], At[m][k], acc[ai][bj][m][n], 0, 0, 0); __builtin_amdgcn_s_setprio(0); } while (0)
#define PG8_WAIT_V(n) asm volatile("s_waitcnt vmcnt(" #n ")" ::: "memory")
#define PG8_WAIT_L(n) asm volatile("s_waitcnt lgkmcnt(" #n ")" ::: "memory")
#define PG8_BAR __builtin_amdgcn_s_barrier()
#define PG8_SCHED __builtin_amdgcn_sched_barrier(0)
    Unit cur, nxt; int ui = 0;
    if (!S.next(0, cur)) return;
    f32x4 acc[2][2][4][2];
#pragma unroll
    for (int a = 0; a < 2; ++a)
#pragma unroll
        for (int b = 0; b < 2; ++b)
#pragma unroll
            for (int m = 0; m < 4; ++m)
#pragma unroll
                for (int n = 0; n < 2; ++n) acc[a][b][m][n] = (f32x4){0.f, 0.f, 0.f, 0.f};
    bf16x8 At[4][2], B0[2][2], B1[2][2];
    const char* cA = (const char*)g.A + (size_t)cur.pm * tstep; const char* cB = (const char*)g.Bt + (size_t)cur.pn * tstep;
    S.a_ready(cur);
    if constexpr (SP2) {
        PG8_STAGE(PG8_SB(0, 0), cB, voffB); PG8_STAGE(PG8_SB(0, 1), cB + hstep, voffB); PG8_STAGE(PG8_SA(0, 0), cA, voffA); PG8_STAGE(PG8_SA(0, 1), cA + hstep, voffA);
        if (wr == 1) PG8_BAR;
        PG8_WAIT_V(2); PG8_BAR;
        PG8_STAGE(PG8_SB(1, 0), cB + kstep, voffB); PG8_STAGE(PG8_SA(1, 0), cA + kstep, voffA); PG8_STAGE(PG8_SB(1, 1), cB + hstep + kstep, voffB);
        PG8_WAIT_V(6); PG8_BAR;
    } else {
        PG8_STAGE(PG8_SB(0, 0), cB, voffB); PG8_STAGE(PG8_SA(0, 0), cA, voffA); PG8_STAGE(PG8_SB(0, 1), cB + hstep, voffB); PG8_STAGE(PG8_SA(0, 1), cA + hstep, voffA);
        if (wr == 1) PG8_BAR;
        PG8_WAIT_V(4); PG8_BAR;
        PG8_STAGE(PG8_SB(1, 0), cB + kstep, voffB); PG8_STAGE(PG8_SA(1, 0), cA + kstep, voffA); PG8_STAGE(PG8_SB(1, 1), cB + hstep + kstep, voffB);
        PG8_WAIT_V(6); PG8_BAR;
    }
    for (;;) {
        const bool has_next = S.next(ui + 1, nxt);
        const char* nA = has_next ? (const char*)g.A + (size_t)nxt.pm * tstep : cA; const char* nB = has_next ? (const char*)g.Bt + (size_t)nxt.pn * tstep : cB;
        for (int t = 0; t < nt; t += 2) {
            if constexpr (Epi::MID) { if (t == Epi::MID_T0 || t == Epi::MID_T1) E.mid(acc, cur, t, wr, wc, fr, fq); }
            const bool last = (t == nt - 2);
            const char* a1 = cA + (size_t)(t + 1) * kstep;
            const char* a2 = last ? nA : cA + (size_t)(t + 2) * kstep; const char* b2 = last ? nB : cB + (size_t)(t + 2) * kstep;
            const char* a3 = a2 + kstep; const char* b3 = b2 + kstep;
            if (last && has_next) S.a_ready(nxt);
            if constexpr (SP2) {
            PG8_LDB(B0, 0, 0); PG8_LDB(B1, 0, 1); PG8_SCHED; PG8_LDA(At, 0, 0); PG8_STAGE(PG8_SA(1, 1), a1 + hstep, voffA);
            PG8_WAIT_V(8); PG8_WAIT_L(0); PG8_BAR; PG8_MMA(0, 0, At, B0); PG8_MMA(0, 1, At, B1); PG8_BAR; PG8_SCHED;
            PG8_LDA(At, 0, 1); PG8_STAGE(PG8_SB(0, 0), b2, voffB); PG8_STAGE(PG8_SB(0, 1), b2 + hstep, voffB); PG8_STAGE(PG8_SA(0, 0), a2, voffA);
            PG8_WAIT_V(8); PG8_WAIT_L(0); PG8_BAR; PG8_MMA(1, 0, At, B0); PG8_MMA(1, 1, At, B1); PG8_BAR; PG8_SCHED;
            PG8_LDB(B0, 1, 0); PG8_LDB(B1, 1, 1); PG8_SCHED; PG8_LDA(At, 1, 0); PG8_STAGE(PG8_SA(0, 1), a2 + hstep, voffA);
            PG8_WAIT_V(8); PG8_WAIT_L(0); PG8_BAR; PG8_MMA(0, 0, At, B0); PG8_MMA(0, 1, At, B1); PG8_BAR; PG8_SCHED;
            PG8_LDA(At, 1, 1); PG8_STAGE(PG8_SB(1, 0), b3, voffB); PG8_STAGE(PG8_SB(1, 1), b3 + hstep, voffB); PG8_STAGE(PG8_SA(1, 0), a3, voffA);
            PG8_WAIT_V(8); PG8_WAIT_L(0); PG8_BAR; PG8_MMA(1, 0, At, B0); PG8_MMA(1, 1, At, B1); PG8_BAR; PG8_SCHED;
            } else {
            PG8_LDB(B0, 0, 0); PG8_SCHED; PG8_LDA(At, 0, 0); PG8_STAGE(PG8_SA(1, 1), a1 + hstep, voffA);
            PG8_WAIT_L(8); PG8_BAR; PG8_WAIT_L(0); PG8_MMA(0, 0, At, B0); PG8_BAR; PG8_SCHED;
            PG8_LDB(B1, 0, 1); PG8_STAGE(PG8_SB(0, 0), b2, voffB);
            PG8_BAR; PG8_WAIT_L(0); PG8_MMA(0, 1, At, B1); PG8_BAR;
            PG8_LDA(At, 0, 1); PG8_STAGE(PG8_SA(0, 0), a2, voffA);
            PG8_BAR; PG8_WAIT_L(0); PG8_MMA(1, 0, At, B0); PG8_BAR; PG8_SCHED;
            PG8_STAGE(PG8_SB(0, 1), b2 + hstep, voffB);
            PG8_WAIT_V(6); PG8_BAR; PG8_MMA(1, 1, At, B1); PG8_BAR;
            PG8_LDB(B0, 1, 0); PG8_SCHED; PG8_LDA(At, 1, 0); PG8_STAGE(PG8_SA(0, 1), a2 + hstep, voffA);
            PG8_WAIT_L(8); PG8_BAR; PG8_WAIT_L(0); PG8_MMA(0, 0, At, B0); PG8_BAR; PG8_SCHED;
            PG8_LDB(B1, 1, 1); PG8_STAGE(PG8_SB(1, 0), b3, voffB);
            PG8_BAR; PG8_WAIT_L(0); PG8_MMA(0, 1, At, B1); PG8_BAR;
            PG8_LDA(At, 1, 1); PG8_STAGE(PG8_SA(1, 0), a3, voffA);
            PG8_BAR; PG8_WAIT_L(0); PG8_MMA(1, 0, At, B0); PG8_BAR; PG8_SCHED;
            PG8_STAGE(PG8_SB(1, 1), b3 + hstep, voffB);
            PG8_WAIT_V(6); PG8_BAR; PG8_MMA(1, 1, At, B1); PG8_BAR;
            }
        }
        if constexpr (ALIGN_EPI) { if (wr == 0) PG8_BAR; }
        if constexpr (!Epi::AFTER_DRAIN) { E(acc, cur, wr, wc, fr, fq); S.done(cur); }
        if (!has_next) break;
#pragma unroll
        for (int a = 0; a < 2; ++a)
#pragma unroll
            for (int b = 0; b < 2; ++b)
#pragma unroll
                for (int m = 0; m < 4; ++m)
#pragma unroll
                    for (int n = 0; n < 2; ++n) acc[a][b][m][n] = (f32x4){0.f, 0.f, 0.f, 0.f};
        cur = nxt; cA = nA; cB = nB; ++ui;
        if constexpr (ALIGN_EPI) { if (wr == 1) PG8_BAR; }
    }
    PG8_WAIT_V(0);
    if constexpr (!ALIGN_EPI) { if (wr == 0) PG8_BAR; }
    PG8_BAR;
    if constexpr (Epi::AFTER_DRAIN) { E.fused(acc, cur, wr, wc, fr, fq, lds, wid, lane); S.done(cur); }
#undef PG8_SA
#undef PG8_SB
#undef PG8_STAGE
#undef PG8_LDA
#undef PG8_LDB
#undef PG8_MMA
#undef PG8_WAIT_V
#undef PG8_WAIT_L
#undef PG8_BAR
#undef PG8_SCHED
}
}
namespace pg8 {
__device__ __forceinline__ float sigm(float v) { return __builtin_amdgcn_rcpf(1.0f + __builtin_amdgcn_exp2f(-1.4426950408889634f * v)); }
struct EpiProj {
    static constexpr bool PERM = true, AFTER_DRAIN = false, MID = false; static constexpr int MID_T0 = -1, MID_T1 = -1;
    bf16_t* O; int ldc; float qscale; const float* rs;
    __device__ __forceinline__ void operator()(const f32x4 (&acc)[2][2][4][2], const Unit& u, int wr, int wc, int fr, int fq) const {
        const int row0 = u.pm * BM + wr * 64 + fr, col0 = u.pn * BM + wc * 32 + 8 * fq;
        const int mode = (u.pn >= 32) ? 3 : (u.pn >= 28 ? 2 : ((u.pn >= 4 && u.pn < 8) ? 1 : 0));
        const float sc = mode == 1 ? qscale : 1.f;
#pragma unroll
        for (int ai = 0; ai < 2; ++ai)
#pragma unroll
            for (int m = 0; m < 4; ++m) { bf16_t* rowp = O + (size_t)(row0 + ai * HALF + m * 16) * ldc + col0; const float rr = rs[row0 + ai * HALF + m * 16];
#pragma unroll
                for (int bj = 0; bj < 2; ++bj) { f32x4 v0 = acc[ai][bj][m][0] * rr, v1 = acc[ai][bj][m][1] * rr;
                    if (mode >= 2) {
#pragma unroll
                        for (int j = 0; j < 4; ++j) { const float s0 = sigm(v0[j]), s1 = sigm(v1[j]); v0[j] = mode == 3 ? s0 : v0[j] * s0; v1[j] = mode == 3 ? s1 : v1[j] * s1; }
                    } else { v0 = v0 * sc; v1 = v1 * sc; }
                    u32x4 w; w.x = cvt_pk_bf16(v0[0], v0[1]); w.y = cvt_pk_bf16(v0[2], v0[3]); w.z = cvt_pk_bf16(v1[0], v1[1]); w.w = cvt_pk_bf16(v1[2], v1[3]);
                    *(u32x4*)(rowp + bj * HALF) = w; } }
    }
};
struct EpiRelu2 {
    static constexpr bool PERM = true, AFTER_DRAIN = false, MID = false; static constexpr int MID_T0 = -1, MID_T1 = -1;
    bf16_t* O; int ldc; const float* rs;
    __device__ __forceinline__ void operator()(const f32x4 (&acc)[2][2][4][2], const Unit& u, int wr, int wc, int fr, int fq) const {
        const int row0 = u.pm * BM + wr * 64 + fr, col0 = u.pn * BM + wc * 32 + 8 * fq;
#pragma unroll
        for (int ai = 0; ai < 2; ++ai)
#pragma unroll
            for (int m = 0; m < 4; ++m) { bf16_t* rowp = O + (size_t)(row0 + ai * HALF + m * 16) * ldc + col0; const float rr = rs[row0 + ai * HALF + m * 16];
#pragma unroll
                for (int bj = 0; bj < 2; ++bj) { f32x4 v0 = acc[ai][bj][m][0], v1 = acc[ai][bj][m][1];
#pragma unroll
                    for (int j = 0; j < 4; ++j) { const float a = __builtin_fmaxf(v0[j], 0.f) * rr, b = __builtin_fmaxf(v1[j], 0.f) * rr; v0[j] = a * a; v1[j] = b * b; }
                    u32x4 w; w.x = cvt_pk_bf16(v0[0], v0[1]); w.y = cvt_pk_bf16(v0[2], v0[3]); w.z = cvt_pk_bf16(v1[0], v1[1]); w.w = cvt_pk_bf16(v1[2], v1[3]);
                    *(u32x4*)(rowp + bj * HALF) = w; } }
    }
};
struct EpiSq {
    static constexpr bool PERM = true, AFTER_DRAIN = false, MID = false; static constexpr int MID_T0 = -1, MID_T1 = -1;
    bf16_t* O; int ldc; float* part;
    __device__ __forceinline__ void operator()(const f32x4 (&acc)[2][2][4][2], const Unit& u, int wr, int wc, int fr, int fq) const {
        const int row0 = u.pm * BM + wr * 64 + fr, col0 = u.pn * BM + wc * 32 + 8 * fq;
#pragma unroll
        for (int ai = 0; ai < 2; ++ai)
#pragma unroll
            for (int m = 0; m < 4; ++m) { const int row = row0 + ai * HALF + m * 16; bf16_t* rowp = O + (size_t)row * ldc + col0; float ss = 0.f;
#pragma unroll
                for (int bj = 0; bj < 2; ++bj) { const f32x4 v0 = acc[ai][bj][m][0], v1 = acc[ai][bj][m][1];
                    ss += (v0[0] * v0[0] + v0[1] * v0[1]) + (v0[2] * v0[2] + v0[3] * v0[3]) + (v1[0] * v1[0] + v1[1] * v1[1]) + (v1[2] * v1[2] + v1[3] * v1[3]);
                    u32x4 w; w.x = cvt_pk_bf16(v0[0], v0[1]); w.y = cvt_pk_bf16(v0[2], v0[3]); w.z = cvt_pk_bf16(v1[0], v1[1]); w.w = cvt_pk_bf16(v1[2], v1[3]);
                    *(u32x4*)(rowp + bj * HALF) = w; }
                ss += __shfl_xor(ss, 16); ss += __shfl_xor(ss, 32);
                if (fq == 0) part[(size_t)row * 32 + u.pn * 4 + wc] = ss; }
    }
};
struct EpiWiden {
    static constexpr bool PERM = true, AFTER_DRAIN = false, MID = true; static constexpr int MID_T0 = 16, MID_T1 = 32;
    bf16_t* O; int ldc; const bf16_t* G; int ldg;
    __device__ __forceinline__ void mid(f32x4 (&acc)[2][2][4][2], const Unit& u, int t, int wr, int wc, int fr, int fq) const {
        const int row0 = u.pm * BM + wr * 64 + fr, col0 = u.pn * BM + wc * 32 + 8 * fq;
        const bf16_t* gp = G + (t == MID_T0 ? 0 : 2048) + col0 + (size_t)row0 * ldg;
#pragma unroll
        for (int ai = 0; ai < 2; ++ai)
#pragma unroll
            for (int m = 0; m < 4; ++m) {
#pragma unroll
                for (int bj = 0; bj < 2; ++bj) { const bf16_t* p = gp + (size_t)(ai * HALF + m * 16) * ldg + bj * HALF; const u32x4 ga = *(const u32x4*)p, gb = *(const u32x4*)(p + 2048);
#pragma unroll
                    for (int k = 0; k < 4; ++k) { const float a0 = __builtin_bit_cast(float, ga[k] << 16), a1 = __builtin_bit_cast(float, ga[k] & 0xffff0000u);
                        const float b0 = __builtin_fmaxf(__builtin_bit_cast(float, gb[k] << 16), 1e-30f), b1 = __builtin_fmaxf(__builtin_bit_cast(float, gb[k] & 0xffff0000u), 1e-30f);
                        const float r0 = a0 * __builtin_amdgcn_rcpf(b0), r1 = a1 * __builtin_amdgcn_rcpf(b1);
                        acc[ai][bj][m][k >> 1][(k & 1) * 2] *= r0; acc[ai][bj][m][k >> 1][(k & 1) * 2 + 1] *= r1; }
                    asm volatile("" : "+v"(acc[ai][bj][m][0]), "+v"(acc[ai][bj][m][1]) :: "memory"); } }
    }
    __device__ __forceinline__ void operator()(const f32x4 (&acc)[2][2][4][2], const Unit& u, int wr, int wc, int fr, int fq) const {
        const int row0 = u.pm * BM + wr * 64 + fr, col0 = u.pn * BM + wc * 32 + 8 * fq;
        const bf16_t* Gc = G + 4096 + col0;
#pragma unroll
        for (int ai = 0; ai < 2; ++ai)
#pragma unroll
            for (int m = 0; m < 4; ++m) { const size_t ro = (size_t)(row0 + ai * HALF + m * 16) * ldg; bf16_t* rowp = O + (size_t)(row0 + ai * HALF + m * 16) * ldc + col0;
#pragma unroll
                for (int bj = 0; bj < 2; ++bj) { const u32x4 gc = *(const u32x4*)(Gc + ro + bj * HALF); f32x4 v0 = acc[ai][bj][m][0], v1 = acc[ai][bj][m][1];
                    v0[0] *= __builtin_bit_cast(float, gc[0] << 16); v0[1] *= __builtin_bit_cast(float, gc[0] & 0xffff0000u); v0[2] *= __builtin_bit_cast(float, gc[1] << 16); v0[3] *= __builtin_bit_cast(float, gc[1] & 0xffff0000u);
                    v1[0] *= __builtin_bit_cast(float, gc[2] << 16); v1[1] *= __builtin_bit_cast(float, gc[2] & 0xffff0000u); v1[2] *= __builtin_bit_cast(float, gc[3] << 16); v1[3] *= __builtin_bit_cast(float, gc[3] & 0xffff0000u);
                    u32x4 w; w.x = cvt_pk_bf16(v0[0], v0[1]); w.y = cvt_pk_bf16(v0[2], v0[3]); w.z = cvt_pk_bf16(v1[0], v1[1]); w.w = cvt_pk_bf16(v1[2], v1[3]);
                    *(u32x4*)(rowp + bj * HALF) = w; } }
    }
};
}
#define DUPMASK 0
#ifndef GEMM_ALIGN
#define GEMM_ALIGN true
#endif
#ifndef GEMM_SP2
#define GEMM_SP2 true
#endif
constexpr int NWAVES = 8;
constexpr bool SINGLE_LAUNCH = 1;
constexpr int BATCH = 4, SEQ = 4096, DM = 2048, DEPTH = 4, MIXW = 1024, M = BATCH * SEQ, INC = 14336, DFF = 8192;
constexpr int LDP = INC;
constexpr int C_POOL = 0, C_QD = 1024, C_KD = 2048, C_VD = 3072, C_QR = 4096, C_KR = 5120, C_VR = 6144, C_GR = 7168, C_GATE = 8192;
constexpr int LDY = 3072;
constexpr float NORM_EPS = 1e-6f;
constexpr float LOG2E = 1.4426950408889634f;
constexpr float QSCALE = 0.125f * 1.4426950408889634f;
constexpr float RET_KSCALE = 0.08838834764831845f;

constexpr size_t MiB = 1u << 20;
constexpr size_t WS_CTL = 0, CTL_ZERO_BYTES = 1 * MiB;
constexpr size_t WS_ROT = 1 * MiB;
constexpr size_t WS_STAT = 3 * MiB;
constexpr size_t WS_POOLT = 5 * MiB;
constexpr size_t WS_RS = 7 * MiB;
constexpr size_t WS_WIN = 8 * MiB;
constexpr size_t WS_WB = WS_WIN + 224 * MiB;
constexpr size_t WS_WO = WS_WB + 48 * MiB;
constexpr size_t WS_WUP = WS_WO + 32 * MiB;
constexpr size_t WS_WDN = WS_WUP + 128 * MiB;
constexpr size_t WS_XN = WS_WDN + 128 * MiB;
constexpr size_t WS_MRG = WS_XN + 64 * MiB;
constexpr size_t WS_MIX = WS_MRG + 64 * MiB;
constexpr size_t WS_Y = WS_MIX + 64 * MiB;
constexpr size_t WS_KV = WS_Y + 96 * MiB;
constexpr size_t WS_SST = WS_KV + 64 * MiB;
constexpr size_t WS_PROJ = WS_SST + 32 * MiB;
constexpr size_t WS_END = WS_PROJ + 448 * MiB;

constexpr int CW_BAR = 4096;

constexpr int RING_BYTES = 131072;
constexpr int LDSCTL_OFF = 135168, MISC_OFF = LDSCTL_OFF + 320;
constexpr int LDS_BYTES = 147456;

#define GAS __attribute__((address_space(1)))
#define LAS __attribute__((address_space(3)))
typedef unsigned short bf16;
typedef unsigned v4u __attribute__((ext_vector_type(4)));
typedef unsigned v2u __attribute__((ext_vector_type(2)));
typedef float f32x4 __attribute__((ext_vector_type(4)));
typedef float f32x2 __attribute__((ext_vector_type(2)));
typedef float f32x16 __attribute__((ext_vector_type(16)));
typedef short bf16x8 __attribute__((ext_vector_type(8)));
typedef short s16x4 __attribute__((ext_vector_type(4)));
typedef GAS unsigned gu32;
#define RLX_AGENT __ATOMIC_RELAXED, __HIP_MEMORY_SCOPE_AGENT
#define LDS_WAIT() asm volatile("s_waitcnt lgkmcnt(0)" ::: "memory")
#define VM_WAIT() asm volatile("s_waitcnt vmcnt(0)" ::: "memory")
#define WG_BAR() do { asm volatile("s_waitcnt vmcnt(0) lgkmcnt(0)" ::: "memory"); __builtin_amdgcn_s_barrier(); asm volatile("" ::: "memory"); } while (0)

typedef float f32x2_t_ __attribute__((ext_vector_type(2))); typedef __bf16 bf16x2_t_ __attribute__((ext_vector_type(2)));
__device__ __forceinline__ unsigned pk2(float lo, float hi) { f32x2_t_ v = {lo, hi}; bf16x2_t_ b = __builtin_convertvector(v, bf16x2_t_); return __builtin_bit_cast(unsigned, b); }
__device__ __forceinline__ float bflo(unsigned w) { return __builtin_bit_cast(float, w << 16); }
__device__ __forceinline__ float bfhi(unsigned w) { return __builtin_bit_cast(float, w & 0xffff0000u); }
__device__ __forceinline__ float wave_sum(float v) {
#pragma unroll
    for (int o = 1; o < 64; o <<= 1) v += __shfl_xor(v, o);
    return v;
}
__device__ __forceinline__ void half_swap(unsigned& a, unsigned& b) { asm volatile("s_nop 1\n\tv_permlane32_swap_b32 %0, %1\n\ts_nop 1" : "+v"(a), "+v"(b)); }
__device__ __forceinline__ float half_swap_max(float m) { unsigned a = __builtin_bit_cast(unsigned, m), b = a; half_swap(a, b); return __builtin_fmaxf(__builtin_bit_cast(float, a), __builtin_bit_cast(float, b)); }
__device__ __forceinline__ float half_swap_sum(float m) { unsigned a = __builtin_bit_cast(unsigned, m), b = a; half_swap(a, b); return __builtin_bit_cast(float, a) + __builtin_bit_cast(float, b); }
__device__ __forceinline__ int crow(int r, int hi) { return (r & 3) + 8 * (r >> 2) + 4 * hi; }
__device__ __forceinline__ int swap23(int i) { return (i & 0x13) | ((i & 4) << 1) | ((i & 8) >> 1); }
__device__ __forceinline__ unsigned offb(int row, int ch) { return 256u * (unsigned)row + 16u * (unsigned)(ch ^ (((row & 3) << 2) | ((row >> 2) & 3))); }
__device__ __forceinline__ unsigned tr_off(int lane, int c, int t) { const int h = lane >> 5, blk = (lane >> 4) & 1, q = (lane & 15) >> 2, p = lane & 3; return offb(8 * h + 4 * t + q, 4 * c + 2 * blk + (p >> 1)) + 8u * (unsigned)(p & 1); }
typedef short v4i16_t __attribute__((ext_vector_type(4)));
__device__ __forceinline__ s16x4 ldtr(LAS unsigned char* p) { return __builtin_bit_cast(s16x4, __builtin_amdgcn_ds_read_tr16_b64_v4i16((LAS v4i16_t*)p)); }
__device__ __forceinline__ bf16x8 trfrag(LAS unsigned char* tile, unsigned o0, unsigned o1) { const s16x4 a = ldtr(tile + o0), b = ldtr(tile + o1); return (bf16x8){a[0], a[1], a[2], a[3], b[0], b[1], b[2], b[3]}; }
__device__ __forceinline__ void glds16(const void* gsrc, LAS unsigned char* dst) { __builtin_amdgcn_global_load_lds((const unsigned*)gsrc, (LAS unsigned*)dst, 16, 0, 0); }
__device__ __forceinline__ void glds16_asm(const void* gsrc, LAS unsigned char* dst) { unsigned keep; const unsigned d = (unsigned)__builtin_amdgcn_readfirstlane((int)(unsigned)(size_t)dst);
    asm volatile("s_mov_b32 %0, m0\n\ts_mov_b32 m0, %2\n\ts_nop 0\n\tglobal_load_lds_dwordx4 %1, off\n\ts_mov_b32 m0, %0" : "=&s"(keep) : "v"(gsrc), "s"(d) : "memory"); }
__device__ __forceinline__ f32x16 splat16(float v) { f32x16 r;
#pragma unroll
    for (int i = 0; i < 16; ++i) r[i] = v; return r; }
#define MFMA32(a, b, c) __builtin_amdgcn_mfma_f32_32x32x16_bf16((a), (b), (c), 0, 0, 0)

__device__ __constant__ const float kLog2Gamma[8] = {-0.04580368961312479f, -0.02272007650008353f, -0.011315313227834146f, -0.005646563141142063f, -0.0028205190623786626f, -0.0014095702546713536f, -0.0007046129765893727f, -0.0003522634716290214f};
__device__ __forceinline__ int t5_bucket(int n) {
    if (n < 16) return n;
    if (n >= 113) return 31;
    int b = 16;
    b += (n >= 19); b += (n >= 21); b += (n >= 24); b += (n >= 27); b += (n >= 31); b += (n >= 35); b += (n >= 40); b += (n >= 46);
    b += (n >= 52); b += (n >= 59); b += (n >= 67); b += (n >= 77); b += (n >= 87); b += (n >= 99);
    return b;
}

__device__ __forceinline__ void p0_transpose_item(const float* W, int N, bf16* WT, int ldt, int koff, LAS float* scr, int item, int lane, const float* gain = nullptr) {
    const int nblk = N / 32, kb = item / nblk, nb = item % nblk, k0 = 64 * kb, n0 = 32 * nb;
#pragma unroll 8
    for (int i = 0; i < 32; ++i) { const int kk = 2 * i + (lane >> 5); scr[kk * 33 + (lane & 31)] = W[(size_t)(k0 + kk) * N + n0 + (lane & 31)]; }
    LDS_WAIT(); asm volatile("" ::: "memory");
    const int c = lane & 7;
    f32x4 ga = {1.f, 1.f, 1.f, 1.f}, gb = ga; if (gain) { ga = *(const GAS f32x4*)(gain + k0 + 8 * c); gb = *(const GAS f32x4*)(gain + k0 + 8 * c + 4); }
#pragma unroll
    for (int j = 0; j < 4; ++j) { const int n = (lane >> 3) + 8 * j; const LAS float* s = scr + (8 * c) * 33 + n;
        v4u o; o.x = pk2(s[0 * 33] * ga.x, s[1 * 33] * ga.y); o.y = pk2(s[2 * 33] * ga.z, s[3 * 33] * ga.w); o.z = pk2(s[4 * 33] * gb.x, s[5 * 33] * gb.y); o.w = pk2(s[6 * 33] * gb.z, s[7 * 33] * gb.w);
        *(GAS v4u*)(WT + (size_t)(n0 + n) * ldt + koff + k0 + 8 * c) = o; }
    LDS_WAIT(); asm volatile("" ::: "memory");
}
__device__ __forceinline__ void prep_row(const float* xrow, bf16* orow, float* rs, int lane) {
    const GAS f32x4* xr = (const GAS f32x4*)xrow + lane;
    f32x4 v[8]; float s = 0.f;
#pragma unroll
    for (int j = 0; j < 8; ++j) { v[j] = xr[64 * j]; s += (v[j].x * v[j].x + v[j].y * v[j].y) + (v[j].z * v[j].z + v[j].w * v[j].w); }
    s = wave_sum(s);
    GAS v2u* o8 = (GAS v2u*)orow + lane;
#pragma unroll
    for (int j = 0; j < 8; ++j) { v2u w; w.x = pk2(v[j].x, v[j].y); w.y = pk2(v[j].z, v[j].w); o8[64 * j] = w; }
    if (lane == 0) *rs = 1.f / sqrtf(s * (1.f / DM) + NORM_EPS);
}
__device__ __forceinline__ void resid_row(bf16* xrow, const bf16* yrow, const float* part, const float* gpost, float* rs, float* fout, int lane, bf16* xdst = nullptr) {
    GAS v2u* xr = (GAS v2u*)xrow + lane; GAS v2u* xw = xdst ? (GAS v2u*)xdst + lane : xr; const GAS v2u* yr = (const GAS v2u*)yrow + lane; const GAS f32x4* gp = (const GAS f32x4*)gpost + lane;
    float ps = (lane < 32) ? part[lane] : 0.f; ps = wave_sum(ps);
    const float rs1 = 1.f / sqrtf(ps * (1.f / DM) + NORM_EPS);
    f32x4 v[8]; float s = 0.f;
#pragma unroll
    for (int j = 0; j < 8; ++j) { const v2u x = xr[64 * j]; const v2u y = yr[64 * j]; const f32x4 g = gp[64 * j];
        v[j].x = bflo(x.x) + bflo(y.x) * rs1 * g.x; v[j].y = bfhi(x.x) + bfhi(y.x) * rs1 * g.y; v[j].z = bflo(x.y) + bflo(y.y) * rs1 * g.z; v[j].w = bfhi(x.y) + bfhi(y.y) * rs1 * g.w;
        s += (v[j].x * v[j].x + v[j].y * v[j].y) + (v[j].z * v[j].z + v[j].w * v[j].w); }
    if (fout) { GAS f32x4* xo = (GAS f32x4*)fout + lane;
#pragma unroll
        for (int j = 0; j < 8; ++j) xo[64 * j] = v[j]; }
    else { s = wave_sum(s);
#pragma unroll
        for (int j = 0; j < 8; ++j) { v2u w; w.x = pk2(v[j].x, v[j].y); w.y = pk2(v[j].z, v[j].w); xw[64 * j] = w; }
        if (lane == 0) *rs = 1.f / sqrtf(s * (1.f / DM) + NORM_EPS); }
}

__device__ __forceinline__ void pool_unit(LAS unsigned char* lds, const bf16* proj, const bf16* poolT, const float* pscale, bf16* Y, int tb, int g, int tid, int lane, int wid) {
    asm volatile("" : "+v"(tid)); lane = tid & 63;
    const int win = 2 << g, hi = lane >> 5, r32 = lane & 31;
    const int t0 = tb * 128;
    bf16x8 bfr[16];
    { const bf16* bp = poolT + ((size_t)g * 256 + 32 * wid + r32) * 256 + 8 * hi;
#pragma unroll
      for (int s = 0; s < 16; ++s) bfr[s] = *(const GAS bf16x8*)(bp + 16 * s); }
    { const int cc = tid & 31, tsb = tid >> 5;
      const bf16* up = proj + (size_t)t0 * LDP + C_POOL + g * 256 + cc * 8;
      const int pos0 = (t0 & (SEQ - 1)) + tsb * 8;
      float aw[8];
#pragma unroll
      for (int e = 0; e < 8; ++e) aw[e] = 0.f;
      for (int j = 1; j < win; ++j) { if (pos0 - j >= 0) { const v4u w = *(const GAS v4u*)(up + (long)(tsb * 8 - j) * LDP);
          aw[0] += bflo(w.x); aw[1] += bfhi(w.x); aw[2] += bflo(w.y); aw[3] += bfhi(w.y); aw[4] += bflo(w.z); aw[5] += bfhi(w.z); aw[6] += bflo(w.w); aw[7] += bfhi(w.w); } }
#pragma unroll
      for (int tt = 0; tt < 8; ++tt) {
          const int pos = pos0 + tt; const v4u w = *(const GAS v4u*)(up + (long)(tsb * 8 + tt) * LDP);
          float cu[8] = {bflo(w.x), bfhi(w.x), bflo(w.y), bfhi(w.y), bflo(w.z), bfhi(w.z), bflo(w.w), bfhi(w.w)};
#pragma unroll
          for (int e = 0; e < 8; ++e) aw[e] += cu[e];
          const float inv = 1.f / (float)(pos + 1 < win ? pos + 1 : win);
          v4u o; o.x = pk2(aw[0] * inv - cu[0], aw[1] * inv - cu[1]); o.y = pk2(aw[2] * inv - cu[2], aw[3] * inv - cu[3]); o.z = pk2(aw[4] * inv - cu[4], aw[5] * inv - cu[5]); o.w = pk2(aw[6] * inv - cu[6], aw[7] * inv - cu[7]);
          *(LAS v4u*)(lds + cc * 2048 + (tsb * 8 + tt) * 16) = o;
          if (pos - (win - 1) >= 0) { const v4u z = *(const GAS v4u*)(up + (long)(tsb * 8 + tt - (win - 1)) * LDP);
              aw[0] -= bflo(z.x); aw[1] -= bfhi(z.x); aw[2] -= bflo(z.y); aw[3] -= bfhi(z.y); aw[4] -= bflo(z.z); aw[5] -= bfhi(z.z); aw[6] -= bflo(z.w); aw[7] -= bfhi(z.w); }
      } }
    WG_BAR();
    f32x16 acc[4];
#pragma unroll
    for (int k = 0; k < 4; ++k) acc[k] = splat16(0.f);
#pragma unroll
    for (int s = 0; s < 16; ++s)
#pragma unroll
        for (int k = 0; k < 4; ++k) { const bf16x8 a = *(const LAS bf16x8*)(lds + (2 * s + hi) * 2048 + (32 * k + r32) * 16); acc[k] = MFMA32(a, bfr[s], acc[k]); }
    const int oc = g * 256 + 32 * wid + r32; const float ps = pscale[oc];
#pragma unroll
    for (int k = 0; k < 4; ++k)
#pragma unroll
        for (int r = 0; r < 16; ++r) { const int tok = 32 * k + crow(r, hi); Y[(size_t)(t0 + tok) * LDY + oc] = (bf16)(pk2(acc[k][r] * ps, 0.f) & 0xffffu); }
    WG_BAR();
}

#ifndef ATT_UNROLL2
#define ATT_UNROLL2 0
#endif
__device__ __forceinline__ void attn_unit(LAS unsigned char* lds, const bf16* proj, bf16* Y, const float* relb, const float* hgain, float lam, float oscale, int b, int h, int qb, int tid, int lane, int wid) {
    asm volatile("" : "+v"(tid)); lane = tid & 63;
    const int r32 = lane & 31, hi = lane >> 5, mp = wid >> 2, wq = wid & 3;
    const int q0 = qb * 128, qw = q0 + 32 * wq;
    const size_t rowbase = (size_t)b * SEQ;
    LAS float* tab = (LAS float*)(lds + 98304);
    if (tid < 129) tab[tid] = relb[t5_bucket(tid) * 8 + h] * LOG2E;
    const float bias31 = relb[31 * 8 + h] * LOG2E;
    LAS unsigned char* qlds = lds + 100352 + wid * 4096 + hi * 512 + r32 * 16;
    { const bf16* qp = proj + (rowbase + qw + r32) * LDP + C_QD + h * 128 + mp * 64 + hi * 8;
#pragma unroll
      for (int d0 = 0; d0 < 4; ++d0) *(LAS bf16x8*)(qlds + d0 * 1024) = *(const GAS bf16x8*)(qp + d0 * 16); }
    const bf16* k0src = proj + (rowbase + (lane & 32) + swap23(r32)) * LDP + C_KD + h * 128 + wid * 8;
    const bf16* k1src = k0src + 64;
    const bf16* vsrc[2];
#pragma unroll
    for (int i = 0; i < 2; ++i) { const int vrow = 8 * wid + 4 * i + (lane >> 4); const int ch = (lane & 15) ^ (((vrow & 3) << 2) | ((vrow >> 2) & 3)); vsrc[i] = proj + (rowbase + vrow) * LDP + C_VD + h * 128 + ch * 8; }
#define ATT_DMA(t, sb_) do { const size_t ko_ = (size_t)(t) * 64 * LDP; \
        glds16_asm(k0src + ko_, (sb_) + wid * 1024); glds16_asm(k1src + ko_, (sb_) + 8192 + wid * 1024); glds16_asm(vsrc[0] + ko_, (sb_) + 16384 + wid * 2048); glds16_asm(vsrc[1] + ko_, (sb_) + 16384 + wid * 2048 + 1024); } while (0)
    unsigned va[4][2];
#pragma unroll
    for (int c = 0; c < 4; ++c) { va[c][0] = 16384u + tr_off(lane, c, 0); va[c][1] = 16384u + tr_off(lane, c, 1); }
    const unsigned kboff = mp * 8192 + hi * 1024 + r32 * 16;
    const int NT = 2 * qb + 2;
    ATT_DMA(0, lds); ATT_DMA(1, lds + 32768);
    float m_run = -1e30f, l_run = 0.f;
    f32x16 o[4];
#pragma unroll
    for (int c = 0; c < 4; ++c) o[c] = splat16(0.f);
    const int qi = qw + r32;
#define ATT_QK(S0, S1, sbp, cin) do { S0 = splat16(cin); S1 = S0; \
        _Pragma("unroll") for (int d0 = 0; d0 < 4; ++d0) { const bf16x8 kf0_ = *(const LAS bf16x8*)((sbp) + kboff + d0 * 2048), kf1_ = *(const LAS bf16x8*)((sbp) + kboff + d0 * 2048 + 512), q_ = *(const LAS bf16x8*)(qlds + d0 * 1024); \
            S0 = MFMA32(kf0_, q_, S0); S1 = MFMA32(kf1_, q_, S1); } } while (0)
    WG_BAR();
    f32x16 sA0, sA1, sB0, sB1;
    typedef __bf16 bf2_t_ __attribute__((ext_vector_type(2)));
    const bf2_t_ one2 = __builtin_bit_cast(bf2_t_, 0x3F803F80u);
    { const bool far0 = (63 + 128 <= qw); ATT_QK(sA0, sA1, lds, far0 ? bias31 : 0.f);
      if (!far0) {
#pragma unroll
          for (int r = 0; r < 16; ++r) { const int key = 16 * (r >> 3) + 8 * hi + (r & 7); const int d0_ = qi - key, d1_ = d0_ - 32;
              const float b0 = tab[d0_ < 0 ? 0 : (d0_ > 128 ? 128 : d0_)], b1 = tab[d1_ < 0 ? 0 : (d1_ > 128 ? 128 : d1_)];
              sA0[r] = d0_ < 0 ? -1e30f : sA0[r] + b0; sA1[r] = d1_ < 0 ? -1e30f : sA1[r] + b1; } }
      float mt = __builtin_fmaxf(sA0[0], sA1[0]);
#pragma unroll
      for (int r = 1; r < 16; ++r) mt = __builtin_fmaxf(mt, __builtin_fmaxf(sA0[r], sA1[r]));
      mt = half_swap_max(mt); m_run = mt;
#pragma unroll
      for (int r = 0; r < 16; ++r) { sA0[r] -= mt; sA1[r] -= mt; } }
    int sc = 0, sn = 32768, sn2 = 65536;
#define SB() __builtin_amdgcn_sched_barrier(0)
#define EX2(P, i) do { P[i] = __builtin_amdgcn_exp2f(P[i]); P[(i) + 1] = __builtin_amdgcn_exp2f(P[(i) + 1]); } while (0)
#define MX4(P, i) __builtin_fmaxf(__builtin_fmaxf(P[i], P[(i) + 1]), __builtin_fmaxf(P[(i) + 2], P[(i) + 3]))
#define PK8(P, i) ({ v4u w_; w_.x = pk2(P[i], P[(i) + 1]); w_.y = pk2(P[(i) + 2], P[(i) + 3]); w_.z = pk2(P[(i) + 4], P[(i) + 5]); w_.w = pk2(P[(i) + 6], P[(i) + 7]); __builtin_bit_cast(bf16x8, w_); })
#define VRD(dst, ks) do { _Pragma("unroll") for (int c_ = 0; c_ < 4; ++c_) dst[c_] = trfrag(sb, va[c_][0] + 4096u * (ks), va[c_][1] + 4096u * (ks)); } while (0)
#define PVM(vf_, pk_) do { _Pragma("unroll") for (int c_ = 0; c_ < 4; ++c_) o[c_] = MFMA32(vf_[c_], pk_, o[c_]); } while (0)
#define DSUM(pk_) do { } while (0)
#define ATT_TILE(P0, P1, N0, N1, T) do { \
        if ((T) + 2 < NT) ATT_DMA((T) + 2, lds + sn2); \
        const int k0 = 64 * (T); \
        if (k0 <= qw + 31) { \
            LAS unsigned char* sb = lds + sc; LAS unsigned char* sbn = lds + sn; \
            if ((T) > 0 && !(k0 + 63 + 128 <= qw)) { \
                _Pragma("unroll") for (int r = 0; r < 16; ++r) { const int key = k0 + 16 * (r >> 3) + 8 * hi + (r & 7); const int d0_ = qi - key, d1_ = d0_ - 32; \
                    const float b0 = tab[d0_ < 0 ? 0 : (d0_ > 128 ? 128 : d0_)], b1 = tab[d1_ < 0 ? 0 : (d1_ > 128 ? 128 : d1_)]; \
                    P0[r] = d0_ < 0 ? -1e30f : P0[r] + b0; P1[r] = d1_ < 0 ? -1e30f : P1[r] + b1; } } \
            const bool farn = (k0 + 64 + 63 + 128 <= qw); const float cin = (farn ? bias31 : 0.f) - m_run; \
            N0 = splat16(cin); N1 = N0; bf16x8 kf[4], qf[2], vfA[4], vfB[4], pw0, pw1, pw2, pw3; \
            SB(); \
            _Pragma("unroll") for (int d0 = 0; d0 < 2; ++d0) { kf[2 * d0] = *(const LAS bf16x8*)(sbn + kboff + d0 * 2048); kf[2 * d0 + 1] = *(const LAS bf16x8*)(sbn + kboff + d0 * 2048 + 512); qf[d0] = *(const LAS bf16x8*)(qlds + d0 * 1024); } \
            SB(); \
            N0 = MFMA32(kf[0], qf[0], N0); EX2(P0, 0); EX2(P0, 2); SB(); \
            N1 = MFMA32(kf[1], qf[0], N1); EX2(P0, 4); EX2(P0, 6); SB(); \
            N0 = MFMA32(kf[2], qf[1], N0); EX2(P0, 8); EX2(P0, 10); SB(); \
            N1 = MFMA32(kf[3], qf[1], N1); EX2(P0, 12); EX2(P0, 14); SB(); \
            _Pragma("unroll") for (int d0 = 0; d0 < 2; ++d0) { kf[2 * d0] = *(const LAS bf16x8*)(sbn + kboff + (d0 + 2) * 2048); kf[2 * d0 + 1] = *(const LAS bf16x8*)(sbn + kboff + (d0 + 2) * 2048 + 512); qf[d0] = *(const LAS bf16x8*)(qlds + (d0 + 2) * 1024); } \
            EX2(P1, 0); EX2(P1, 2); SB(); \
            N0 = MFMA32(kf[0], qf[0], N0); EX2(P1, 4); EX2(P1, 6); SB(); \
            N1 = MFMA32(kf[1], qf[0], N1); EX2(P1, 8); EX2(P1, 10); SB(); \
            N0 = MFMA32(kf[2], qf[1], N0); EX2(P1, 12); EX2(P1, 14); SB(); \
            N1 = MFMA32(kf[3], qf[1], N1); VRD(vfA, 0); VRD(vfB, 1); SB(); \
            float mx = __builtin_fmaxf(__builtin_fmaxf(__builtin_fmaxf(MX4(P0, 0), MX4(P0, 4)), __builtin_fmaxf(MX4(P0, 8), MX4(P0, 12))), __builtin_fmaxf(__builtin_fmaxf(MX4(P1, 0), MX4(P1, 4)), __builtin_fmaxf(MX4(P1, 8), MX4(P1, 12)))); \
            if (__any(mx > 256.f)) {                                              \
                mx = half_swap_max(mx); const float big = __builtin_fmaxf(mx, 1.f); const float dl = __builtin_amdgcn_logf(big), f = __builtin_amdgcn_rcpf(big); m_run += dl; \
                _Pragma("unroll") for (int c = 0; c < 4; ++c) _Pragma("unroll") for (int r = 0; r < 16; ++r) o[c][r] *= f; \
                l_run *= f; _Pragma("unroll") for (int r = 0; r < 16; ++r) { P0[r] *= f; P1[r] *= f; N0[r] -= dl; N1[r] -= dl; } } \
            { float sm_ = 0.f; _Pragma("unroll") for (int r = 0; r < 16; ++r) sm_ += P0[r] + P1[r]; l_run += sm_; } \
            pw0 = PK8(P0, 0); pw1 = PK8(P0, 8); pw2 = PK8(P1, 0); pw3 = PK8(P1, 8); DSUM(pw0); DSUM(pw1); DSUM(pw2); DSUM(pw3); SB(); \
            PVM(vfA, pw0); SB(); \
            VRD(vfA, 2); SB(); \
            PVM(vfB, pw1); SB(); \
            VRD(vfB, 3); SB(); \
            PVM(vfA, pw2); SB(); \
            PVM(vfB, pw3); SB(); \
        } \
        { const int tmp = sc; sc = sn; sn = sn2; sn2 = tmp; } \
        WG_BAR(); } while (0)
#if ATT_UNROLL2
    for (int t = 0; t < NT; t += 2) { ATT_TILE(sA0, sA1, sB0, sB1, t); ATT_TILE(sB0, sB1, sA0, sA1, t + 1); }
#else
    for (int t = 0; t < NT; ++t) { ATT_TILE(sA0, sA1, sB0, sB1, t); sA0 = sB0; sA1 = sB1; }
#endif
#undef ATT_TILE
#undef SB
#undef EX2
#undef MX4
#undef PK8
#undef VRD
#undef PVM
#undef DSUM
#undef ATT_DMA
#undef ATT_QK
    l_run = half_swap_sum(l_run);
    const float inv = 1.f / l_run;
    LAS float* xch = (LAS float*)lds;
    if (mp == 1) {
#pragma unroll
        for (int c = 0; c < 4; ++c)
#pragma unroll
            for (int r = 0; r < 16; ++r) xch[((wq * 64 + c * 16 + r) << 6) + lane] = o[c][r] * inv;
    }
    WG_BAR();
    if (mp == 0) {
        float ss = 0.f;
#pragma unroll
        for (int c = 0; c < 4; ++c)
#pragma unroll
            for (int r = 0; r < 16; ++r) { const float d = o[c][r] * inv - lam * xch[((wq * 64 + c * 16 + r) << 6) + lane]; o[c][r] = d; ss += d * d; }
        ss = half_swap_sum(ss);
        const float rs = oscale / sqrtf(ss * (1.f / 128.f) + NORM_EPS);
        bf16* yp = Y + (rowbase + qi) * LDY + 1024 + h * 128;
#pragma unroll
        for (int c = 0; c < 4; ++c)
#pragma unroll
            for (int r4 = 0; r4 < 4; ++r4) { const int dv = 32 * c + 8 * r4 + 4 * hi; const f32x4 g = *(const GAS f32x4*)(hgain + dv);
                v2u w; w.x = pk2(o[c][4 * r4] * rs * g.x, o[c][4 * r4 + 1] * rs * g.y); w.y = pk2(o[c][4 * r4 + 2] * rs * g.z, o[c][4 * r4 + 3] * rs * g.w);
                *(GAS v2u*)(yp + dv) = w; }
    }
    WG_BAR();
}

template <int MODE  > __device__ __forceinline__ void ret_stage_rot(LAS unsigned char* tile, const bf16* src  , const f32x2* rot  , float sc, float l2g, int tid) {
#pragma unroll
    for (int i = 0; i < 2; ++i) { const int item = tid + 512 * i, j = item >> 3, cc = item & 7;
        const v4u lo = *(const GAS v4u*)(src + (size_t)j * LDP + 8 * cc), hh = *(const GAS v4u*)(src + (size_t)j * LDP + 64 + 8 * cc);
        const GAS f32x4* rp = (const GAS f32x4*)(rot + (size_t)j * 64 + 8 * cc);
        const f32x4 c0 = rp[0], c1 = rp[1], c2 = rp[2], c3 = rp[3];
        const float cs[8] = {c0.x, c0.z, c1.x, c1.z, c2.x, c2.z, c3.x, c3.z}, sn[8] = {c0.y, c0.w, c1.y, c1.w, c2.y, c2.w, c3.y, c3.w};
        const float a[8] = {bflo(lo.x), bfhi(lo.x), bflo(lo.y), bfhi(lo.y), bflo(lo.z), bfhi(lo.z), bflo(lo.w), bfhi(lo.w)};
        const float bb[8] = {bflo(hh.x), bfhi(hh.x), bflo(hh.y), bfhi(hh.y), bflo(hh.z), bfhi(hh.z), bflo(hh.w), bfhi(hh.w)};
        const float s = MODE == 1 ? sc * __builtin_amdgcn_exp2f((float)(127 - j) * l2g) : sc;
        float o1[8], o2[8];
#pragma unroll
        for (int e = 0; e < 8; ++e) { o1[e] = (a[e] * cs[e] - bb[e] * sn[e]) * s; o2[e] = (bb[e] * cs[e] + a[e] * sn[e]) * s; }
        v4u w; w.x = pk2(o1[0], o1[1]); w.y = pk2(o1[2], o1[3]); w.z = pk2(o1[4], o1[5]); w.w = pk2(o1[6], o1[7]); *(LAS v4u*)(tile + offb(j, cc)) = w;
        w.x = pk2(o2[0], o2[1]); w.y = pk2(o2[2], o2[3]); w.z = pk2(o2[4], o2[5]); w.w = pk2(o2[6], o2[7]); *(LAS v4u*)(tile + offb(j, cc + 8)) = w; }
}
__device__ __forceinline__ void ret_stage_plain(LAS unsigned char* tile, const bf16* src, int ld, int tid) {
#pragma unroll
    for (int i = 0; i < 4; ++i) { const int item = tid + 512 * i, row = item >> 4, ch = item & 15; *(LAS v4u*)(tile + offb(row, ch)) = *(const GAS v4u*)(src + (size_t)row * ld + 8 * ch); }
}
__device__ __forceinline__ void retA_unit(LAS unsigned char* lds, const bf16* proj, const f32x2* rot, float* KV, int u, int tid, int lane, int wid) {
    asm volatile("" : "+v"(tid)); lane = tid & 63;
    const int bh = u >> 5, c = u & 31, b = bh >> 3, h = bh & 7, hi = lane >> 5, r32 = lane & 31;
    const size_t t0 = (size_t)b * SEQ + c * 128; const float l2g = kLog2Gamma[h];
    ret_stage_rot<1>(lds, proj + t0 * LDP + C_KR + h * 128, rot + (size_t)c * 128 * 64, RET_KSCALE, l2g, tid);
    ret_stage_plain(lds + 32768, proj + t0 * LDP + C_VR + h * 128, LDP, tid);
    WG_BAR();
    const int db = wid & 3, eb0 = 2 * (wid >> 2);
    const unsigned a0 = tr_off(lane, db, 0), a1 = tr_off(lane, db, 1);
    unsigned b0[2], b1[2];
#pragma unroll
    for (int k = 0; k < 2; ++k) { b0[k] = 32768u + tr_off(lane, eb0 + k, 0); b1[k] = 32768u + tr_off(lane, eb0 + k, 1); }
    f32x16 acc[2] = {splat16(0.f), splat16(0.f)};
#pragma unroll
    for (int ks = 0; ks < 8; ++ks) { const bf16x8 A = trfrag(lds, a0 + 4096u * ks, a1 + 4096u * ks);
#pragma unroll
        for (int k = 0; k < 2; ++k) { const bf16x8 B = trfrag(lds, b0[k] + 4096u * ks, b1[k] + 4096u * ks); acc[k] = MFMA32(A, B, acc[k]); } }
    float* kvp = KV + (size_t)u * 16384;
#pragma unroll
    for (int k = 0; k < 2; ++k)
#pragma unroll
        for (int r = 0; r < 16; ++r) kvp[(32 * db + crow(r, hi)) * 128 + 32 * (eb0 + k) + r32] = acc[k][r];
    WG_BAR();
}
__device__ __forceinline__ void retC_unit(LAS unsigned char* lds, const bf16* proj, const f32x2* rot, const bf16* SST, bf16* Y, int u, int tid, int lane, int wid) {
    asm volatile("" : "+v"(tid)); lane = tid & 63;
    const int bh = u >> 5, c = u & 31, b = bh >> 3, h = bh & 7, hi = lane >> 5, r32 = lane & 31;
    const size_t t0 = (size_t)b * SEQ + c * 128; const float l2g = kLog2Gamma[h];
    ret_stage_rot<0>(lds, proj + t0 * LDP + C_QR + h * 128, rot + (size_t)c * 128 * 64, 1.f, 0.f, tid);
    ret_stage_rot<0>(lds + 32768, proj + t0 * LDP + C_KR + h * 128, rot + (size_t)c * 128 * 64, RET_KSCALE, 0.f, tid);
    ret_stage_plain(lds + 65536, proj + t0 * LDP + C_VR + h * 128, LDP, tid);
    if (c > 0) ret_stage_plain(lds + 98304, SST + (size_t)u * 16384, 128, tid);
    WG_BAR();
    const int ib = wid & 3, eh = wid >> 2, il = 32 * ib + r32;
    bf16x8 qf[8];
#pragma unroll
    for (int ks = 0; ks < 8; ++ks) qf[ks] = *(const LAS bf16x8*)(lds + offb(il, 2 * ks + hi));
    unsigned v0[2], v1[2];
#pragma unroll
    for (int k = 0; k < 2; ++k) { v0[k] = tr_off(lane, 2 * eh + k, 0); v1[k] = tr_off(lane, 2 * eh + k, 1); }
    f32x16 acc[2] = {splat16(0.f), splat16(0.f)};
    if (c > 0) {
#pragma unroll
        for (int ks = 0; ks < 8; ++ks)
#pragma unroll
            for (int k = 0; k < 2; ++k) { const bf16x8 A = trfrag(lds + 98304, v0[k] + 4096u * ks, v1[k] + 4096u * ks); acc[k] = MFMA32(A, qf[ks], acc[k]); }
        const float qd = __builtin_amdgcn_exp2f((float)(il + 1) * l2g);
#pragma unroll
        for (int k = 0; k < 2; ++k)
#pragma unroll
            for (int r = 0; r < 16; ++r) acc[k][r] *= qd;
    }
    for (int jb = 0; jb <= ib; ++jb) {
        f32x16 sc = splat16(0.f);
        const int krow = 32 * jb + swap23(r32);
#pragma unroll
        for (int ks = 0; ks < 8; ++ks) { const bf16x8 A = *(const LAS bf16x8*)(lds + 32768 + offb(krow, 2 * ks + hi)); sc = MFMA32(A, qf[ks], sc); }
#pragma unroll
        for (int r = 0; r < 16; ++r) { const int j = 32 * jb + 16 * (r >> 3) + 8 * hi + (r & 7); const int dj = il - j; sc[r] = dj >= 0 ? sc[r] * __builtin_amdgcn_exp2f((float)dj * l2g) : 0.f; }
        bf16x8 pk[2];
        { v4u w; w.x = pk2(sc[0], sc[1]); w.y = pk2(sc[2], sc[3]); w.z = pk2(sc[4], sc[5]); w.w = pk2(sc[6], sc[7]); pk[0] = __builtin_bit_cast(bf16x8, w);
          w.x = pk2(sc[8], sc[9]); w.y = pk2(sc[10], sc[11]); w.z = pk2(sc[12], sc[13]); w.w = pk2(sc[14], sc[15]); pk[1] = __builtin_bit_cast(bf16x8, w); }
#pragma unroll
        for (int s = 0; s < 2; ++s)
#pragma unroll
            for (int k = 0; k < 2; ++k) { const unsigned ko = 4096u * (unsigned)(2 * jb + s); const bf16x8 A = trfrag(lds + 65536, v0[k] + ko, v1[k] + ko); acc[k] = MFMA32(A, pk[s], acc[k]); }
    }
    float ss = 0.f;
#pragma unroll
    for (int k = 0; k < 2; ++k)
#pragma unroll
        for (int r = 0; r < 16; ++r) ss += acc[k][r] * acc[k][r];
    ss = half_swap_sum(ss);
    LAS float* xs = (LAS float*)(lds + 131072);
    if (hi == 0) xs[eh * 128 + il] = ss;
    WG_BAR();
    const float rs = 1.f / sqrtf((xs[il] + xs[128 + il]) * (1.f / 128.f) + NORM_EPS);
    const bf16* gp = proj + (t0 + il) * LDP + C_GR + h * 128; bf16* yp = Y + (t0 + il) * LDY + 2048 + h * 128;
#pragma unroll
    for (int k = 0; k < 2; ++k)
#pragma unroll
        for (int r4 = 0; r4 < 4; ++r4) { const int e = 32 * (2 * eh + k) + 8 * r4 + 4 * hi; const v2u gw = *(const GAS v2u*)(gp + e);
            v2u w; w.x = pk2(acc[k][4 * r4] * rs * bflo(gw.x), acc[k][4 * r4 + 1] * rs * bfhi(gw.x)); w.y = pk2(acc[k][4 * r4 + 2] * rs * bflo(gw.y), acc[k][4 * r4 + 3] * rs * bfhi(gw.y));
            *(GAS v2u*)(yp + e) = w; }
    WG_BAR();
}
#define XB_TMO      128
#define XB_XCNT(j)  (256  + 64 * (j))
#define XB_XSUB(j)  (1280 + 64 * (j))
#define XB_XGEN(j)  (2304 + 64 * (j))
#define XB_TOP      3328
#define XB_TOPGEN   3392
#define XCD_BAR_WORDS 3456
#define XB_SPIN_CAP (1u << 18)

__device__ __forceinline__ unsigned xb_ld(unsigned* p)              { return __hip_atomic_load(p, __ATOMIC_RELAXED, __HIP_MEMORY_SCOPE_AGENT); }
__device__ __forceinline__ unsigned xb_add(unsigned* p, unsigned v) { return __hip_atomic_fetch_add(p, v, __ATOMIC_RELAXED, __HIP_MEMORY_SCOPE_AGENT); }
__device__ __forceinline__ unsigned xb_xcc_id() { return (unsigned)__builtin_amdgcn_s_getreg((3 << 11) | 20) & 0xFu; }
#define XB_SPIN(cond, bar) do { unsigned _sp = 0; while (cond) { __builtin_amdgcn_s_sleep(1); \
    if ((++_sp & 255u) == 0u) { if (xb_ld(&(bar)[XB_TMO])) break; if (_sp > XB_SPIN_CAP) { atomicAdd(&(bar)[XB_TMO], 1u); break; } } } } while (0)

struct XcdBarrier {
    unsigned* bar; unsigned x;
    volatile LAS unsigned* st;
};

__device__ __forceinline__ XcdBarrier xcd_barrier_post(unsigned* bar, volatile LAS unsigned* st) {
    XcdBarrier b; b.bar = bar; b.x = xb_xcc_id(); b.st = st;
    if (threadIdx.x == 0) (void)xb_add(&bar[XB_XCNT(b.x)], 1u);
    return b;
}
__device__ __forceinline__ void xcd_barrier_complete(unsigned* bar, unsigned x, unsigned& nloc, unsigned& nx) {
    const unsigned G = gridDim.x * gridDim.y * gridDim.z;
    unsigned sum, cnt, mine, sp = 0u;
    for (;;) {
        sum = 0u; cnt = 0u; mine = 0u;
#pragma unroll
        for (unsigned j = 0; j < 16; ++j) { const unsigned c = xb_ld(&bar[XB_XCNT(j)]); sum += c; cnt += (c > 0u) ? 1u : 0u; mine = (j == x) ? c : mine; }
        if (sum == G) break;
        __builtin_amdgcn_s_sleep(1);
        if ((++sp & 255u) == 0u) { if (xb_ld(&bar[XB_TMO])) break; if (sp > XB_SPIN_CAP) { atomicAdd(&bar[XB_TMO], 1u); break; } }
    }
    nloc = mine > 0u ? mine : 1u; nx = cnt > 0u ? cnt : 1u;
}

__device__ __forceinline__ void xcd_barrier(const XcdBarrier& b) {
    asm volatile("s_waitcnt vmcnt(0)" ::: "memory");
    __syncthreads();
    if (threadIdx.x == 0) {
        unsigned* bar = b.bar;
        __builtin_amdgcn_s_waitcnt(0);
        unsigned nloc = b.st[0], nx = b.st[1];
        if (nloc == 0u) { xcd_barrier_complete(bar, b.x, nloc, nx); b.st[0] = nloc; b.st[1] = nx; }
        const unsigned old = xb_add(&bar[XB_XSUB(b.x)], 1u);
        const unsigned gen = old / nloc;
        if (old + 1u == (gen + 1u) * nloc) {
            __builtin_amdgcn_fence(__ATOMIC_RELEASE, "agent");
            asm volatile("s_waitcnt vmcnt(0)" ::: "memory");
            const unsigned og = xb_add(&bar[XB_TOP], 1u);
            const unsigned tg = og / nx;
            if (og + 1u == (tg + 1u) * nx) xb_add(&bar[XB_TOPGEN], 1u);
            else XB_SPIN(xb_ld(&bar[XB_TOPGEN]) == tg, bar);
            __builtin_amdgcn_fence(__ATOMIC_ACQUIRE, "agent");
            xb_add(&bar[XB_XGEN(b.x)], 1u);
            asm volatile("s_waitcnt vmcnt(0)" ::: "memory");
        } else {
            XB_SPIN(xb_ld(&bar[XB_XGEN(b.x)]) == gen, bar);
            __builtin_amdgcn_fence(__ATOMIC_ACQUIRE, "agent");
            asm volatile("s_waitcnt vmcnt(0)" ::: "memory");
        }
    }
    __syncthreads();
}
#ifndef NAIVE
#define NAIVE 0
#endif
__device__ __forceinline__ void naive_pool(LAS unsigned char* lds, const bf16* proj, const float* poolw  , const float* pscale, bf16* Y, int vcu, int G, int tid) {
    LAS float* dl = (LAS float*)lds; LAS float* part = dl + 256;
    for (int it = vcu; it < M * 4; it += G) { const int t = it >> 2, g = it & 3, win = 2 << g, pos = t & (SEQ - 1);
        if (tid < 256) { const int lo = pos + 1 - win < 0 ? 0 : pos + 1 - win; float s = 0.f;
            for (int p = lo; p <= pos; ++p) s += bflo((unsigned)proj[(size_t)(t - (pos - p)) * LDP + C_POOL + g * 256 + tid]);
            const float cur = bflo((unsigned)proj[(size_t)t * LDP + C_POOL + g * 256 + tid]);
            dl[tid] = s / (float)(pos + 1 - lo) - cur; }
        __syncthreads();
        const int o = tid & 255, hf = tid >> 8; float a = 0.f;
        for (int c = hf * 128; c < hf * 128 + 128; ++c) a += dl[c] * poolw[((size_t)g * 256 + c) * 256 + o];
        if (hf) part[o] = a;
        __syncthreads();
        if (!hf) Y[(size_t)t * LDY + g * 256 + o] = (bf16)(pk2((a + part[o]) * pscale[g * 256 + o], 0.f) & 0xffffu);
        __syncthreads(); }
}
__device__ __forceinline__ void naive_ret(LAS unsigned char* lds, const bf16* proj, bf16* Y, int vcu, int G, int tid) {
    LAS float* qs = (LAS float*)lds; LAS float* ks = qs + 128; LAS float* vs = ks + 128; LAS float* po = vs + 128; LAS float* red = po + 512;
    for (int bh = vcu; bh < 32; bh += G) { const int b = bh >> 3, h = bh & 7; const float gam = 1.0f - exp2f(-5.0f - (float)h);
        float S[32];
#pragma unroll
        for (int i = 0; i < 32; ++i) S[i] = 0.f;
        const int e = tid & 127, dg = tid >> 7;
        for (int pos = 0; pos < SEQ; ++pos) { const size_t row = (size_t)b * SEQ + pos; const bf16* pr = proj + row * LDP + h * 128;
            if (tid < 128) { const int i = tid & 63; const float invf = exp2f(-((float)i / 63.0f) * 13.287712379549449f); const float ang = (float)pos * invf;
                const double rev = (double)ang * 0.15915494309189535; const float fr = (float)(rev - __builtin_rint(rev)); const float cs = __builtin_amdgcn_cosf(fr), sn = __builtin_amdgcn_sinf(fr);
                const float q1 = bflo((unsigned)pr[C_QR + i]), q2 = bflo((unsigned)pr[C_QR + 64 + i]), k1 = bflo((unsigned)pr[C_KR + i]), k2 = bflo((unsigned)pr[C_KR + 64 + i]);
                if (tid < 64) { qs[i] = q1 * cs - q2 * sn; ks[i] = (k1 * cs - k2 * sn) * RET_KSCALE; } else { qs[64 + i] = q2 * cs + q1 * sn; ks[64 + i] = (k2 * cs + k1 * sn) * RET_KSCALE; }
                vs[tid] = bflo((unsigned)pr[C_VR + tid]); }
            __syncthreads();
            float a = 0.f; const float ve = vs[e];
#pragma unroll
            for (int i = 0; i < 32; ++i) { const int d = dg * 32 + i; S[i] = gam * S[i] + ks[d] * ve; a += qs[d] * S[i]; }
            po[dg * 128 + e] = a;
            __syncthreads();
            if (tid < 128) { const float o = po[e] + po[128 + e] + po[256 + e] + po[384 + e]; const float s2 = wave_sum(o * o); if ((tid & 63) == 0) red[tid >> 6] = s2; po[e] = o; }
            __syncthreads();
            if (tid < 128) { const float rs = 1.0f / sqrtf((red[0] + red[1]) * (1.f / 128.f) + NORM_EPS); const float gt = bflo((unsigned)pr[C_GR + e]);
                Y[row * LDY + 2048 + h * 128 + e] = (bf16)(pk2(po[e] * rs * gt, 0.f) & 0xffffu); }
            __syncthreads(); } }
}
__device__ __forceinline__ void naive_attn(const bf16* proj, bf16* Y, const float* relb, const float* hgain, float lam, float oscale, int gw, int NGW, int lane) {
    for (int it = gw; it < 32 * SEQ; it += NGW) { const int bh = it / SEQ, q = it % SEQ, b = bh >> 3, h = bh & 7; const size_t rowbase = (size_t)b * SEQ;
        const bf16* qp = proj + (rowbase + q) * LDP + C_QD + h * 128;
        const float qa = bflo((unsigned)qp[lane]), qb = bflo((unsigned)qp[64 + lane]);
        float mx0 = -1e30f, mx1 = -1e30f;
        const int nkb = q / 64 + 1;
        for (int pass = 0; pass < 2; ++pass) {
            float l0 = 0.f, l1 = 0.f, o0a = 0.f, o0b = 0.f, o1a = 0.f, o1b = 0.f;
            for (int kb = 0; kb < nkb; ++kb) { const int key = kb * 64 + lane; const bool valid = key <= q; const int kc = valid ? key : q;
                const bf16* kp = proj + (rowbase + kc) * LDP + C_KD + h * 128; float s0 = 0.f, s1 = 0.f;
#pragma unroll
                for (int d8 = 0; d8 < 8; ++d8) { const v4u w0 = *(const GAS v4u*)(kp + 8 * d8), w1 = *(const GAS v4u*)(kp + 64 + 8 * d8);
#pragma unroll
                    for (int j = 0; j < 4; ++j) { const int d = 8 * d8 + 2 * j;
                        const float q0a = __builtin_bit_cast(float, __builtin_amdgcn_readlane(__builtin_bit_cast(int, qa), d)), q0b = __builtin_bit_cast(float, __builtin_amdgcn_readlane(__builtin_bit_cast(int, qa), d + 1));
                        const float q1a = __builtin_bit_cast(float, __builtin_amdgcn_readlane(__builtin_bit_cast(int, qb), d)), q1b = __builtin_bit_cast(float, __builtin_amdgcn_readlane(__builtin_bit_cast(int, qb), d + 1));
                        s0 += q0a * bflo(w0[j]) + q0b * bfhi(w0[j]); s1 += q1a * bflo(w1[j]) + q1b * bfhi(w1[j]); } }
                const float bs = relb[t5_bucket(q - kc) * 8 + h] * LOG2E; s0 += bs; s1 += bs;
                if (pass == 0) { if (valid) { mx0 = fmaxf(mx0, s0); mx1 = fmaxf(mx1, s1); } }
                else { const float p0 = valid ? exp2f(s0 - mx0) : 0.f, p1 = valid ? exp2f(s1 - mx1) : 0.f; l0 += p0; l1 += p1;
                    for (int kk = 0; kk < 64; ++kk) { const int k2 = kb * 64 + kk; if (k2 > q) break; const float a0 = __shfl(p0, kk), a1 = __shfl(p1, kk);
                        const bf16* vp = proj + (rowbase + k2) * LDP + C_VD + h * 128; const float va = bflo((unsigned)vp[lane]), vb = bflo((unsigned)vp[64 + lane]);
                        o0a += a0 * va; o0b += a0 * vb; o1a += a1 * va; o1b += a1 * vb; } } }
            if (pass == 0) {
#pragma unroll
                for (int o = 1; o < 64; o <<= 1) { mx0 = fmaxf(mx0, __shfl_xor(mx0, o)); mx1 = fmaxf(mx1, __shfl_xor(mx1, o)); } }
            else { l0 = wave_sum(l0); l1 = wave_sum(l1);
                const float da = o0a / l0 - lam * o1a / l1, db = o0b / l0 - lam * o1b / l1; const float ss = wave_sum(da * da + db * db);
                const float rs = oscale / sqrtf(ss * (1.f / 128.f) + NORM_EPS); bf16* yp = Y + (rowbase + q) * LDY + 1024 + h * 128;
                yp[lane] = (bf16)(pk2(da * rs * hgain[lane], 0.f) & 0xffffu); yp[64 + lane] = (bf16)(pk2(db * rs * hgain[64 + lane], 0.f) & 0xffffu); } } }
}
constexpr int NPH_LAYER = 10, NPH = 1 + DEPTH * NPH_LAYER;
struct Args { const float* in[15]; float* out; unsigned char* ws; int p_lo, p_hi; };
__global__ void __launch_bounds__(NWAVES * 64, 2) fwd(Args args) {
    extern __shared__ __attribute__((aligned(16))) unsigned char lds_raw[];
    LAS unsigned char* lds = (LAS unsigned char*)lds_raw;
#define LTID() ({ int t_ = threadIdx.x; asm volatile("" : "+v"(t_)); t_; })
    const int tid0 = threadIdx.x, wave = __builtin_amdgcn_readfirstlane(tid0 >> 6);
    const int G = gridDim.x; const int bx = blockIdx.x; const int vcu = (G % 8 == 0) ? (bx % 8) * (G / 8) + bx / 8 : bx;
    unsigned char* ws = args.ws;
    gu32* ctl = (gu32*)(ws + WS_CTL);
    for (int u = tid0; u < (LDS_BYTES - LDSCTL_OFF) / 4; u += NWAVES * 64) ((LAS unsigned*)(lds + LDSCTL_OFF))[u] = 0u;
    __syncthreads();
    volatile LAS unsigned* MISC = (volatile LAS unsigned*)(lds + MISC_OFF);
    XcdBarrier bar; bar.bar = (unsigned*)(ctl + CW_BAR); bar.x = 0; bar.st = nullptr;
    if (SINGLE_LAUNCH) bar = xcd_barrier_post((unsigned*)(ctl + CW_BAR), MISC + 8);
    const int lo = args.p_lo, hi_ph = args.p_hi;
#define IN(k) (lo <= (k) && (k) < hi_ph)
#ifndef PHMASK
#define PHMASK 0xffff
#endif
#define PHM(i) (((PHMASK) >> (i)) & 1)
#ifndef UMASK
#define UMASK 7
#endif
#define UEN(i) (((UMASK) >> (i)) & 1)
#ifndef DUPMASK
#define DUPMASK 0
#endif
#define REPS(i) ((((DUPMASK) >> (i)) & 1) ? 2 : 1)
#define SEAM(k) do { if (SINGLE_LAUNCH && IN(k) && IN((k) + 1)) xcd_barrier(bar); } while (0)
#ifndef FUSE_THIN
#define FUSE_THIN 0
#endif
    const bool fuse_thin = FUSE_THIN && SINGLE_LAUNCH && (G == 256);
    constexpr int CW_PANEL = 16384;
#define PANEL_TAIL(S_, TI, GPOST, FOUT) do { \
        pg8::Unit u0_; (void)(S_).next(0, u0_); \
        gu32* cnt_ = ctl + CW_PANEL + ((TI) * 64 + u0_.pm) * 64; \
        if (tid0 == 0) { __builtin_amdgcn_fence(__ATOMIC_RELEASE, "agent"); asm volatile("s_waitcnt vmcnt(0)" ::: "memory"); (void)__hip_atomic_fetch_add(cnt_, 1u, RLX_AGENT); \
            unsigned sp_ = 0; while (__hip_atomic_load(cnt_, RLX_AGENT) < 4u) { __builtin_amdgcn_s_sleep(1); if (++sp_ > (1u << 21)) break; } \
            __builtin_amdgcn_fence(__ATOMIC_ACQUIRE, "agent"); asm volatile("s_waitcnt vmcnt(0)" ::: "memory"); } \
        __syncthreads(); \
        { const int lane_ = LTID() & 63; const int r0_ = u0_.pm * 256 + (u0_.pn & 3) * 64; float* fo_ = (FOUT); \
          for (int r_ = wave; r_ < 64; r_ += NWAVES) { const size_t m_ = (size_t)(r0_ + r_); resid_row(XN + m_ * DM, MIX + m_ * DM, STAT + m_ * 32, (GPOST), RS + m_, fo_ ? fo_ + m_ * DM : (float*)nullptr, lane_); } } \
    } while (0)

    const float* x_in = args.in[0]; const float* rel_bias = args.in[1];
    const float* g_pre_mix = args.in[2]; const float* g_post_mix = args.in[3]; const float* g_pre_mlp = args.in[4]; const float* g_post_mlp = args.in[5];
    const float* w_in = args.in[6]; const float* pool_w = args.in[7]; const float* pool_scale = args.in[8]; const float* diff_lambda = args.in[9]; const float* diff_hn = args.in[10];
    const float* w_branch = args.in[11]; const float* w_out = args.in[12]; const float* w_up = args.in[13]; const float* w_down = args.in[14];
    float* xres = args.out;
    bf16* WIN = (bf16*)(ws + WS_WIN); bf16* WB = (bf16*)(ws + WS_WB); bf16* WO = (bf16*)(ws + WS_WO); bf16* WUP = (bf16*)(ws + WS_WUP); bf16* WDN = (bf16*)(ws + WS_WDN); bf16* POOLT = (bf16*)(ws + WS_POOLT);
    bf16* XN = (bf16*)(ws + WS_XN); bf16* MRG = (bf16*)(ws + WS_MRG); bf16* MIX = (bf16*)(ws + WS_MIX); bf16* Y = (bf16*)(ws + WS_Y); bf16* PROJ = (bf16*)(ws + WS_PROJ); bf16* FF = PROJ;
    float* RS = (float*)(ws + WS_RS); float* KV = (float*)(ws + WS_KV); bf16* SST = (bf16*)(ws + WS_SST); float* STAT = (float*)(ws + WS_STAT); f32x2* ROT = (f32x2*)(ws + WS_ROT);
    const int gw = vcu * NWAVES + wave, NGW = G * NWAVES;

    if (PHM(0) && IN(0)) for (int rep_ = 0; rep_ < REPS(0); ++rep_) {
        const int tid = LTID(), lane = tid & 63;
        LAS float* scr = (LAS float*)(lds + wave * 16384);
        constexpr int I_IN = (DM / 64) * (INC / 32), I_B = (MIXW / 64) * (DM / 32), I_O = (DM / 64) * (DM / 32), I_UP = (DM / 64) * (DFF / 32), I_DN = (DFF / 64) * (DM / 32), I_P = (256 / 64) * (256 / 32);
        constexpr int I_LAYER = I_IN + 3 * I_B + I_O + I_UP + I_DN + 4 * I_P;
        for (int it = gw; it < DEPTH * I_LAYER; it += NGW) {
            const int l = it / I_LAYER; int r = it - l * I_LAYER;
            if (r < I_IN) { p0_transpose_item(w_in + (size_t)l * DM * INC, INC, WIN + (size_t)l * INC * DM, DM, 0, scr, r, lane, g_pre_mix + l * DM); continue; } r -= I_IN;
            if (r < 3 * I_B) { const int n = r / I_B; r -= n * I_B; p0_transpose_item(w_branch + ((size_t)l * 3 + n) * MIXW * DM, DM, WB + (size_t)l * DM * 3072, 3072, n * MIXW, scr, r, lane); continue; } r -= 3 * I_B;
            if (r < I_O) { p0_transpose_item(w_out + (size_t)l * DM * DM, DM, WO + (size_t)l * DM * DM, DM, 0, scr, r, lane); continue; } r -= I_O;
            if (r < I_UP) { p0_transpose_item(w_up + (size_t)l * DM * DFF, DFF, WUP + (size_t)l * DFF * DM, DM, 0, scr, r, lane, g_pre_mlp + l * DM); continue; } r -= I_UP;
            if (r < I_DN) { p0_transpose_item(w_down + (size_t)l * DFF * DM, DM, WDN + (size_t)l * DM * DFF, DFF, 0, scr, r, lane); continue; } r -= I_DN;
            { const int g = r / I_P; r -= g * I_P; p0_transpose_item(pool_w + ((size_t)l * 4 + g) * 65536, 256, POOLT + ((size_t)l * 4 + g) * 65536, 256, 0, scr, r, lane); }
        }
        for (int i = vcu * 512 + tid; i < SEQ * 64; i += G * 512) { const int pos = i >> 6, f = i & 63;
            const float invf = __builtin_amdgcn_exp2f(-(float)f * (13.287712379549449f / 63.0f));
            const float ang = (float)pos * invf; const double rev = (double)ang * 0.15915494309189535; const float fr = (float)(rev - __builtin_rint(rev));
            ROT[i] = (f32x2){__builtin_amdgcn_cosf(fr), __builtin_amdgcn_sinf(fr)}; }
        for (int m = gw; m < M; m += NGW) prep_row(x_in + (size_t)m * DM, XN + (size_t)m * DM, RS + m, lane);
    }
    SEAM(0);

    for (int l = 0; l < DEPTH; ++l) {
        const int pb = 1 + l * NPH_LAYER;
        const float lambda_init = 0.8f - 0.6f * __expf(-0.3f * (float)l);
#ifndef GREP1
#define GREP1 1
#endif
        for (int gr_ = 0; gr_ < GREP1; ++gr_) {
        if (PHM(1) && IN(pb + 0)) for (int rep_ = 0; rep_ < REPS(1); ++rep_) {
            pg8::Gemm g{XN, WIN + (size_t)l * INC * DM, M, INC, DM}; pg8::StaticOrder S; S.init(M, INC, G, bx);
            pg8::EpiProj E{PROJ, LDP, QSCALE, RS};
            pg8::gemm_phase<pg8::EpiProj, pg8::StaticOrder, GEMM_ALIGN, GEMM_SP2>(lds, g, S, E);
#ifdef DUPBAR
            if (rep_ + 1 < REPS(1)) xcd_barrier(bar);
#endif
        }
        SEAM(pb + 0);
        if (PHM(2) && IN(pb + 1)) for (int rep_ = 0; rep_ < REPS(2); ++rep_) {
            const int tid = LTID(), lane = tid & 63;
            if (NAIVE & 1) naive_pool(lds, PROJ, pool_w + (size_t)l * 4 * 65536, pool_scale + l * MIXW, Y, vcu, G, tid);
            else if (UEN(0)) for (int r2_ = 0; r2_ < REPS(11); ++r2_) for (int u = vcu; u < 512; u += G) pool_unit(lds, PROJ, POOLT + (size_t)l * 4 * 65536, pool_scale + l * MIXW, Y, u >> 2, u & 3, tid, lane, wave);
            if (NAIVE & 4) naive_ret(lds, PROJ, Y, vcu, G, tid);
            else if (UEN(1)) for (int r2_ = 0; r2_ < REPS(12); ++r2_) for (int u = vcu; u < 1024; u += G) retA_unit(lds, PROJ, ROT, KV, u, tid, lane, wave);
            if (UEN(2)) { const float* lp = diff_lambda + l * 256;
              const float s1 = wave_sum(lp[lane] * lp[64 + lane]), s2 = wave_sum(lp[128 + lane] * lp[192 + lane]);
              const float lam = __expf(s1) - __expf(s2) + lambda_init;
              if (NAIVE & 2) naive_attn(PROJ, Y, rel_bias, diff_hn + l * 128, lam, 1.f - lambda_init, gw, NGW, lane);
              else for (int r2_ = 0; r2_ < REPS(13); ++r2_) for (int i = 0; i < 4 * ((256 + G - 1) / G); ++i) { const int v = vcu + (i >> 2) * G; if (v >= 256) break;
                  const int bh = v >> 3, s = v & 7, k = i & 3; const int qb = (k == 0) ? 31 - s : (k == 1) ? 16 + s : (k == 2) ? 15 - s : s;
                  attn_unit(lds, PROJ, Y, rel_bias, diff_hn + l * 128, lam, 1.f - lambda_init, bh >> 3, bh & 7, qb, tid, lane, wave); } }
        }
        SEAM(pb + 1);
        if (!(NAIVE & 4) && PHM(3) && IN(pb + 2)) for (int rep_ = 0; rep_ < REPS(3); ++rep_) {
            const int tid = LTID();
            for (int gid = vcu * 512 + tid; gid < 32 * 4096; gid += G * 512) { const int bh = gid >> 12, i4 = gid & 4095; const float dec = __builtin_amdgcn_exp2f(128.f * kLog2Gamma[bh & 7]);
                f32x4 S = {0.f, 0.f, 0.f, 0.f};
                const GAS f32x4* kp = (const GAS f32x4*)(KV + (size_t)bh * 32 * 16384) + i4; GAS v2u* sp = (GAS v2u*)(SST + (size_t)bh * 32 * 16384) + i4;
#pragma unroll 4
                for (int c = 0; c < 31; ++c) { const f32x4 kv = kp[(size_t)c * 4096]; S = S * dec + kv; v2u w; w.x = pk2(S.x, S.y); w.y = pk2(S.z, S.w); sp[(size_t)(c + 1) * 4096] = w; } }
        }
        SEAM(pb + 2);
        if (!(NAIVE & 4) && PHM(4) && IN(pb + 3)) for (int rep_ = 0; rep_ < REPS(4); ++rep_) { const int tid = LTID(), lane = tid & 63; for (int u = vcu; u < 1024; u += G) retC_unit(lds, PROJ, ROT, SST, Y, u, tid, lane, wave); }
        SEAM(pb + 3);
        if (PHM(5) && IN(pb + 4)) for (int rep_ = 0; rep_ < REPS(5); ++rep_) {
            pg8::Gemm g{Y, WB + (size_t)l * DM * 3072, M, DM, 3072}; pg8::StaticOrder S; S.init(M, DM, G, bx);
            pg8::EpiWiden E{MRG, DM, PROJ + C_GATE, LDP};
            pg8::gemm_phase<pg8::EpiWiden, pg8::StaticOrder, GEMM_ALIGN, GEMM_SP2>(lds, g, S, E);
        }
        SEAM(pb + 4);
        if (PHM(6) && IN(pb + 5)) for (int rep_ = 0; rep_ < REPS(6); ++rep_) {
            pg8::Gemm g{MRG, WO + (size_t)l * DM * DM, M, DM, DM}; pg8::StaticOrder S; S.init(M, DM, G, bx);
            pg8::EpiSq E{MIX, DM, STAT};
            pg8::gemm_phase<pg8::EpiSq, pg8::StaticOrder, GEMM_ALIGN, GEMM_SP2>(lds, g, S, E);
            if (fuse_thin && GREP1 == 1 && REPS(6) == 1) PANEL_TAIL(S, l * 2, g_post_mix + l * DM, (float*)nullptr);
        }
        if (gr_ + 1 < GREP1) xcd_barrier(bar);
        }
        SEAM(pb + 5);
        if (!(fuse_thin && GREP1 == 1 && REPS(6) == 1)) {
        if (PHM(7) && IN(pb + 6)) {
            const int lane = LTID() & 63;
            for (int rep_ = REPS(7) - 1; rep_ >= 0; --rep_)
            for (int m = gw; m < M; m += NGW) resid_row(XN + (size_t)m * DM, MIX + (size_t)m * DM, STAT + (size_t)m * 32, g_post_mix + l * DM, rep_ ? KV + m : RS + m, (float*)nullptr, lane, rep_ ? MRG + (size_t)m * DM : (bf16*)nullptr);
        }
        SEAM(pb + 6);
        }
        if (PHM(8) && IN(pb + 7)) for (int rep_ = 0; rep_ < REPS(8); ++rep_) {
            pg8::Gemm g{XN, WUP + (size_t)l * DFF * DM, M, DFF, DM}; pg8::StaticOrder S; S.init(M, DFF, G, bx);
            pg8::EpiRelu2 E{FF, DFF, RS};
            pg8::gemm_phase<pg8::EpiRelu2, pg8::StaticOrder, GEMM_ALIGN, GEMM_SP2>(lds, g, S, E);
        }
        SEAM(pb + 7);
        if (PHM(9) && IN(pb + 8)) for (int rep_ = 0; rep_ < REPS(9); ++rep_) {
            pg8::Gemm g{FF, WDN + (size_t)l * DM * DFF, M, DM, DFF}; pg8::StaticOrder S; S.init(M, DM, G, bx);
            pg8::EpiSq E{MIX, DM, STAT};
            pg8::gemm_phase<pg8::EpiSq, pg8::StaticOrder, GEMM_ALIGN, GEMM_SP2>(lds, g, S, E);
            if (fuse_thin && REPS(9) == 1) PANEL_TAIL(S, l * 2 + 1, g_post_mlp + l * DM, (l == DEPTH - 1) ? xres : (float*)nullptr);
        }
        SEAM(pb + 8);
        if (!(fuse_thin && REPS(9) == 1)) {
        if (PHM(10) && IN(pb + 9)) {
            const int lane = LTID() & 63;
            const bool lastl = (l == DEPTH - 1);
            for (int m = gw; m < M; m += NGW) resid_row(XN + (size_t)m * DM, MIX + (size_t)m * DM, STAT + (size_t)m * 32, g_post_mlp + l * DM, RS + m, lastl ? xres + (size_t)m * DM : (float*)nullptr, lane);
        }
        SEAM(pb + 9);
        }
    }
#undef IN
#undef SEAM
}

extern "C" void kernel_launch(void* const* d_in, const int* in_sizes, int n_in, void* d_out, int out_size, void* d_ws, size_t ws_size, hipStream_t stream) {
    static int grid = 0;
    if (grid == 0) {
        if (n_in != 15 || in_sizes[0] != M * DM || out_size != M * DM || ws_size < WS_END) { fprintf(stderr, "kernel_launch: unexpected shapes / workspace (n_in %d, ws %zu, need %zu); nothing launched\n", n_in, ws_size, (size_t)WS_END); grid = -1; return; }
        int dev = 0, cus = 0, per_cu = 0;
        if (hipGetDevice(&dev) != hipSuccess || hipDeviceGetAttribute(&cus, hipDeviceAttributeMultiprocessorCount, dev) != hipSuccess) { grid = -1; return; }
        if (hipFuncSetAttribute((const void*)fwd, hipFuncAttributeMaxDynamicSharedMemorySize, LDS_BYTES) != hipSuccess) { fprintf(stderr, "kernel_launch: hipFuncSetAttribute failed\n"); grid = -1; return; }
        if (hipOccupancyMaxActiveBlocksPerMultiprocessor(&per_cu, (const void*)fwd, NWAVES * 64, LDS_BYTES) != hipSuccess || per_cu < 1) fprintf(stderr, "kernel_launch: note: occupancy query reports %d workgroups per CU\n", per_cu);
        (void)hipGetLastError();
        grid = cus;
    }
    if (grid < 0) return;
    if (hipMemsetAsync((char*)d_ws + WS_CTL, 0, CTL_ZERO_BYTES, stream) != hipSuccess) return;
    Args a{};
    for (int i = 0; i < 15; ++i) a.in[i] = (const float*)d_in[i];
    a.out = (float*)d_out; a.ws = (unsigned char*)d_ws;
    if (SINGLE_LAUNCH) {
        a.p_lo = 0; a.p_hi = NPH;
        hipLaunchKernelGGL(fwd, dim3(grid), dim3(NWAVES * 64), LDS_BYTES, stream, a);
    } else {
        for (int p = 0; p < NPH; ++p) { a.p_lo = p; a.p_hi = p + 1; hipLaunchKernelGGL(fwd, dim3(grid), dim3(NWAVES * 64), LDS_BYTES, stream, a); }
    }
    const hipError_t le = hipPeekAtLastError();
    if (le != hipSuccess) fprintf(stderr, "kernel_launch: launch failed: %s\n", hipGetErrorName(le));
}
```

```cpp
#include <hip/hip_runtime.h>
#include <cstdio>
#include <cstdint>
namespace pg8 {
#define PG8_LAS __attribute__((address_space(3)))
typedef unsigned short bf16_t;
typedef short bf16x8 __attribute__((ext_vector_type(8)));
typedef float f32x4 __attribute__((ext_vector_type(4)));
typedef unsigned u32x4 __attribute__((ext_vector_type(4)));
constexpr int BM = 256, BK = 64, HALF = 128, HTB = HALF * BK * 2  , STAGE_BYTES = 8 * HTB, NXCD = 8, WGM = 8;

__host__ __device__ __forceinline__ int lds_byte(int r, int c) { const int st = (r >> 4) * 2 + (c >> 5), rr = r & 15, cc = c & 31, ob = rr * 64 + cc * 2; return st * 1024 + (ob ^ (((ob >> 9) & 1) << 5)); }
__host__ __device__ __forceinline__ void stage_rc(int b, int& R, int& C) { const int st = b / 1024, sb = b % 1024, swz = sb ^ (((sb >> 9) & 1) << 5); R = (st >> 1) * 16 + swz / 64; C = (st & 1) * 32 + (swz % 64) / 2; }
__host__ __device__ __forceinline__ int perm32(int rho) { const int n = rho >> 4, i = rho & 15; return 8 * (i >> 2) + 4 * n + (i & 3); }

struct Unit { int pm, pn; };
struct Gemm { const bf16_t* A; const bf16_t* Bt; int M, N, K; };

struct StaticOrder {
    int nM, nN, nwg, G, c;
    __host__ __device__ void init(int M, int N, int G_, int c_) { nM = M / BM; nN = N / BM; nwg = nM * nN; G = G_; c = c_; }
    __host__ __device__ bool next(int i, Unit& u) const {
        const long L = (long)i * G + c; if (L >= nwg) return false;
        int wgid = (int)L; { const int q = nwg / NXCD, r = nwg % NXCD, xcd = wgid % NXCD, off = wgid / NXCD; wgid = (xcd < r ? xcd * (q + 1) : r * (q + 1) + (xcd - r) * q) + off; }
        const int nig = WGM * nN, gid = wgid / nig, fm = gid * WGM, gsz = (nM - fm) < WGM ? (nM - fm) : WGM;
        u.pm = fm + ((wgid % nig) % gsz); u.pn = (wgid % nig) / gsz; return true;
    }
    __device__ __forceinline__ void a_ready(const Unit&) const {}
    __device__ __forceinline__ void done(const Unit&) const {}
};

typedef float f32x2c __attribute__((ext_vector_type(2))); typedef __bf16 bf16x2c __attribute__((ext_vector_type(2)));
__device__ __forceinline__ unsigned cvt_pk_bf16(float lo, float hi) { f32x2c v = {lo, hi}; bf16x2c b = __builtin_convertvector(v, bf16x2c); return __builtin_bit_cast(unsigned, b); }
typedef float f32x2 __attribute__((ext_vector_type(2)));

template <class Epi, class Sched, bool ALIGN_EPI = false, bool SP2 = false>
__device__ __forceinline__ void gemm_phase(PG8_LAS unsigned char* lds, const Gemm g, const Sched& S, const Epi& E) {
    int tid_ = threadIdx.x; asm volatile("" : "+v"(tid_));
    const int tid = tid_, wid = __builtin_amdgcn_readfirstlane(tid >> 6), lane = tid & 63, wr = wid >> 2, wc = wid & 3, fr = lane & 15, fq = lane >> 4;
    const int K = g.K, nt = K / BK;
    unsigned voffA[2], voffB[2];
#pragma unroll
    for (int i = 0; i < 2; ++i) { int R, C; stage_rc(tid * 16 + i * 8192, R, C); const int Rb = Epi::PERM ? ((R & ~31) + perm32(R & 31)) : R;
        voffA[i] = (unsigned)(R * K + C) * 2u; voffB[i] = (unsigned)(Rb * K + C) * 2u; }
    const size_t kstep = (size_t)(BK * 2);
    const size_t hstep = (size_t)HALF * K * 2;
    const size_t tstep = 2 * hstep;
    const unsigned ldsw = (unsigned)wid * 1024u;
    const int aoff = lds_byte(wr * 64 + fr, fq * 8), boff = lds_byte(wc * 32 + fr, fq * 8);
#define PG8_SA(b, h) (((b) * 2 + (h)) * HTB)
#define PG8_SB(b, h) ((4 + (b) * 2 + (h)) * HTB)
#define PG8_STAGE(bufoff, gbase, voff) do { _Pragma("unroll") for (int _i = 0; _i < 2; ++_i) \
        __builtin_amdgcn_global_load_lds((const unsigned*)((const char*)(gbase) + (voff)[_i]), (PG8_LAS unsigned*)(lds + (bufoff) + ldsw + _i * 8192), 16, 0, 0); } while (0)
#define PG8_LDA(dst, b, h) do { _Pragma("unroll") for (int m = 0; m < 4; ++m) _Pragma("unroll") for (int k = 0; k < 2; ++k) dst[m][k] = *(const PG8_LAS bf16x8*)(lds + PG8_SA(b, h) + aoff + m * 2048 + k * 1024); } while (0)
#define PG8_LDB(dst, b, h) do { _Pragma("unroll") for (int n = 0; n < 2; ++n) _Pragma("unroll") for (int k = 0; k < 2; ++k) dst[n][k] = *(const PG8_LAS bf16x8*)(lds + PG8_SB(b, h) + boff + n * 2048 + k * 1024); } while (0)
#define PG8_MMA(ai, bj, At, Bt) do { __builtin_amdgcn_s_setprio(1); _Pragma("unroll") for (int m = 0; m < 4; ++m) _Pragma("unroll") for (int n = 0; n < 2; ++n) _Pragma("unroll") for (int k = 0; k < 2; ++k) \
        acc[ai][bj][m][n] = __builtin_amdgcn_mfma_f32_16x16x32_bf16(Bt[n][k], At[m][k], acc[ai][bj][m][n], 0, 0, 0); __builtin_amdgcn_s_setprio(0); } while (0)
#define PG8_WAIT_V(n) asm volatile("s_waitcnt vmcnt(" #n ")" ::: "memory")
#define PG8_WAIT_L(n) asm volatile("s_waitcnt lgkmcnt(" #n ")" ::: "memory")
#define PG8_BAR __builtin_amdgcn_s_barrier()
#define PG8_SCHED __builtin_amdgcn_sched_barrier(0)
    Unit cur, nxt; int ui = 0;
    if (!S.next(0, cur)) return;
    f32x4 acc[2][2][4][2];
#pragma unroll
    for (int a = 0; a < 2; ++a)
#pragma unroll
        for (int b = 0; b < 2; ++b)
#pragma unroll
            for (int m = 0; m < 4; ++m)
#pragma unroll
                for (int n = 0; n < 2; ++n) acc[a][b][m][n] = (f32x4){0.f, 0.f, 0.f, 0.f};
    bf16x8 At[4][2], B0[2][2], B1[2][2];
    const char* cA = (const char*)g.A + (size_t)cur.pm * tstep; const char* cB = (const char*)g.Bt + (size_t)cur.pn * tstep;
    S.a_ready(cur);
    if constexpr (SP2) {
        PG8_STAGE(PG8_SB(0, 0), cB, voffB); PG8_STAGE(PG8_SB(0, 1), cB + hstep, voffB); PG8_STAGE(PG8_SA(0, 0), cA, voffA); PG8_STAGE(PG8_SA(0, 1), cA + hstep, voffA);
        if (wr == 1) PG8_BAR;
        PG8_WAIT_V(2); PG8_BAR;
        PG8_STAGE(PG8_SB(1, 0), cB + kstep, voffB); PG8_STAGE(PG8_SA(1, 0), cA + kstep, voffA); PG8_STAGE(PG8_SB(1, 1), cB + hstep + kstep, voffB);
        PG8_WAIT_V(6); PG8_BAR;
    } else {
        PG8_STAGE(PG8_SB(0, 0), cB, voffB); PG8_STAGE(PG8_SA(0, 0), cA, voffA); PG8_STAGE(PG8_SB(0, 1), cB + hstep, voffB); PG8_STAGE(PG8_SA(0, 1), cA + hstep, voffA);
        if (wr == 1) PG8_BAR;
        PG8_WAIT_V(4); PG8_BAR;
        PG8_STAGE(PG8_SB(1, 0), cB + kstep, voffB); PG8_STAGE(PG8_SA(1, 0), cA + kstep, voffA); PG8_STAGE(PG8_SB(1, 1), cB + hstep + kstep, voffB);
        PG8_WAIT_V(6); PG8_BAR;
    }
    for (;;) {
        const bool has_next = S.next(ui + 1, nxt);
        const char* nA = has_next ? (const char*)g.A + (size_t)nxt.pm * tstep : cA; const char* nB = has_next ? (const char*)g.Bt + (size_t)nxt.pn * tstep : cB;
        for (int t = 0; t < nt; t += 2) {
            if constexpr (Epi::MID) { if (t == Epi::MID_T0 || t == Epi::MID_T1) E.mid(acc, cur, t, wr, wc, fr, fq); }
            const bool last = (t == nt - 2);
            const char* a1 = cA + (size_t)(t + 1) * kstep;
            const char* a2 = last ? nA : cA + (size_t)(t + 2) * kstep; const char* b2 = last ? nB : cB + (size_t)(t + 2) * kstep;
            const char* a3 = a2 + kstep; const char* b3 = b2 + kstep;
            if (last && has_next) S.a_ready(nxt);
            if constexpr (SP2) {
            PG8_LDB(B0, 0, 0); PG8_LDB(B1, 0, 1); PG8_SCHED; PG8_LDA(At, 0, 0); PG8_STAGE(PG8_SA(1, 1), a1 + hstep, voffA);
            PG8_WAIT_V(8); PG8_WAIT_L(0); PG8_BAR; PG8_MMA(0, 0, At, B0); PG8_MMA(0, 1, At, B1); PG8_BAR; PG8_SCHED;
            PG8_LDA(At, 0, 1); PG8_STAGE(PG8_SB(0, 0), b2, voffB); PG8_STAGE(PG8_SB(0, 1), b2 + hstep, voffB); PG8_STAGE(PG8_SA(0, 0), a2, voffA);
            PG8_WAIT_V(8); PG8_WAIT_L(0); PG8_BAR; PG8_MMA(1, 0, At, B0); PG8_MMA(1, 1, At, B1); PG8_BAR; PG8_SCHED;
            PG8_LDB(B0, 1, 0); PG8_LDB(B1, 1, 1); PG8_SCHED; PG8_LDA(At, 1, 0); PG8_STAGE(PG8_SA(0, 1), a2 + hstep, voffA);
            PG8_WAIT_V(8); PG8_WAIT_L(0); PG8_BAR; PG8_MMA(0, 0, At, B0); PG8_MMA(0, 1, At, B1); PG8_BAR; PG8_SCHED;
            PG8_LDA(At, 1, 1); PG8_STAGE(PG8_SB(1, 0), b3, voffB); PG8_STAGE(PG8_SB(1, 1), b3 + hstep, voffB); PG8_STAGE(PG8_SA(1, 0), a3, voffA);
            PG8_WAIT_V(8); PG8_WAIT_L(0); PG8_BAR; PG8_MMA(1, 0, At, B0); PG8_MMA(1, 1, At, B1); PG8_BAR; PG8_SCHED;
            } else {
            PG8_LDB(B0, 0, 0); PG8_SCHED; PG8_LDA(At, 0, 0); PG8_STAGE(PG8_SA(1, 1), a1 + hstep, voffA);
            PG8_WAIT_L(8); PG8_BAR; PG8_WAIT_L(0); PG8_MMA(0, 0, At, B0); PG8_BAR; PG8_SCHED;
            PG8_LDB(B1, 0, 1); PG8_STAGE(PG8_SB(0, 0), b2, voffB);
            PG8_BAR; PG8_WAIT_L(0); PG8_MMA(0, 1, At, B1); PG8_BAR;
            PG8_LDA(At, 0, 1); PG8_STAGE(PG8_SA(0, 0), a2, voffA);
            PG8_BAR; PG8_WAIT_L(0); PG8_MMA(1, 0, At, B0); PG8_BAR; PG8_SCHED;
            PG8_STAGE(PG8_SB(0, 1), b2 + hstep, voffB);
            PG8_WAIT_V(6); PG8_BAR; PG8_MMA(1, 1, At, B1); PG8_BAR;
            PG8_LDB(B0, 1, 0); PG8_SCHED; PG8_LDA(At, 1, 0); PG8_STAGE(PG8_SA(0, 1), a2 + hstep, voffA);
            PG8_WAIT_L(8); PG8_BAR; PG8_WAIT_L(0); PG8_MMA(0, 0, At, B0); PG8_BAR; PG8_SCHED;
            PG8_LDB(B1, 1, 1); PG8_STAGE(PG8_SB(1, 0), b3, voffB);
            PG8_BAR; PG8_WAIT_L(0); PG8_MMA(0, 1, At, B1); PG8_BAR;
            PG8_LDA(At, 1, 1); PG8_STAGE(PG8_SA(1, 0), a3, voffA);
            PG8_BAR; PG8_WAIT_L(0); PG8_MMA(1, 0, At, B0); PG8_BAR; PG8_SCHED;
            PG8_STAGE(PG8_SB(1, 1), b3 + hstep, voffB);
            PG8_WAIT_V(6); PG8_BAR; PG8_MMA(1, 1, At, B1); PG8_BAR;
            }
        }
        if constexpr (ALIGN_EPI) { if (wr == 0) PG8_BAR; }
        if constexpr (!Epi::AFTER_DRAIN) { E(acc, cur, wr, wc, fr, fq); S.done(cur); }
        if (!has_next) break;
#pragma unroll
        for (int a = 0; a < 2; ++a)
#pragma unroll
            for (int b = 0; b < 2; ++b)
#pragma unroll
                for (int m = 0; m < 4; ++m)
#pragma unroll
                    for (int n = 0; n < 2; ++n) acc[a][b][m][n] = (f32x4){0.f, 0.f, 0.f, 0.f};
        cur = nxt; cA = nA; cB = nB; ++ui;
        if constexpr (ALIGN_EPI) { if (wr == 1) PG8_BAR; }
    }
    PG8_WAIT_V(0);
    if constexpr (!ALIGN_EPI) { if (wr == 0) PG8_BAR; }
    PG8_BAR;
    if constexpr (Epi::AFTER_DRAIN) { E.fused(acc, cur, wr, wc, fr, fq, lds, wid, lane); S.done(cur); }
#undef PG8_SA
#undef PG8_SB
#undef PG8_STAGE
#undef PG8_LDA
#undef PG8_LDB
#undef PG8_MMA
#undef PG8_WAIT_V
#undef PG8_WAIT_L
#undef PG8_BAR
#undef PG8_SCHED
}
}
namespace pg8 {
__device__ __forceinline__ float sigm(float v) { return __builtin_amdgcn_rcpf(1.0f + __builtin_amdgcn_exp2f(-1.4426950408889634f * v)); }
struct EpiProj {
    static constexpr bool PERM = true, AFTER_DRAIN = false, MID = false; static constexpr int MID_T0 = -1, MID_T1 = -1;
    bf16_t* O; int ldc; float qscale; const float* rs;
    __device__ __forceinline__ void operator()(const f32x4 (&acc)[2][2][4][2], const Unit& u, int wr, int wc, int fr, int fq) const {
        const int row0 = u.pm * BM + wr * 64 + fr, col0 = u.pn * BM + wc * 32 + 8 * fq;
        const int mode = (u.pn >= 32) ? 3 : (u.pn >= 28 ? 2 : ((u.pn >= 4 && u.pn < 8) ? 1 : 0));
        const float sc = mode == 1 ? qscale : 1.f;
#pragma unroll
        for (int ai = 0; ai < 2; ++ai)
#pragma unroll
            for (int m = 0; m < 4; ++m) { bf16_t* rowp = O + (size_t)(row0 + ai * HALF + m * 16) * ldc + col0; const float rr = rs[row0 + ai * HALF + m * 16];
#pragma unroll
                for (int bj = 0; bj < 2; ++bj) { f32x4 v0 = acc[ai][bj][m][0] * rr, v1 = acc[ai][bj][m][1] * rr;
                    if (mode >= 2) {
#pragma unroll
                        for (int j = 0; j < 4; ++j) { const float s0 = sigm(v0[j]), s1 = sigm(v1[j]); v0[j] = mode == 3 ? s0 : v0[j] * s0; v1[j] = mode == 3 ? s1 : v1[j] * s1; }
                    } else { v0 = v0 * sc; v1 = v1 * sc; }
                    u32x4 w; w.x = cvt_pk_bf16(v0[0], v0[1]); w.y = cvt_pk_bf16(v0[2], v0[3]); w.z = cvt_pk_bf16(v1[0], v1[1]); w.w = cvt_pk_bf16(v1[2], v1[3]);
                    *(u32x4*)(rowp + bj * HALF) = w; } }
    }
};
struct EpiRelu2 {
    static constexpr bool PERM = true, AFTER_DRAIN = false, MID = false; static constexpr int MID_T0 = -1, MID_T1 = -1;
    bf16_t* O; int ldc; const float* rs;
    __device__ __forceinline__ void operator()(const f32x4 (&acc)[2][2][4][2], const Unit& u, int wr, int wc, int fr, int fq) const {
        const int row0 = u.pm * BM + wr * 64 + fr, col0 = u.pn * BM + wc * 32 + 8 * fq;
#pragma unroll
        for (int ai = 0; ai < 2; ++ai)
#pragma unroll
            for (int m = 0; m < 4; ++m) { bf16_t* rowp = O + (size_t)(row0 + ai * HALF + m * 16) * ldc + col0; const float rr = rs[row0 + ai * HALF + m * 16];
#pragma unroll
                for (int bj = 0; bj < 2; ++bj) { f32x4 v0 = acc[ai][bj][m][0], v1 = acc[ai][bj][m][1];
#pragma unroll
                    for (int j = 0; j < 4; ++j) { const float a = __builtin_fmaxf(v0[j], 0.f) * rr, b = __builtin_fmaxf(v1[j], 0.f) * rr; v0[j] = a * a; v1[j] = b * b; }
                    u32x4 w; w.x = cvt_pk_bf16(v0[0], v0[1]); w.y = cvt_pk_bf16(v0[2], v0[3]); w.z = cvt_pk_bf16(v1[0], v1[1]); w.w = cvt_pk_bf16(v1[2], v1[3]);
                    *(u32x4*)(rowp + bj * HALF) = w; } }
    }
};
struct EpiSq {
    static constexpr bool PERM = true, AFTER_DRAIN = false, MID = false; static constexpr int MID_T0 = -1, MID_T1 = -1;
    bf16_t* O; int ldc; float* part;
    __device__ __forceinline__ void operator()(const f32x4 (&acc)[2][2][4][2], const Unit& u, int wr, int wc, int fr, int fq) const {
        const int row0 = u.pm * BM + wr * 64 + fr, col0 = u.pn * BM + wc * 32 + 8 * fq;
#pragma unroll
        for (int ai = 0; ai < 2; ++ai)
#pragma unroll
            for (int m = 0; m < 4; ++m) { const int row = row0 + ai * HALF + m * 16; bf16_t* rowp = O + (size_t)row * ldc + col0; float ss = 0.f;
#pragma unroll
                for (int bj = 0; bj < 2; ++bj) { const f32x4 v0 = acc[ai][bj][m][0], v1 = acc[ai][bj][m][1];
                    ss += (v0[0] * v0[0] + v0[1] * v0[1]) + (v0[2] * v0[2] + v0[3] * v0[3]) + (v1[0] * v1[0] + v1[1] * v1[1]) + (v1[2] * v1[2] + v1[3] * v1[3]);
                    u32x4 w; w.x = cvt_pk_bf16(v0[0], v0[1]); w.y = cvt_pk_bf16(v0[2], v0[3]); w.z = cvt_pk_bf16(v1[0], v1[1]); w.w = cvt_pk_bf16(v1[2], v1[3]);
                    *(u32x4*)(rowp + bj * HALF) = w; }
                ss += __shfl_xor(ss, 16); ss += __shfl_xor(ss, 32);
                if (fq == 0) part[(size_t)row * 32 + u.pn * 4 + wc] = ss; }
    }
};
struct EpiWiden {
    static constexpr bool PERM = true, AFTER_DRAIN = false, MID = true; static constexpr int MID_T0 = 16, MID_T1 = 32;
    bf16_t* O; int ldc; const bf16_t* G; int ldg;
    __device__ __forceinline__ void mid(f32x4 (&acc)[2][2][4][2], const Unit& u, int t, int wr, int wc, int fr, int fq) const {
        const int row0 = u.pm * BM + wr * 64 + fr, col0 = u.pn * BM + wc * 32 + 8 * fq;
        const bf16_t* gp = G + (t == MID_T0 ? 0 : 2048) + col0 + (size_t)row0 * ldg;
#pragma unroll
        for (int ai = 0; ai < 2; ++ai)
#pragma unroll
            for (int m = 0; m < 4; ++m) {
#pragma unroll
                for (int bj = 0; bj < 2; ++bj) { const bf16_t* p = gp + (size_t)(ai * HALF + m * 16) * ldg + bj * HALF; const u32x4 ga = *(const u32x4*)p, gb = *(const u32x4*)(p + 2048);
#pragma unroll
                    for (int k = 0; k < 4; ++k) { const float a0 = __builtin_bit_cast(float, ga[k] << 16), a1 = __builtin_bit_cast(float, ga[k] & 0xffff0000u);
                        const float b0 = __builtin_fmaxf(__builtin_bit_cast(float, gb[k] << 16), 1e-30f), b1 = __builtin_fmaxf(__builtin_bit_cast(float, gb[k] & 0xffff0000u), 1e-30f);
                        const float r0 = a0 * __builtin_amdgcn_rcpf(b0), r1 = a1 * __builtin_amdgcn_rcpf(b1);
                        acc[ai][bj][m][k >> 1][(k & 1) * 2] *= r0; acc[ai][bj][m][k >> 1][(k & 1) * 2 + 1] *= r1; }
                    asm volatile("" : "+v"(acc[ai][bj][m][0]), "+v"(acc[ai][bj][m][1]) :: "memory"); } }
    }
    __device__ __forceinline__ void operator()(const f32x4 (&acc)[2][2][4][2], const Unit& u, int wr, int wc, int fr, int fq) const {
        const int row0 = u.pm * BM + wr * 64 + fr, col0 = u.pn * BM + wc * 32 + 8 * fq;
        const bf16_t* Gc = G + 4096 + col0;
#pragma unroll
        for (int ai = 0; ai < 2; ++ai)
#pragma unroll
            for (int m = 0; m < 4; ++m) { const size_t ro = (size_t)(row0 + ai * HALF + m * 16) * ldg; bf16_t* rowp = O + (size_t)(row0 + ai * HALF + m * 16) * ldc + col0;
#pragma unroll
                for (int bj = 0; bj < 2; ++bj) { const u32x4 gc = *(const u32x4*)(Gc + ro + bj * HALF); f32x4 v0 = acc[ai][bj][m][0], v1 = acc[ai][bj][m][1];
                    v0[0] *= __builtin_bit_cast(float, gc[0] << 16); v0[1] *= __builtin_bit_cast(float, gc[0] & 0xffff0000u); v0[2] *= __builtin_bit_cast(float, gc[1] << 16); v0[3] *= __builtin_bit_cast(float, gc[1] & 0xffff0000u);
                    v1[0] *= __builtin_bit_cast(float, gc[2] << 16); v1[1] *= __builtin_bit_cast(float, gc[2] & 0xffff0000u); v1[2] *= __builtin_bit_cast(float, gc[3] << 16); v1[3] *= __builtin_bit_cast(float, gc[3] & 0xffff0000u);
                    u32x4 w; w.x = cvt_pk_bf16(v0[0], v0[1]); w.y = cvt_pk_bf16(v0[2], v0[3]); w.z = cvt_pk_bf16(v1[0], v1[1]); w.w = cvt_pk_bf16(v1[2], v1[3]);
                    *(u32x4*)(rowp + bj * HALF) = w; } }
    }
};
}
#define DUPMASK 0
#ifndef GEMM_ALIGN
#define GEMM_ALIGN true
#endif
#ifndef GEMM_SP2
#define GEMM_SP2 true
#endif
constexpr int NWAVES = 8;
constexpr bool SINGLE_LAUNCH = 1;
constexpr int BATCH = 4, SEQ = 4096, DM = 2048, DEPTH = 4, MIXW = 1024, M = BATCH * SEQ, INC = 14336, DFF = 8192;
constexpr int LDP = INC;
constexpr int C_POOL = 0, C_QD = 1024, C_KD = 2048, C_VD = 3072, C_QR = 4096, C_KR = 5120, C_VR = 6144, C_GR = 7168, C_GATE = 8192;
constexpr int LDY = 3072;
constexpr float NORM_EPS = 1e-6f;
constexpr float LOG2E = 1.4426950408889634f;
constexpr float QSCALE = 0.125f * 1.4426950408889634f;
constexpr float RET_KSCALE = 0.08838834764831845f;

constexpr size_t MiB = 1u << 20;
constexpr size_t WS_CTL = 0, CTL_ZERO_BYTES = 1 * MiB;
constexpr size_t WS_ROT = 1 * MiB;
constexpr size_t WS_STAT = 3 * MiB;
constexpr size_t WS_POOLT = 5 * MiB;
constexpr size_t WS_RS = 7 * MiB;
constexpr size_t WS_WIN = 8 * MiB;
constexpr size_t WS_WB = WS_WIN + 224 * MiB;
constexpr size_t WS_WO = WS_WB + 48 * MiB;
constexpr size_t WS_WUP = WS_WO + 32 * MiB;
constexpr size_t WS_WDN = WS_WUP + 128 * MiB;
constexpr size_t WS_XN = WS_WDN + 128 * MiB;
constexpr size_t WS_MRG = WS_XN + 64 * MiB;
constexpr size_t WS_MIX = WS_MRG + 64 * MiB;
constexpr size_t WS_Y = WS_MIX + 64 * MiB;
constexpr size_t WS_KV = WS_Y + 96 * MiB;
constexpr size_t WS_SST = WS_KV + 64 * MiB;
constexpr size_t WS_PROJ = WS_SST + 32 * MiB;
constexpr size_t WS_END = WS_PROJ + 448 * MiB;

constexpr int CW_BAR = 4096;

constexpr int RING_BYTES = 131072;
constexpr int LDSCTL_OFF = 135168, MISC_OFF = LDSCTL_OFF + 320;
constexpr int LDS_BYTES = 147456;

#define GAS __attribute__((address_space(1)))
#define LAS __attribute__((address_space(3)))
typedef unsigned short bf16;
typedef unsigned v4u __attribute__((ext_vector_type(4)));
typedef unsigned v2u __attribute__((ext_vector_type(2)));
typedef float f32x4 __attribute__((ext_vector_type(4)));
typedef float f32x2 __attribute__((ext_vector_type(2)));
typedef float f32x16 __attribute__((ext_vector_type(16)));
typedef short bf16x8 __attribute__((ext_vector_type(8)));
typedef short s16x4 __attribute__((ext_vector_type(4)));
typedef GAS unsigned gu32;
#define RLX_AGENT __ATOMIC_RELAXED, __HIP_MEMORY_SCOPE_AGENT
#define LDS_WAIT() asm volatile("s_waitcnt lgkmcnt(0)" ::: "memory")
#define VM_WAIT() asm volatile("s_waitcnt vmcnt(0)" ::: "memory")
#define WG_BAR() do { asm volatile("s_waitcnt vmcnt(0) lgkmcnt(0)" ::: "memory"); __builtin_amdgcn_s_barrier(); asm volatile("" ::: "memory"); } while (0)

typedef float f32x2_t_ __attribute__((ext_vector_type(2))); typedef __bf16 bf16x2_t_ __attribute__((ext_vector_type(2)));
__device__ __forceinline__ unsigned pk2(float lo, float hi) { f32x2_t_ v = {lo, hi}; bf16x2_t_ b = __builtin_convertvector(v, bf16x2_t_); return __builtin_bit_cast(unsigned, b); }
__device__ __forceinline__ float bflo(unsigned w) { return __builtin_bit_cast(float, w << 16); }
__device__ __forceinline__ float bfhi(unsigned w) { return __builtin_bit_cast(float, w & 0xffff0000u); }
__device__ __forceinline__ float wave_sum(float v) {
#pragma unroll
    for (int o = 1; o < 64; o <<= 1) v += __shfl_xor(v, o);
    return v;
}
__device__ __forceinline__ void half_swap(unsigned& a, unsigned& b) { asm volatile("s_nop 1\n\tv_permlane32_swap_b32 %0, %1\n\ts_nop 1" : "+v"(a), "+v"(b)); }
__device__ __forceinline__ float half_swap_max(float m) { unsigned a = __builtin_bit_cast(unsigned, m), b = a; half_swap(a, b); return __builtin_fmaxf(__builtin_bit_cast(float, a), __builtin_bit_cast(float, b)); }
__device__ __forceinline__ float half_swap_sum(float m) { unsigned a = __builtin_bit_cast(unsigned, m), b = a; half_swap(a, b); return __builtin_bit_cast(float, a) + __builtin_bit_cast(float, b); }
__device__ __forceinline__ int crow(int r, int hi) { return (r & 3) + 8 * (r >> 2) + 4 * hi; }
__device__ __forceinline__ int swap23(int i) { return (i & 0x13) | ((i & 4) << 1) | ((i & 8) >> 1); }
__device__ __forceinline__ unsigned offb(int row, int ch) { return 256u * (unsigned)row + 16u * (unsigned)(ch ^ (((row & 3) << 2) | ((row >> 2) & 3))); }
__device__ __forceinline__ unsigned tr_off(int lane, int c, int t) { const int h = lane >> 5, blk = (lane >> 4) & 1, q = (lane & 15) >> 2, p = lane & 3; return offb(8 * h + 4 * t + q, 4 * c + 2 * blk + (p >> 1)) + 8u * (unsigned)(p & 1); }
typedef short v4i16_t __attribute__((ext_vector_type(4)));
__device__ __forceinline__ s16x4 ldtr(LAS unsigned char* p) { return __builtin_bit_cast(s16x4, __builtin_amdgcn_ds_read_tr16_b64_v4i16((LAS v4i16_t*)p)); }
__device__ __forceinline__ bf16x8 trfrag(LAS unsigned char* tile, unsigned o0, unsigned o1) { const s16x4 a = ldtr(tile + o0), b = ldtr(tile + o1); return (bf16x8){a[0], a[1], a[2], a[3], b[0], b[1], b[2], b[3]}; }
__device__ __forceinline__ void glds16(const void* gsrc, LAS unsigned char* dst) { __builtin_amdgcn_global_load_lds((const unsigned*)gsrc, (LAS unsigned*)dst, 16, 0, 0); }
__device__ __forceinline__ void glds16_asm(const void* gsrc, LAS unsigned char* dst) { unsigned keep; const unsigned d = (unsigned)__builtin_amdgcn_readfirstlane((int)(unsigned)(size_t)dst);
    asm volatile("s_mov_b32 %0, m0\n\ts_mov_b32 m0, %2\n\ts_nop 0\n\tglobal_load_lds_dwordx4 %1, off\n\ts_mov_b32 m0, %0" : "=&s"(keep) : "v"(gsrc), "s"(d) : "memory"); }
__device__ __forceinline__ f32x16 splat16(float v) { f32x16 r;
#pragma unroll
    for (int i = 0; i < 16; ++i) r[i] = v; return r; }
#define MFMA32(a, b, c) __builtin_amdgcn_mfma_f32_32x32x16_bf16((a), (b), (c), 0, 0, 0)

__device__ __constant__ const float kLog2Gamma[8] = {-0.04580368961312479f, -0.02272007650008353f, -0.011315313227834146f, -0.005646563141142063f, -0.0028205190623786626f, -0.0014095702546713536f, -0.0007046129765893727f, -0.0003522634716290214f};
__device__ __forceinline__ int t5_bucket(int n) {
    if (n < 16) return n;
    if (n >= 113) return 31;
    int b = 16;
    b += (n >= 19); b += (n >= 21); b += (n >= 24); b += (n >= 27); b += (n >= 31); b += (n >= 35); b += (n >= 40); b += (n >= 46);
    b += (n >= 52); b += (n >= 59); b += (n >= 67); b += (n >= 77); b += (n >= 87); b += (n >= 99);
    return b;
}

__device__ __forceinline__ void p0_transpose_item(const float* W, int N, bf16* WT, int ldt, int koff, LAS float* scr, int item, int lane, const float* gain = nullptr) {
    const int nblk = N / 32, kb = item / nblk, nb = item % nblk, k0 = 64 * kb, n0 = 32 * nb;
#pragma unroll 8
    for (int i = 0; i < 32; ++i) { const int kk = 2 * i + (lane >> 5); scr[kk * 33 + (lane & 31)] = W[(size_t)(k0 + kk) * N + n0 + (lane & 31)]; }
    LDS_WAIT(); asm volatile("" ::: "memory");
    const int c = lane & 7;
    f32x4 ga = {1.f, 1.f, 1.f, 1.f}, gb = ga; if (gain) { ga = *(const GAS f32x4*)(gain + k0 + 8 * c); gb = *(const GAS f32x4*)(gain + k0 + 8 * c + 4); }
#pragma unroll
    for (int j = 0; j < 4; ++j) { const int n = (lane >> 3) + 8 * j; const LAS float* s = scr + (8 * c) * 33 + n;
        v4u o; o.x = pk2(s[0 * 33] * ga.x, s[1 * 33] * ga.y); o.y = pk2(s[2 * 33] * ga.z, s[3 * 33] * ga.w); o.z = pk2(s[4 * 33] * gb.x, s[5 * 33] * gb.y); o.w = pk2(s[6 * 33] * gb.z, s[7 * 33] * gb.w);
        *(GAS v4u*)(WT + (size_t)(n0 + n) * ldt + koff + k0 + 8 * c) = o; }
    LDS_WAIT(); asm volatile("" ::: "memory");
}
__device__ __forceinline__ void prep_row(const float* xrow, bf16* orow, float* rs, int lane) {
    const GAS f32x4* xr = (const GAS f32x4*)xrow + lane;
    f32x4 v[8]; float s = 0.f;
#pragma unroll
    for (int j = 0; j < 8; ++j) { v[j] = xr[64 * j]; s += (v[j].x * v[j].x + v[j].y * v[j].y) + (v[j].z * v[j].z + v[j].w * v[j].w); }
    s = wave_sum(s);
    GAS v2u* o8 = (GAS v2u*)orow + lane;
#pragma unroll
    for (int j = 0; j < 8; ++j) { v2u w; w.x = pk2(v[j].x, v[j].y); w.y = pk2(v[j].z, v[j].w); o8[64 * j] = w; }
    if (lane == 0) *rs = 1.f / sqrtf(s * (1.f / DM) + NORM_EPS);
}
__device__ __forceinline__ void resid_row(bf16* xrow, const bf16* yrow, const float* part, const float* gpost, float* rs, float* fout, int lane, bf16* xdst = nullptr) {
    GAS v2u* xr = (GAS v2u*)xrow + lane; GAS v2u* xw = xdst ? (GAS v2u*)xdst + lane : xr; const GAS v2u* yr = (const GAS v2u*)yrow + lane; const GAS f32x4* gp = (const GAS f32x4*)gpost + lane;
    float ps = (lane < 32) ? part[lane] : 0.f; ps = wave_sum(ps);
    const float rs1 = 1.f / sqrtf(ps * (1.f / DM) + NORM_EPS);
    f32x4 v[8]; float s = 0.f;
#pragma unroll
    for (int j = 0; j < 8; ++j) { const v2u x = xr[64 * j]; const v2u y = yr[64 * j]; const f32x4 g = gp[64 * j];
        v[j].x = bflo(x.x) + bflo(y.x) * rs1 * g.x; v[j].y = bfhi(x.x) + bfhi(y.x) * rs1 * g.y; v[j].z = bflo(x.y) + bflo(y.y) * rs1 * g.z; v[j].w = bfhi(x.y) + bfhi(y.y) * rs1 * g.w;
        s += (v[j].x * v[j].x + v[j].y * v[j].y) + (v[j].z * v[j].z + v[j].w * v[j].w); }
    if (fout) { GAS f32x4* xo = (GAS f32x4*)fout + lane;
#pragma unroll
        for (int j = 0; j < 8; ++j) xo[64 * j] = v[j]; }
    else { s = wave_sum(s);
#pragma unroll
        for (int j = 0; j < 8; ++j) { v2u w; w.x = pk2(v[j].x, v[j].y); w.y = pk2(v[j].z, v[j].w); xw[64 * j] = w; }
        if (lane == 0) *rs = 1.f / sqrtf(s * (1.f / DM) + NORM_EPS); }
}

__device__ __forceinline__ void pool_unit(LAS unsigned char* lds, const bf16* proj, const bf16* poolT, const float* pscale, bf16* Y, int tb, int g, int tid, int lane, int wid) {
    asm volatile("" : "+v"(tid)); lane = tid & 63;
    const int win = 2 << g, hi = lane >> 5, r32 = lane & 31;
    const int t0 = tb * 128;
    bf16x8 bfr[16];
    { const bf16* bp = poolT + ((size_t)g * 256 + 32 * wid + r32) * 256 + 8 * hi;
#pragma unroll
      for (int s = 0; s < 16; ++s) bfr[s] = *(const GAS bf16x8*)(bp + 16 * s); }
    { const int cc = tid & 31, tsb = tid >> 5;
      const bf16* up = proj + (size_t)t0 * LDP + C_POOL + g * 256 + cc * 8;
      const int pos0 = (t0 & (SEQ - 1)) + tsb * 8;
      float aw[8];
#pragma unroll
      for (int e = 0; e < 8; ++e) aw[e] = 0.f;
      for (int j = 1; j < win; ++j) { if (pos0 - j >= 0) { const v4u w = *(const GAS v4u*)(up + (long)(tsb * 8 - j) * LDP);
          aw[0] += bflo(w.x); aw[1] += bfhi(w.x); aw[2] += bflo(w.y); aw[3] += bfhi(w.y); aw[4] += bflo(w.z); aw[5] += bfhi(w.z); aw[6] += bflo(w.w); aw[7] += bfhi(w.w); } }
#pragma unroll
      for (int tt = 0; tt < 8; ++tt) {
          const int pos = pos0 + tt; const v4u w = *(const GAS v4u*)(up + (long)(tsb * 8 + tt) * LDP);
          float cu[8] = {bflo(w.x), bfhi(w.x), bflo(w.y), bfhi(w.y), bflo(w.z), bfhi(w.z), bflo(w.w), bfhi(w.w)};
#pragma unroll
          for (int e = 0; e < 8; ++e) aw[e] += cu[e];
          const float inv = 1.f / (float)(pos + 1 < win ? pos + 1 : win);
          v4u o; o.x = pk2(aw[0] * inv - cu[0], aw[1] * inv - cu[1]); o.y = pk2(aw[2] * inv - cu[2], aw[3] * inv - cu[3]); o.z = pk2(aw[4] * inv - cu[4], aw[5] * inv - cu[5]); o.w = pk2(aw[6] * inv - cu[6], aw[7] * inv - cu[7]);
          *(LAS v4u*)(lds + cc * 2048 + (tsb * 8 + tt) * 16) = o;
          if (pos - (win - 1) >= 0) { const v4u z = *(const GAS v4u*)(up + (long)(tsb * 8 + tt - (win - 1)) * LDP);
              aw[0] -= bflo(z.x); aw[1] -= bfhi(z.x); aw[2] -= bflo(z.y); aw[3] -= bfhi(z.y); aw[4] -= bflo(z.z); aw[5] -= bfhi(z.z); aw[6] -= bflo(z.w); aw[7] -= bfhi(z.w); }
      } }
    WG_BAR();
    f32x16 acc[4];
#pragma unroll
    for (int k = 0; k < 4; ++k) acc[k] = splat16(0.f);
#pragma unroll
    for (int s = 0; s < 16; ++s)
#pragma unroll
        for (int k = 0; k < 4; ++k) { const bf16x8 a = *(const LAS bf16x8*)(lds + (2 * s + hi) * 2048 + (32 * k + r32) * 16); acc[k] = MFMA32(a, bfr[s], acc[k]); }
    const int oc = g * 256 + 32 * wid + r32; const float ps = pscale[oc];
#pragma unroll
    for (int k = 0; k < 4; ++k)
#pragma unroll
        for (int r = 0; r < 16; ++r) { const int tok = 32 * k + crow(r, hi); Y[(size_t)(t0 + tok) * LDY + oc] = (bf16)(pk2(acc[k][r] * ps, 0.f) & 0xffffu); }
    WG_BAR();
}

#ifndef ATT_UNROLL2
#define ATT_UNROLL2 0
#endif
__device__ __forceinline__ void attn_unit(LAS unsigned char* lds, const bf16* proj, bf16* Y, const float* relb, const float* hgain, float lam, float oscale, int b, int h, int qb, int tid, int lane, int wid) {
    asm volatile("" : "+v"(tid)); lane = tid & 63;
    const int r32 = lane & 31, hi = lane >> 5, mp = wid >> 2, wq = wid & 3;
    const int q0 = qb * 128, qw = q0 + 32 * wq;
    const size_t rowbase = (size_t)b * SEQ;
    LAS float* tab = (LAS float*)(lds + 98304);
    if (tid < 129) tab[tid] = relb[t5_bucket(tid) * 8 + h] * LOG2E;
    const float bias31 = relb[31 * 8 + h] * LOG2E;
    LAS unsigned char* qlds = lds + 100352 + wid * 4096 + hi * 512 + r32 * 16;
    { const bf16* qp = proj + (rowbase + qw + r32) * LDP + C_QD + h * 128 + mp * 64 + hi * 8;
#pragma unroll
      for (int d0 = 0; d0 < 4; ++d0) *(LAS bf16x8*)(qlds + d0 * 1024) = *(const GAS bf16x8*)(qp + d0 * 16); }
    const bf16* k0src = proj + (rowbase + (lane & 32) + swap23(r32)) * LDP + C_KD + h * 128 + wid * 8;
    const bf16* k1src = k0src + 64;
    const bf16* vsrc[2];
#pragma unroll
    for (int i = 0; i < 2; ++i) { const int vrow = 8 * wid + 4 * i + (lane >> 4); const int ch = (lane & 15) ^ (((vrow & 3) << 2) | ((vrow >> 2) & 3)); vsrc[i] = proj + (rowbase + vrow) * LDP + C_VD + h * 128 + ch * 8; }
#define ATT_DMA(t, sb_) do { const size_t ko_ = (size_t)(t) * 64 * LDP; \
        glds16_asm(k0src + ko_, (sb_) + wid * 1024); glds16_asm(k1src + ko_, (sb_) + 8192 + wid * 1024); glds16_asm(vsrc[0] + ko_, (sb_) + 16384 + wid * 2048); glds16_asm(vsrc[1] + ko_, (sb_) + 16384 + wid * 2048 + 1024); } while (0)
    unsigned va[4][2];
#pragma unroll
    for (int c = 0; c < 4; ++c) { va[c][0] = 16384u + tr_off(lane, c, 0); va[c][1] = 16384u + tr_off(lane, c, 1); }
    const unsigned kboff = mp * 8192 + hi * 1024 + r32 * 16;
    const int NT = 2 * qb + 2;
    ATT_DMA(0, lds); ATT_DMA(1, lds + 32768);
    float m_run = -1e30f, l_run = 0.f;
    f32x16 o[4];
#pragma unroll
    for (int c = 0; c < 4; ++c) o[c] = splat16(0.f);
    const int qi = qw + r32;
#define ATT_QK(S0, S1, sbp, cin) do { S0 = splat16(cin); S1 = S0; \
        _Pragma("unroll") for (int d0 = 0; d0 < 4; ++d0) { const bf16x8 kf0_ = *(const LAS bf16x8*)((sbp) + kboff + d0 * 2048), kf1_ = *(const LAS bf16x8*)((sbp) + kboff + d0 * 2048 + 512), q_ = *(const LAS bf16x8*)(qlds + d0 * 1024); \
            S0 = MFMA32(kf0_, q_, S0); S1 = MFMA32(kf1_, q_, S1); } } while (0)
    WG_BAR();
    f32x16 sA0, sA1, sB0, sB1;
    typedef __bf16 bf2_t_ __attribute__((ext_vector_type(2)));
    const bf2_t_ one2 = __builtin_bit_cast(bf2_t_, 0x3F803F80u);
    { const bool far0 = (63 + 128 <= qw); ATT_QK(sA0, sA1, lds, far0 ? bias31 : 0.f);
      if (!far0) {
#pragma unroll
          for (int r = 0; r < 16; ++r) { const int key = 16 * (r >> 3) + 8 * hi + (r & 7); const int d0_ = qi - key, d1_ = d0_ - 32;
              const float b0 = tab[d0_ < 0 ? 0 : (d0_ > 128 ? 128 : d0_)], b1 = tab[d1_ < 0 ? 0 : (d1_ > 128 ? 128 : d1_)];
              sA0[r] = d0_ < 0 ? -1e30f : sA0[r] + b0; sA1[r] = d1_ < 0 ? -1e30f : sA1[r] + b1; } }
      float mt = __builtin_fmaxf(sA0[0], sA1[0]);
#pragma unroll
      for (int r = 1; r < 16; ++r) mt = __builtin_fmaxf(mt, __builtin_fmaxf(sA0[r], sA1[r]));
      mt = half_swap_max(mt); m_run = mt;
#pragma unroll
      for (int r = 0; r < 16; ++r) { sA0[r] -= mt; sA1[r] -= mt; } }
    int sc = 0, sn = 32768, sn2 = 65536;
#define SB() __builtin_amdgcn_sched_barrier(0)
#define EX2(P, i) do { P[i] = __builtin_amdgcn_exp2f(P[i]); P[(i) + 1] = __builtin_amdgcn_exp2f(P[(i) + 1]); } while (0)
#define MX4(P, i) __builtin_fmaxf(__builtin_fmaxf(P[i], P[(i) + 1]), __builtin_fmaxf(P[(i) + 2], P[(i) + 3]))
#define PK8(P, i) ({ v4u w_; w_.x = pk2(P[i], P[(i) + 1]); w_.y = pk2(P[(i) + 2], P[(i) + 3]); w_.z = pk2(P[(i) + 4], P[(i) + 5]); w_.w = pk2(P[(i) + 6], P[(i) + 7]); __builtin_bit_cast(bf16x8, w_); })
#define VRD(dst, ks) do { _Pragma("unroll") for (int c_ = 0; c_ < 4; ++c_) dst[c_] = trfrag(sb, va[c_][0] + 4096u * (ks), va[c_][1] + 4096u * (ks)); } while (0)
#define PVM(vf_, pk_) do { _Pragma("unroll") for (int c_ = 0; c_ < 4; ++c_) o[c_] = MFMA32(vf_[c_], pk_, o[c_]); } while (0)
#define DSUM(pk_) do { } while (0)
#define ATT_TILE(P0, P1, N0, N1, T) do { \
        if ((T) + 2 < NT) ATT_DMA((T) + 2, lds + sn2); \
        const int k0 = 64 * (T); \
        if (k0 <= qw + 31) { \
            LAS unsigned char* sb = lds + sc; LAS unsigned char* sbn = lds + sn; \
            if ((T) > 0 && !(k0 + 63 + 128 <= qw)) { \
                _Pragma("unroll") for (int r = 0; r < 16; ++r) { const int key = k0 + 16 * (r >> 3) + 8 * hi + (r & 7); const int d0_ = qi - key, d1_ = d0_ - 32; \
                    const float b0 = tab[d0_ < 0 ? 0 : (d0_ > 128 ? 128 : d0_)], b1 = tab[d1_ < 0 ? 0 : (d1_ > 128 ? 128 : d1_)]; \
                    P0[r] = d0_ < 0 ? -1e30f : P0[r] + b0; P1[r] = d1_ < 0 ? -1e30f : P1[r] + b1; } } \
            const bool farn = (k0 + 64 + 63 + 128 <= qw); const float cin = (farn ? bias31 : 0.f) - m_run; \
            N0 = splat16(cin); N1 = N0; bf16x8 kf[4], qf[2], vfA[4], vfB[4], pw0, pw1, pw2, pw3; \
            SB(); \
            _Pragma("unroll") for (int d0 = 0; d0 < 2; ++d0) { kf[2 * d0] = *(const LAS bf16x8*)(sbn + kboff + d0 * 2048); kf[2 * d0 + 1] = *(const LAS bf16x8*)(sbn + kboff + d0 * 2048 + 512); qf[d0] = *(const LAS bf16x8*)(qlds + d0 * 1024); } \
            SB(); \
            N0 = MFMA32(kf[0], qf[0], N0); EX2(P0, 0); EX2(P0, 2); SB(); \
            N1 = MFMA32(kf[1], qf[0], N1); EX2(P0, 4); EX2(P0, 6); SB(); \
            N0 = MFMA32(kf[2], qf[1], N0); EX2(P0, 8); EX2(P0, 10); SB(); \
            N1 = MFMA32(kf[3], qf[1], N1); EX2(P0, 12); EX2(P0, 14); SB(); \
            _Pragma("unroll") for (int d0 = 0; d0 < 2; ++d0) { kf[2 * d0] = *(const LAS bf16x8*)(sbn + kboff + (d0 + 2) * 2048); kf[2 * d0 + 1] = *(const LAS bf16x8*)(sbn + kboff + (d0 + 2) * 2048 + 512); qf[d0] = *(const LAS bf16x8*)(qlds + (d0 + 2) * 1024); } \
            EX2(P1, 0); EX2(P1, 2); SB(); \
            N0 = MFMA32(kf[0], qf[0], N0); EX2(P1, 4); EX2(P1, 6); SB(); \
            N1 = MFMA32(kf[1], qf[0], N1); EX2(P1, 8); EX2(P1, 10); SB(); \
            N0 = MFMA32(kf[2], qf[1], N0); EX2(P1, 12); EX2(P1, 14); SB(); \
            N1 = MFMA32(kf[3], qf[1], N1); VRD(vfA, 0); VRD(vfB, 1); SB(); \
            float mx = __builtin_fmaxf(__builtin_fmaxf(__builtin_fmaxf(MX4(P0, 0), MX4(P0, 4)), __builtin_fmaxf(MX4(P0, 8), MX4(P0, 12))), __builtin_fmaxf(__builtin_fmaxf(MX4(P1, 0), MX4(P1, 4)), __builtin_fmaxf(MX4(P1, 8), MX4(P1, 12)))); \
            if (__any(mx > 256.f)) {                                              \
                mx = half_swap_max(mx); const float big = __builtin_fmaxf(mx, 1.f); const float dl = __builtin_amdgcn_logf(big), f = __builtin_amdgcn_rcpf(big); m_run += dl; \
                _Pragma("unroll") for (int c = 0; c < 4; ++c) _Pragma("unroll") for (int r = 0; r < 16; ++r) o[c][r] *= f; \
                l_run *= f; _Pragma("unroll") for (int r = 0; r < 16; ++r) { P0[r] *= f; P1[r] *= f; N0[r] -= dl; N1[r] -= dl; } } \
            { float sm_ = 0.f; _Pragma("unroll") for (int r = 0; r < 16; ++r) sm_ += P0[r] + P1[r]; l_run += sm_; } \
            pw0 = PK8(P0, 0); pw1 = PK8(P0, 8); pw2 = PK8(P1, 0); pw3 = PK8(P1, 8); DSUM(pw0); DSUM(pw1); DSUM(pw2); DSUM(pw3); SB(); \
            PVM(vfA, pw0); SB(); \
            VRD(vfA, 2); SB(); \
            PVM(vfB, pw1); SB(); \
            VRD(vfB, 3); SB(); \
            PVM(vfA, pw2); SB(); \
            PVM(vfB, pw3); SB(); \
        } \
        { const int tmp = sc; sc = sn; sn = sn2; sn2 = tmp; } \
        WG_BAR(); } while (0)
#if ATT_UNROLL2
    for (int t = 0; t < NT; t += 2) { ATT_TILE(sA0, sA1, sB0, sB1, t); ATT_TILE(sB0, sB1, sA0, sA1, t + 1); }
#else
    for (int t = 0; t < NT; ++t) { ATT_TILE(sA0, sA1, sB0, sB1, t); sA0 = sB0; sA1 = sB1; }
#endif
#undef ATT_TILE
#undef SB
#undef EX2
#undef MX4
#undef PK8
#undef VRD
#undef PVM
#undef DSUM
#undef ATT_DMA
#undef ATT_QK
    l_run = half_swap_sum(l_run);
    const float inv = 1.f / l_run;
    LAS float* xch = (LAS float*)lds;
    if (mp == 1) {
#pragma unroll
        for (int c = 0; c < 4; ++c)
#pragma unroll
            for (int r = 0; r < 16; ++r) xch[((wq * 64 + c * 16 + r) << 6) + lane] = o[c][r] * inv;
    }
    WG_BAR();
    if (mp == 0) {
        float ss = 0.f;
#pragma unroll
        for (int c = 0; c < 4; ++c)
#pragma unroll
            for (int r = 0; r < 16; ++r) { const float d = o[c][r] * inv - lam * xch[((wq * 64 + c * 16 + r) << 6) + lane]; o[c][r] = d; ss += d * d; }
        ss = half_swap_sum(ss);
        const float rs = oscale / sqrtf(ss * (1.f / 128.f) + NORM_EPS);
        bf16* yp = Y + (rowbase + qi) * LDY + 1024 + h * 128;
#pragma unroll
        for (int c = 0; c < 4; ++c)
#pragma unroll
            for (int r4 = 0; r4 < 4; ++r4) { const int dv = 32 * c + 8 * r4 + 4 * hi; const f32x4 g = *(const GAS f32x4*)(hgain + dv);
                v2u w; w.x = pk2(o[c][4 * r4] * rs * g.x, o[c][4 * r4 + 1] * rs * g.y); w.y = pk2(o[c][4 * r4 + 2] * rs * g.z, o[c][4 * r4 + 3] * rs * g.w);
                *(GAS v2u*)(yp + dv) = w; }
    }
    WG_BAR();
}

template <int MODE  > __device__ __forceinline__ void ret_stage_rot(LAS unsigned char* tile, const bf16* src  , const f32x2* rot  , float sc, float l2g, int tid) {
#pragma unroll
    for (int i = 0; i < 2; ++i) { const int item = tid + 512 * i, j = item >> 3, cc = item & 7;
        const v4u lo = *(const GAS v4u*)(src + (size_t)j * LDP + 8 * cc), hh = *(const GAS v4u*)(src + (size_t)j * LDP + 64 + 8 * cc);
        const GAS f32x4* rp = (const GAS f32x4*)(rot + (size_t)j * 64 + 8 * cc);
        const f32x4 c0 = rp[0], c1 = rp[1], c2 = rp[2], c3 = rp[3];
        const float cs[8] = {c0.x, c0.z, c1.x, c1.z, c2.x, c2.z, c3.x, c3.z}, sn[8] = {c0.y, c0.w, c1.y, c1.w, c2.y, c2.w, c3.y, c3.w};
        const float a[8] = {bflo(lo.x), bfhi(lo.x), bflo(lo.y), bfhi(lo.y), bflo(lo.z), bfhi(lo.z), bflo(lo.w), bfhi(lo.w)};
        const float bb[8] = {bflo(hh.x), bfhi(hh.x), bflo(hh.y), bfhi(hh.y), bflo(hh.z), bfhi(hh.z), bflo(hh.w), bfhi(hh.w)};
        const float s = MODE == 1 ? sc * __builtin_amdgcn_exp2f((float)(127 - j) * l2g) : sc;
        float o1[8], o2[8];
#pragma unroll
        for (int e = 0; e < 8; ++e) { o1[e] = (a[e] * cs[e] - bb[e] * sn[e]) * s; o2[e] = (bb[e] * cs[e] + a[e] * sn[e]) * s; }
        v4u w; w.x = pk2(o1[0], o1[1]); w.y = pk2(o1[2], o1[3]); w.z = pk2(o1[4], o1[5]); w.w = pk2(o1[6], o1[7]); *(LAS v4u*)(tile + offb(j, cc)) = w;
        w.x = pk2(o2[0], o2[1]); w.y = pk2(o2[2], o2[3]); w.z = pk2(o2[4], o2[5]); w.w = pk2(o2[6], o2[7]); *(LAS v4u*)(tile + offb(j, cc + 8)) = w; }
}
__device__ __forceinline__ void ret_stage_plain(LAS unsigned char* tile, const bf16* src, int ld, int tid) {
#pragma unroll
    for (int i = 0; i < 4; ++i) { const int item = tid + 512 * i, row = item >> 4, ch = item & 15; *(LAS v4u*)(tile + offb(row, ch)) = *(const GAS v4u*)(src + (size_t)row * ld + 8 * ch); }
}
__device__ __forceinline__ void retA_unit(LAS unsigned char* lds, const bf16* proj, const f32x2* rot, float* KV, int u, int tid, int lane, int wid) {
    asm volatile("" : "+v"(tid)); lane = tid & 63;
    const int bh = u >> 5, c = u & 31, b = bh >> 3, h = bh & 7, hi = lane >> 5, r32 = lane & 31;
    const size_t t0 = (size_t)b * SEQ + c * 128; const float l2g = kLog2Gamma[h];
    ret_stage_rot<1>(lds, proj + t0 * LDP + C_KR + h * 128, rot + (size_t)c * 128 * 64, RET_KSCALE, l2g, tid);
    ret_stage_plain(lds + 32768, proj + t0 * LDP + C_VR + h * 128, LDP, tid);
    WG_BAR();
    const int db = wid & 3, eb0 = 2 * (wid >> 2);
    const unsigned a0 = tr_off(lane, db, 0), a1 = tr_off(lane, db, 1);
    unsigned b0[2], b1[2];
#pragma unroll
    for (int k = 0; k < 2; ++k) { b0[k] = 32768u + tr_off(lane, eb0 + k, 0); b1[k] = 32768u + tr_off(lane, eb0 + k, 1); }
    f32x16 acc[2] = {splat16(0.f), splat16(0.f)};
#pragma unroll
    for (int ks = 0; ks < 8; ++ks) { const bf16x8 A = trfrag(lds, a0 + 4096u * ks, a1 + 4096u * ks);
#pragma unroll
        for (int k = 0; k < 2; ++k) { const bf16x8 B = trfrag(lds, b0[k] + 4096u * ks, b1[k] + 4096u * ks); acc[k] = MFMA32(A, B, acc[k]); } }
    float* kvp = KV + (size_t)u * 16384;
#pragma unroll
    for (int k = 0; k < 2; ++k)
#pragma unroll
        for (int r = 0; r < 16; ++r) kvp[(32 * db + crow(r, hi)) * 128 + 32 * (eb0 + k) + r32] = acc[k][r];
    WG_BAR();
}
__device__ __forceinline__ void retC_unit(LAS unsigned char* lds, const bf16* proj, const f32x2* rot, const bf16* SST, bf16* Y, int u, int tid, int lane, int wid) {
    asm volatile("" : "+v"(tid)); lane = tid & 63;
    const int bh = u >> 5, c = u & 31, b = bh >> 3, h = bh & 7, hi = lane >> 5, r32 = lane & 31;
    const size_t t0 = (size_t)b * SEQ + c * 128; const float l2g = kLog2Gamma[h];
    ret_stage_rot<0>(lds, proj + t0 * LDP + C_QR + h * 128, rot + (size_t)c * 128 * 64, 1.f, 0.f, tid);
    ret_stage_rot<0>(lds + 32768, proj + t0 * LDP + C_KR + h * 128, rot + (size_t)c * 128 * 64, RET_KSCALE, 0.f, tid);
    ret_stage_plain(lds + 65536, proj + t0 * LDP + C_VR + h * 128, LDP, tid);
    if (c > 0) ret_stage_plain(lds + 98304, SST + (size_t)u * 16384, 128, tid);
    WG_BAR();
    const int ib = wid & 3, eh = wid >> 2, il = 32 * ib + r32;
    bf16x8 qf[8];
#pragma unroll
    for (int ks = 0; ks < 8; ++ks) qf[ks] = *(const LAS bf16x8*)(lds + offb(il, 2 * ks + hi));
    unsigned v0[2], v1[2];
#pragma unroll
    for (int k = 0; k < 2; ++k) { v0[k] = tr_off(lane, 2 * eh + k, 0); v1[k] = tr_off(lane, 2 * eh + k, 1); }
    f32x16 acc[2] = {splat16(0.f), splat16(0.f)};
    if (c > 0) {
#pragma unroll
        for (int ks = 0; ks < 8; ++ks)
#pragma unroll
            for (int k = 0; k < 2; ++k) { const bf16x8 A = trfrag(lds + 98304, v0[k] + 4096u * ks, v1[k] + 4096u * ks); acc[k] = MFMA32(A, qf[ks], acc[k]); }
        const float qd = __builtin_amdgcn_exp2f((float)(il + 1) * l2g);
#pragma unroll
        for (int k = 0; k < 2; ++k)
#pragma unroll
            for (int r = 0; r < 16; ++r) acc[k][r] *= qd;
    }
    for (int jb = 0; jb <= ib; ++jb) {
        f32x16 sc = splat16(0.f);
        const int krow = 32 * jb + swap23(r32);
#pragma unroll
        for (int ks = 0; ks < 8; ++ks) { const bf16x8 A = *(const LAS bf16x8*)(lds + 32768 + offb(krow, 2 * ks + hi)); sc = MFMA32(A, qf[ks], sc); }
#pragma unroll
        for (int r = 0; r < 16; ++r) { const int j = 32 * jb + 16 * (r >> 3) + 8 * hi + (r & 7); const int dj = il - j; sc[r] = dj >= 0 ? sc[r] * __builtin_amdgcn_exp2f((float)dj * l2g) : 0.f; }
        bf16x8 pk[2];
        { v4u w; w.x = pk2(sc[0], sc[1]); w.y = pk2(sc[2], sc[3]); w.z = pk2(sc[4], sc[5]); w.w = pk2(sc[6], sc[7]); pk[0] = __builtin_bit_cast(bf16x8, w);
          w.x = pk2(sc[8], sc[9]); w.y = pk2(sc[10], sc[11]); w.z = pk2(sc[12], sc[13]); w.w = pk2(sc[14], sc[15]); pk[1] = __builtin_bit_cast(bf16x8, w); }
#pragma unroll
        for (int s = 0; s < 2; ++s)
#pragma unroll
            for (int k = 0; k < 2; ++k) { const unsigned ko = 4096u * (unsigned)(2 * jb + s); const bf16x8 A = trfrag(lds + 65536, v0[k] + ko, v1[k] + ko); acc[k] = MFMA32(A, pk[s], acc[k]); }
    }
    float ss = 0.f;
#pragma unroll
    for (int k = 0; k < 2; ++k)
#pragma unroll
        for (int r = 0; r < 16; ++r) ss += acc[k][r] * acc[k][r];
    ss = half_swap_sum(ss);
    LAS float* xs = (LAS float*)(lds + 131072);
    if (hi == 0) xs[eh * 128 + il] = ss;
    WG_BAR();
    const float rs = 1.f / sqrtf((xs[il] + xs[128 + il]) * (1.f / 128.f) + NORM_EPS);
    const bf16* gp = proj + (t0 + il) * LDP + C_GR + h * 128; bf16* yp = Y + (t0 + il) * LDY + 2048 + h * 128;
#pragma unroll
    for (int k = 0; k < 2; ++k)
#pragma unroll
        for (int r4 = 0; r4 < 4; ++r4) { const int e = 32 * (2 * eh + k) + 8 * r4 + 4 * hi; const v2u gw = *(const GAS v2u*)(gp + e);
            v2u w; w.x = pk2(acc[k][4 * r4] * rs * bflo(gw.x), acc[k][4 * r4 + 1] * rs * bfhi(gw.x)); w.y = pk2(acc[k][4 * r4 + 2] * rs * bflo(gw.y), acc[k][4 * r4 + 3] * rs * bfhi(gw.y));
            *(GAS v2u*)(yp + e) = w; }
    WG_BAR();
}
#define XB_TMO      128
#define XB_XCNT(j)  (256  + 64 * (j))
#define XB_XSUB(j)  (1280 + 64 * (j))
#define XB_XGEN(j)  (2304 + 64 * (j))
#define XB_TOP      3328
#define XB_TOPGEN   3392
#define XCD_BAR_WORDS 3456
#define XB_SPIN_CAP (1u << 18)

__device__ __forceinline__ unsigned xb_ld(unsigned* p)              { return __hip_atomic_load(p, __ATOMIC_RELAXED, __HIP_MEMORY_SCOPE_AGENT); }
__device__ __forceinline__ unsigned xb_add(unsigned* p, unsigned v) { return __hip_atomic_fetch_add(p, v, __ATOMIC_RELAXED, __HIP_MEMORY_SCOPE_AGENT); }
__device__ __forceinline__ unsigned xb_xcc_id() { return (unsigned)__builtin_amdgcn_s_getreg((3 << 11) | 20) & 0xFu; }
#define XB_SPIN(cond, bar) do { unsigned _sp = 0; while (cond) { __builtin_amdgcn_s_sleep(1); \
    if ((++_sp & 255u) == 0u) { if (xb_ld(&(bar)[XB_TMO])) break; if (_sp > XB_SPIN_CAP) { atomicAdd(&(bar)[XB_TMO], 1u); break; } } } } while (0)

struct XcdBarrier {
    unsigned* bar; unsigned x;
    volatile LAS unsigned* st;
};

__device__ __forceinline__ XcdBarrier xcd_barrier_post(unsigned* bar, volatile LAS unsigned* st) {
    XcdBarrier b; b.bar = bar; b.x = xb_xcc_id(); b.st = st;
    if (threadIdx.x == 0) (void)xb_add(&bar[XB_XCNT(b.x)], 1u);
    return b;
}
__device__ __forceinline__ void xcd_barrier_complete(unsigned* bar, unsigned x, unsigned& nloc, unsigned& nx) {
    const unsigned G = gridDim.x * gridDim.y * gridDim.z;
    unsigned sum, cnt, mine, sp = 0u;
    for (;;) {
        sum = 0u; cnt = 0u; mine = 0u;
#pragma unroll
        for (unsigned j = 0; j < 16; ++j) { const unsigned c = xb_ld(&bar[XB_XCNT(j)]); sum += c; cnt += (c > 0u) ? 1u : 0u; mine = (j == x) ? c : mine; }
        if (sum == G) break;
        __builtin_amdgcn_s_sleep(1);
        if ((++sp & 255u) == 0u) { if (xb_ld(&bar[XB_TMO])) break; if (sp > XB_SPIN_CAP) { atomicAdd(&bar[XB_TMO], 1u); break; } }
    }
    nloc = mine > 0u ? mine : 1u; nx = cnt > 0u ? cnt : 1u;
}

__device__ __forceinline__ void xcd_barrier(const XcdBarrier& b) {
    asm volatile("s_waitcnt vmcnt(0)" ::: "memory");
    __syncthreads();
    if (threadIdx.x == 0) {
        unsigned* bar = b.bar;
        __builtin_amdgcn_s_waitcnt(0);
        unsigned nloc = b.st[0], nx = b.st[1];
        if (nloc == 0u) { xcd_barrier_complete(bar, b.x, nloc, nx); b.st[0] = nloc; b.st[1] = nx; }
        const unsigned old = xb_add(&bar[XB_XSUB(b.x)], 1u);
        const unsigned gen = old / nloc;
        if (old + 1u == (gen + 1u) * nloc) {
            __builtin_amdgcn_fence(__ATOMIC_RELEASE, "agent");
            asm volatile("s_waitcnt vmcnt(0)" ::: "memory");
            const unsigned og = xb_add(&bar[XB_TOP], 1u);
            const unsigned tg = og / nx;
            if (og + 1u == (tg + 1u) * nx) xb_add(&bar[XB_TOPGEN], 1u);
            else XB_SPIN(xb_ld(&bar[XB_TOPGEN]) == tg, bar);
            __builtin_amdgcn_fence(__ATOMIC_ACQUIRE, "agent");
            xb_add(&bar[XB_XGEN(b.x)], 1u);
            asm volatile("s_waitcnt vmcnt(0)" ::: "memory");
        } else {
            XB_SPIN(xb_ld(&bar[XB_XGEN(b.x)]) == gen, bar);
            __builtin_amdgcn_fence(__ATOMIC_ACQUIRE, "agent");
            asm volatile("s_waitcnt vmcnt(0)" ::: "memory");
        }
    }
    __syncthreads();
}
#ifndef NAIVE
#define NAIVE 0
#endif
__device__ __forceinline__ void naive_pool(LAS unsigned char* lds, const bf16* proj, const float* poolw  , const float* pscale, bf16* Y, int vcu, int G, int tid) {
    LAS float* dl = (LAS float*)lds; LAS float* part = dl + 256;
    for (int it = vcu; it < M * 4; it += G) { const int t = it >> 2, g = it & 3, win = 2 << g, pos = t & (SEQ - 1);
        if (tid < 256) { const int lo = pos + 1 - win < 0 ? 0 : pos + 1 - win; float s = 0.f;
            for (int p = lo; p <= pos; ++p) s += bflo((unsigned)proj[(size_t)(t - (pos - p)) * LDP + C_POOL + g * 256 + tid]);
            const float cur = bflo((unsigned)proj[(size_t)t * LDP + C_POOL + g * 256 + tid]);
            dl[tid] = s / (float)(pos + 1 - lo) - cur; }
        __syncthreads();
        const int o = tid & 255, hf = tid >> 8; float a = 0.f;
        for (int c = hf * 128; c < hf * 128 + 128; ++c) a += dl[c] * poolw[((size_t)g * 256 + c) * 256 + o];
        if (hf) part[o] = a;
        __syncthreads();
        if (!hf) Y[(size_t)t * LDY + g * 256 + o] = (bf16)(pk2((a + part[o]) * pscale[g * 256 + o], 0.f) & 0xffffu);
        __syncthreads(); }
}
__device__ __forceinline__ void naive_ret(LAS unsigned char* lds, const bf16* proj, bf16* Y, int vcu, int G, int tid) {
    LAS float* qs = (LAS float*)lds; LAS float* ks = qs + 128; LAS float* vs = ks + 128; LAS float* po = vs + 128; LAS float* red = po + 512;
    for (int bh = vcu; bh < 32; bh += G) { const int b = bh >> 3, h = bh & 7; const float gam = 1.0f - exp2f(-5.0f - (float)h);
        float S[32];
#pragma unroll
        for (int i = 0; i < 32; ++i) S[i] = 0.f;
        const int e = tid & 127, dg = tid >> 7;
        for (int pos = 0; pos < SEQ; ++pos) { const size_t row = (size_t)b * SEQ + pos; const bf16* pr = proj + row * LDP + h * 128;
            if (tid < 128) { const int i = tid & 63; const float invf = exp2f(-((float)i / 63.0f) * 13.287712379549449f); const float ang = (float)pos * invf;
                const double rev = (double)ang * 0.15915494309189535; const float fr = (float)(rev - __builtin_rint(rev)); const float cs = __builtin_amdgcn_cosf(fr), sn = __builtin_amdgcn_sinf(fr);
                const float q1 = bflo((unsigned)pr[C_QR + i]), q2 = bflo((unsigned)pr[C_QR + 64 + i]), k1 = bflo((unsigned)pr[C_KR + i]), k2 = bflo((unsigned)pr[C_KR + 64 + i]);
                if (tid < 64) { qs[i] = q1 * cs - q2 * sn; ks[i] = (k1 * cs - k2 * sn) * RET_KSCALE; } else { qs[64 + i] = q2 * cs + q1 * sn; ks[64 + i] = (k2 * cs + k1 * sn) * RET_KSCALE; }
                vs[tid] = bflo((unsigned)pr[C_VR + tid]); }
            __syncthreads();
            float a = 0.f; const float ve = vs[e];
#pragma unroll
            for (int i = 0; i < 32; ++i) { const int d = dg * 32 + i; S[i] = gam * S[i] + ks[d] * ve; a += qs[d] * S[i]; }
            po[dg * 128 + e] = a;
            __syncthreads();
            if (tid < 128) { const float o = po[e] + po[128 + e] + po[256 + e] + po[384 + e]; const float s2 = wave_sum(o * o); if ((tid & 63) == 0) red[tid >> 6] = s2; po[e] = o; }
            __syncthreads();
            if (tid < 128) { const float rs = 1.0f / sqrtf((red[0] + red[1]) * (1.f / 128.f) + NORM_EPS); const float gt = bflo((unsigned)pr[C_GR + e]);
                Y[row * LDY + 2048 + h * 128 + e] = (bf16)(pk2(po[e] * rs * gt, 0.f) & 0xffffu); }
            __syncthreads(); } }
}
__device__ __forceinline__ void naive_attn(const bf16* proj, bf16* Y, const float* relb, const float* hgain, float lam, float oscale, int gw, int NGW, int lane) {
    for (int it = gw; it < 32 * SEQ; it += NGW) { const int bh = it / SEQ, q = it % SEQ, b = bh >> 3, h = bh & 7; const size_t rowbase = (size_t)b * SEQ;
        const bf16* qp = proj + (rowbase + q) * LDP + C_QD + h * 128;
        const float qa = bflo((unsigned)qp[lane]), qb = bflo((unsigned)qp[64 + lane]);
        float mx0 = -1e30f, mx1 = -1e30f;
        const int nkb = q / 64 + 1;
        for (int pass = 0; pass < 2; ++pass) {
            float l0 = 0.f, l1 = 0.f, o0a = 0.f, o0b = 0.f, o1a = 0.f, o1b = 0.f;
            for (int kb = 0; kb < nkb; ++kb) { const int key = kb * 64 + lane; const bool valid = key <= q; const int kc = valid ? key : q;
                const bf16* kp = proj + (rowbase + kc) * LDP + C_KD + h * 128; float s0 = 0.f, s1 = 0.f;
#pragma unroll
                for (int d8 = 0; d8 < 8; ++d8) { const v4u w0 = *(const GAS v4u*)(kp + 8 * d8), w1 = *(const GAS v4u*)(kp + 64 + 8 * d8);
#pragma unroll
                    for (int j = 0; j < 4; ++j) { const int d = 8 * d8 + 2 * j;
                        const float q0a = __builtin_bit_cast(float, __builtin_amdgcn_readlane(__builtin_bit_cast(int, qa), d)), q0b = __builtin_bit_cast(float, __builtin_amdgcn_readlane(__builtin_bit_cast(int, qa), d + 1));
                        const float q1a = __builtin_bit_cast(float, __builtin_amdgcn_readlane(__builtin_bit_cast(int, qb), d)), q1b = __builtin_bit_cast(float, __builtin_amdgcn_readlane(__builtin_bit_cast(int, qb), d + 1));
                        s0 += q0a * bflo(w0[j]) + q0b * bfhi(w0[j]); s1 += q1a * bflo(w1[j]) + q1b * bfhi(w1[j]); } }
                const float bs = relb[t5_bucket(q - kc) * 8 + h] * LOG2E; s0 += bs; s1 += bs;
                if (pass == 0) { if (valid) { mx0 = fmaxf(mx0, s0); mx1 = fmaxf(mx1, s1); } }
                else { const float p0 = valid ? exp2f(s0 - mx0) : 0.f, p1 = valid ? exp2f(s1 - mx1) : 0.f; l0 += p0; l1 += p1;
                    for (int kk = 0; kk < 64; ++kk) { const int k2 = kb * 64 + kk; if (k2 > q) break; const float a0 = __shfl(p0, kk), a1 = __shfl(p1, kk);
                        const bf16* vp = proj + (rowbase + k2) * LDP + C_VD + h * 128; const float va = bflo((unsigned)vp[lane]), vb = bflo((unsigned)vp[64 + lane]);
                        o0a += a0 * va; o0b += a0 * vb; o1a += a1 * va; o1b += a1 * vb; } } }
            if (pass == 0) {
#pragma unroll
                for (int o = 1; o < 64; o <<= 1) { mx0 = fmaxf(mx0, __shfl_xor(mx0, o)); mx1 = fmaxf(mx1, __shfl_xor(mx1, o)); } }
            else { l0 = wave_sum(l0); l1 = wave_sum(l1);
                const float da = o0a / l0 - lam * o1a / l1, db = o0b / l0 - lam * o1b / l1; const float ss = wave_sum(da * da + db * db);
                const float rs = oscale / sqrtf(ss * (1.f / 128.f) + NORM_EPS); bf16* yp = Y + (rowbase + q) * LDY + 1024 + h * 128;
                yp[lane] = (bf16)(pk2(da * rs * hgain[lane], 0.f) & 0xffffu); yp[64 + lane] = (bf16)(pk2(db * rs * hgain[64 + lane], 0.f) & 0xffffu); } } }
}
constexpr int NPH_LAYER = 10, NPH = 1 + DEPTH * NPH_LAYER;
struct Args { const float* in[15]; float* out; unsigned char* ws; int p_lo, p_hi; };
__global__ void __launch_bounds__(NWAVES * 64, 2) fwd(Args args) {
    extern __shared__ __attribute__((aligned(16))) unsigned char lds_raw[];
    LAS unsigned char* lds = (LAS unsigned char*)lds_raw;
#define LTID() ({ int t_ = threadIdx.x; asm volatile("" : "+v"(t_)); t_; })
    const int tid0 = threadIdx.x, wave = __builtin_amdgcn_readfirstlane(tid0 >> 6);
    const int G = gridDim.x; const int bx = blockIdx.x; const int vcu = (G % 8 == 0) ? (bx % 8) * (G / 8) + bx / 8 : bx;
    unsigned char* ws = args.ws;
    gu32* ctl = (gu32*)(ws + WS_CTL);
    for (int u = tid0; u < (LDS_BYTES - LDSCTL_OFF) / 4; u += NWAVES * 64) ((LAS unsigned*)(lds + LDSCTL_OFF))[u] = 0u;
    __syncthreads();
    volatile LAS unsigned* MISC = (volatile LAS unsigned*)(lds + MISC_OFF);
    XcdBarrier bar; bar.bar = (unsigned*)(ctl + CW_BAR); bar.x = 0; bar.st = nullptr;
    if (SINGLE_LAUNCH) bar = xcd_barrier_post((unsigned*)(ctl + CW_BAR), MISC + 8);
    const int lo = args.p_lo, hi_ph = args.p_hi;
#define IN(k) (lo <= (k) && (k) < hi_ph)
#ifndef PHMASK
#define PHMASK 0xffff
#endif
#define PHM(i) (((PHMASK) >> (i)) & 1)
#ifndef UMASK
#define UMASK 7
#endif
#define UEN(i) (((UMASK) >> (i)) & 1)
#ifndef DUPMASK
#define DUPMASK 0
#endif
#define REPS(i) ((((DUPMASK) >> (i)) & 1) ? 2 : 1)
#define SEAM(k) do { if (SINGLE_LAUNCH && IN(k) && IN((k) + 1)) xcd_barrier(bar); } while (0)
#ifndef FUSE_THIN
#define FUSE_THIN 0
#endif
    const bool fuse_thin = FUSE_THIN && SINGLE_LAUNCH && (G == 256);
    constexpr int CW_PANEL = 16384;
#define PANEL_TAIL(S_, TI, GPOST, FOUT) do { \
        pg8::Unit u0_; (void)(S_).next(0, u0_); \
        gu32* cnt_ = ctl + CW_PANEL + ((TI) * 64 + u0_.pm) * 64; \
        if (tid0 == 0) { __builtin_amdgcn_fence(__ATOMIC_RELEASE, "agent"); asm volatile("s_waitcnt vmcnt(0)" ::: "memory"); (void)__hip_atomic_fetch_add(cnt_, 1u, RLX_AGENT); \
            unsigned sp_ = 0; while (__hip_atomic_load(cnt_, RLX_AGENT) < 4u) { __builtin_amdgcn_s_sleep(1); if (++sp_ > (1u << 21)) break; } \
            __builtin_amdgcn_fence(__ATOMIC_ACQUIRE, "agent"); asm volatile("s_waitcnt vmcnt(0)" ::: "memory"); } \
        __syncthreads(); \
        { const int lane_ = LTID() & 63; const int r0_ = u0_.pm * 256 + (u0_.pn & 3) * 64; float* fo_ = (FOUT); \
          for (int r_ = wave; r_ < 64; r_ += NWAVES) { const size_t m_ = (size_t)(r0_ + r_); resid_row(XN + m_ * DM, MIX + m_ * DM, STAT + m_ * 32, (GPOST), RS + m_, fo_ ? fo_ + m_ * DM : (float*)nullptr, lane_); } } \
    } while (0)

    const float* x_in = args.in[0]; const float* rel_bias = args.in[1];
    const float* g_pre_mix = args.in[2]; const float* g_post_mix = args.in[3]; const float* g_pre_mlp = args.in[4]; const float* g_post_mlp = args.in[5];
    const float* w_in = args.in[6]; const float* pool_w = args.in[7]; const float* pool_scale = args.in[8]; const float* diff_lambda = args.in[9]; const float* diff_hn = args.in[10];
    const float* w_branch = args.in[11]; const float* w_out = args.in[12]; const float* w_up = args.in[13]; const float* w_down = args.in[14];
    float* xres = args.out;
    bf16* WIN = (bf16*)(ws + WS_WIN); bf16* WB = (bf16*)(ws + WS_WB); bf16* WO = (bf16*)(ws + WS_WO); bf16* WUP = (bf16*)(ws + WS_WUP); bf16* WDN = (bf16*)(ws + WS_WDN); bf16* POOLT = (bf16*)(ws + WS_POOLT);
    bf16* XN = (bf16*)(ws + WS_XN); bf16* MRG = (bf16*)(ws + WS_MRG); bf16* MIX = (bf16*)(ws + WS_MIX); bf16* Y = (bf16*)(ws + WS_Y); bf16* PROJ = (bf16*)(ws + WS_PROJ); bf16* FF = PROJ;
    float* RS = (float*)(ws + WS_RS); float* KV = (float*)(ws + WS_KV); bf16* SST = (bf16*)(ws + WS_SST); float* STAT = (float*)(ws + WS_STAT); f32x2* ROT = (f32x2*)(ws + WS_ROT);
    const int gw = vcu * NWAVES + wave, NGW = G * NWAVES;

    if (PHM(0) && IN(0)) for (int rep_ = 0; rep_ < REPS(0); ++rep_) {
        const int tid = LTID(), lane = tid & 63;
        LAS float* scr = (LAS float*)(lds + wave * 16384);
        constexpr int I_IN = (DM / 64) * (INC / 32), I_B = (MIXW / 64) * (DM / 32), I_O = (DM / 64) * (DM / 32), I_UP = (DM / 64) * (DFF / 32), I_DN = (DFF / 64) * (DM / 32), I_P = (256 / 64) * (256 / 32);
        constexpr int I_LAYER = I_IN + 3 * I_B + I_O + I_UP + I_DN + 4 * I_P;
        for (int it = gw; it < DEPTH * I_LAYER; it += NGW) {
            const int l = it / I_LAYER; int r = it - l * I_LAYER;
            if (r < I_IN) { p0_transpose_item(w_in + (size_t)l * DM * INC, INC, WIN + (size_t)l * INC * DM, DM, 0, scr, r, lane, g_pre_mix + l * DM); continue; } r -= I_IN;
            if (r < 3 * I_B) { const int n = r / I_B; r -= n * I_B; p0_transpose_item(w_branch + ((size_t)l * 3 + n) * MIXW * DM, DM, WB + (size_t)l * DM * 3072, 3072, n * MIXW, scr, r, lane); continue; } r -= 3 * I_B;
            if (r < I_O) { p0_transpose_item(w_out + (size_t)l * DM * DM, DM, WO + (size_t)l * DM * DM, DM, 0, scr, r, lane); continue; } r -= I_O;
            if (r < I_UP) { p0_transpose_item(w_up + (size_t)l * DM * DFF, DFF, WUP + (size_t)l * DFF * DM, DM, 0, scr, r, lane, g_pre_mlp + l * DM); continue; } r -= I_UP;
            if (r < I_DN) { p0_transpose_item(w_down + (size_t)l * DFF * DM, DM, WDN + (size_t)l * DM * DFF, DFF, 0, scr, r, lane); continue; } r -= I_DN;
            { const int g = r / I_P; r -= g * I_P; p0_transpose_item(pool_w + ((size_t)l * 4 + g) * 65536, 256, POOLT + ((size_t)l * 4 + g) * 65536, 256, 0, scr, r, lane); }
        }
        for (int i = vcu * 512 + tid; i < SEQ * 64; i += G * 512) { const int pos = i >> 6, f = i & 63;
            const float invf = __builtin_amdgcn_exp2f(-(float)f * (13.287712379549449f / 63.0f));
            const float ang = (float)pos * invf; const double rev = (double)ang * 0.15915494309189535; const float fr = (float)(rev - __builtin_rint(rev));
            ROT[i] = (f32x2){__builtin_amdgcn_cosf(fr), __builtin_amdgcn_sinf(fr)}; }
        for (int m = gw; m < M; m += NGW) prep_row(x_in + (size_t)m * DM, XN + (size_t)m * DM, RS + m, lane);
    }
    SEAM(0);

    for (int l = 0; l < DEPTH; ++l) {
        const int pb = 1 + l * NPH_LAYER;
        const float lambda_init = 0.8f - 0.6f * __expf(-0.3f * (float)l);
#ifndef GREP1
#define GREP1 1
#endif
        for (int gr_ = 0; gr_ < GREP1; ++gr_) {
        if (PHM(1) && IN(pb + 0)) for (int rep_ = 0; rep_ < REPS(1); ++rep_) {
            pg8::Gemm g{XN, WIN + (size_t)l * INC * DM, M, INC, DM}; pg8::StaticOrder S; S.init(M, INC, G, bx);
            pg8::EpiProj E{PROJ, LDP, QSCALE, RS};
            pg8::gemm_phase<pg8::EpiProj, pg8::StaticOrder, GEMM_ALIGN, GEMM_SP2>(lds, g, S, E);
#ifdef DUPBAR
            if (rep_ + 1 < REPS(1)) xcd_barrier(bar);
#endif
        }
        SEAM(pb + 0);
        if (PHM(2) && IN(pb + 1)) for (int rep_ = 0; rep_ < REPS(2); ++rep_) {
            const int tid = LTID(), lane = tid & 63;
            if (NAIVE & 1) naive_pool(lds, PROJ, pool_w + (size_t)l * 4 * 65536, pool_scale + l * MIXW, Y, vcu, G, tid);
            else if (UEN(0)) for (int r2_ = 0; r2_ < REPS(11); ++r2_) for (int u = vcu; u < 512; u += G) pool_unit(lds, PROJ, POOLT + (size_t)l * 4 * 65536, pool_scale + l * MIXW, Y, u >> 2, u & 3, tid, lane, wave);
            if (NAIVE & 4) naive_ret(lds, PROJ, Y, vcu, G, tid);
            else if (UEN(1)) for (int r2_ = 0; r2_ < REPS(12); ++r2_) for (int u = vcu; u < 1024; u += G) retA_unit(lds, PROJ, ROT, KV, u, tid, lane, wave);
            if (UEN(2)) { const float* lp = diff_lambda + l * 256;
              const float s1 = wave_sum(lp[lane] * lp[64 + lane]), s2 = wave_sum(lp[128 + lane] * lp[192 + lane]);
              const float lam = __expf(s1) - __expf(s2) + lambda_init;
              if (NAIVE & 2) naive_attn(PROJ, Y, rel_bias, diff_hn + l * 128, lam, 1.f - lambda_init, gw, NGW, lane);
              else for (int r2_ = 0; r2_ < REPS(13); ++r2_) for (int i = 0; i < 4 * ((256 + G - 1) / G); ++i) { const int v = vcu + (i >> 2) * G; if (v >= 256) break;
                  const int bh = v >> 3, s = v & 7, k = i & 3; const int qb = (k == 0) ? 31 - s : (k == 1) ? 16 + s : (k == 2) ? 15 - s : s;
                  attn_unit(lds, PROJ, Y, rel_bias, diff_hn + l * 128, lam, 1.f - lambda_init, bh >> 3, bh & 7, qb, tid, lane, wave); } }
        }
        SEAM(pb + 1);
        if (!(NAIVE & 4) && PHM(3) && IN(pb + 2)) for (int rep_ = 0; rep_ < REPS(3); ++rep_) {
            const int tid = LTID();
            for (int gid = vcu * 512 + tid; gid < 32 * 4096; gid += G * 512) { const int bh = gid >> 12, i4 = gid & 4095; const float dec = __builtin_amdgcn_exp2f(128.f * kLog2Gamma[bh & 7]);
                f32x4 S = {0.f, 0.f, 0.f, 0.f};
                const GAS f32x4* kp = (const GAS f32x4*)(KV + (size_t)bh * 32 * 16384) + i4; GAS v2u* sp = (GAS v2u*)(SST + (size_t)bh * 32 * 16384) + i4;
#pragma unroll 4
                for (int c = 0; c < 31; ++c) { const f32x4 kv = kp[(size_t)c * 4096]; S = S * dec + kv; v2u w; w.x = pk2(S.x, S.y); w.y = pk2(S.z, S.w); sp[(size_t)(c + 1) * 4096] = w; } }
        }
        SEAM(pb + 2);
        if (!(NAIVE & 4) && PHM(4) && IN(pb + 3)) for (int rep_ = 0; rep_ < REPS(4); ++rep_) { const int tid = LTID(), lane = tid & 63; for (int u = vcu; u < 1024; u += G) retC_unit(lds, PROJ, ROT, SST, Y, u, tid, lane, wave); }
        SEAM(pb + 3);
        if (PHM(5) && IN(pb + 4)) for (int rep_ = 0; rep_ < REPS(5); ++rep_) {
            pg8::Gemm g{Y, WB + (size_t)l * DM * 3072, M, DM, 3072}; pg8::StaticOrder S; S.init(M, DM, G, bx);
            pg8::EpiWiden E{MRG, DM, PROJ + C_GATE, LDP};
            pg8::gemm_phase<pg8::EpiWiden, pg8::StaticOrder, GEMM_ALIGN, GEMM_SP2>(lds, g, S, E);
        }
        SEAM(pb + 4);
        if (PHM(6) && IN(pb + 5)) for (int rep_ = 0; rep_ < REPS(6); ++rep_) {
            pg8::Gemm g{MRG, WO + (size_t)l * DM * DM, M, DM, DM}; pg8::StaticOrder S; S.init(M, DM, G, bx);
            pg8::EpiSq E{MIX, DM, STAT};
            pg8::gemm_phase<pg8::EpiSq, pg8::StaticOrder, GEMM_ALIGN, GEMM_SP2>(lds, g, S, E);
            if (fuse_thin && GREP1 == 1 && REPS(6) == 1) PANEL_TAIL(S, l * 2, g_post_mix + l * DM, (float*)nullptr);
        }
        if (gr_ + 1 < GREP1) xcd_barrier(bar);
        }
        SEAM(pb + 5);
        if (!(fuse_thin && GREP1 == 1 && REPS(6) == 1)) {
        if (PHM(7) && IN(pb + 6)) {
            const int lane = LTID() & 63;
            for (int rep_ = REPS(7) - 1; rep_ >= 0; --rep_)
            for (int m = gw; m < M; m += NGW) resid_row(XN + (size_t)m * DM, MIX + (size_t)m * DM, STAT + (size_t)m * 32, g_post_mix + l * DM, rep_ ? KV + m : RS + m, (float*)nullptr, lane, rep_ ? MRG + (size_t)m * DM : (bf16*)nullptr);
        }
        SEAM(pb + 6);
        }
#ifndef MLP_HALVES
#define MLP_HALVES 1
#endif
#if MLP_HALVES
        if (PHM(8) && IN(pb + 7)) {
            constexpr int MH = M / 2;
            for (int st_ = 0; st_ < 3; ++st_) {
                if (st_ >= 1) { const int h_ = st_ - 1;
                    pg8::Gemm g{FF + (size_t)h_ * MH * DFF, WDN + (size_t)l * DM * DFF, MH, DM, DFF}; pg8::StaticOrder S; S.init(MH, DM, G, bx);
                    pg8::EpiSq E{MIX + (size_t)h_ * MH * DM, DM, STAT + (size_t)h_ * MH * 32};
                    pg8::gemm_phase<pg8::EpiSq, pg8::StaticOrder, GEMM_ALIGN, GEMM_SP2>(lds, g, S, E); }
                if (st_ <= 1) { const int h_ = st_;
                    pg8::Gemm g{XN + (size_t)h_ * MH * DM, WUP + (size_t)l * DFF * DM, MH, DFF, DM}; pg8::StaticOrder S; S.init(MH, DFF, G, bx);
                    pg8::EpiRelu2 E{FF + (size_t)h_ * MH * DFF, DFF, RS + (size_t)h_ * MH};
                    pg8::gemm_phase<pg8::EpiRelu2, pg8::StaticOrder, GEMM_ALIGN, GEMM_SP2>(lds, g, S, E); }
                if (st_ < 2 && SINGLE_LAUNCH) xcd_barrier(bar);
            }
        }
        SEAM(pb + 8);
#else
        if (PHM(8) && IN(pb + 7)) for (int rep_ = 0; rep_ < REPS(8); ++rep_) {
            pg8::Gemm g{XN, WUP + (size_t)l * DFF * DM, M, DFF, DM}; pg8::StaticOrder S; S.init(M, DFF, G, bx);
            pg8::EpiRelu2 E{FF, DFF, RS};
            pg8::gemm_phase<pg8::EpiRelu2, pg8::StaticOrder, GEMM_ALIGN, GEMM_SP2>(lds, g, S, E);
        }
        SEAM(pb + 7);
        if (PHM(9) && IN(pb + 8)) for (int rep_ = 0; rep_ < REPS(9); ++rep_) {
            pg8::Gemm g{FF, WDN + (size_t)l * DM * DFF, M, DM, DFF}; pg8::StaticOrder S; S.init(M, DM, G, bx);
            pg8::EpiSq E{MIX, DM, STAT};
            pg8::gemm_phase<pg8::EpiSq, pg8::StaticOrder, GEMM_ALIGN, GEMM_SP2>(lds, g, S, E);
            if (fuse_thin && REPS(9) == 1) PANEL_TAIL(S, l * 2 + 1, g_post_mlp + l * DM, (l == DEPTH - 1) ? xres : (float*)nullptr);
        }
        SEAM(pb + 8);
#endif
        if (!(fuse_thin && REPS(9) == 1)) {
        if (PHM(10) && IN(pb + 9)) {
            const int lane = LTID() & 63;
            const bool lastl = (l == DEPTH - 1);
            for (int m = gw; m < M; m += NGW) resid_row(XN + (size_t)m * DM, MIX + (size_t)m * DM, STAT + (size_t)m * 32, g_post_mlp + l * DM, RS + m, lastl ? xres + (size_t)m * DM : (float*)nullptr, lane);
        }
        SEAM(pb + 9);
        }
    }
#undef IN
#undef SEAM
}

extern "C" void kernel_launch(void* const* d_in, const int* in_sizes, int n_in, void* d_out, int out_size, void* d_ws, size_t ws_size, hipStream_t stream) {
    static int grid = 0;
    if (grid == 0) {
        if (n_in != 15 || in_sizes[0] != M * DM || out_size != M * DM || ws_size < WS_END) { fprintf(stderr, "kernel_launch: unexpected shapes / workspace (n_in %d, ws %zu, need %zu); nothing launched\n", n_in, ws_size, (size_t)WS_END); grid = -1; return; }
        int dev = 0, cus = 0, per_cu = 0;
        if (hipGetDevice(&dev) != hipSuccess || hipDeviceGetAttribute(&cus, hipDeviceAttributeMultiprocessorCount, dev) != hipSuccess) { grid = -1; return; }
        if (hipFuncSetAttribute((const void*)fwd, hipFuncAttributeMaxDynamicSharedMemorySize, LDS_BYTES) != hipSuccess) { fprintf(stderr, "kernel_launch: hipFuncSetAttribute failed\n"); grid = -1; return; }
        if (hipOccupancyMaxActiveBlocksPerMultiprocessor(&per_cu, (const void*)fwd, NWAVES * 64, LDS_BYTES) != hipSuccess || per_cu < 1) fprintf(stderr, "kernel_launch: note: occupancy query reports %d workgroups per CU\n", per_cu);
        (void)hipGetLastError();
        grid = cus;
    }
    if (grid < 0) return;
    if (hipMemsetAsync((char*)d_ws + WS_CTL, 0, CTL_ZERO_BYTES, stream) != hipSuccess) return;
    Args a{};
    for (int i = 0; i < 15; ++i) a.in[i] = (const float*)d_in[i];
    a.out = (float*)d_out; a.ws = (unsigned char*)d_ws;
    if (SINGLE_LAUNCH) {
        a.p_lo = 0; a.p_hi = NPH;
        hipLaunchKernelGGL(fwd, dim3(grid), dim3(NWAVES * 64), LDS_BYTES, stream, a);
    } else {
        for (int p = 0; p < NPH; ++p) { a.p_lo = p; a.p_hi = p + 1; hipLaunchKernelGGL(fwd, dim3(grid), dim3(NWAVES * 64), LDS_BYTES, stream, a); }
    }
    const hipError_t le = hipPeekAtLastError();
    if (le != hipSuccess) fprintf(stderr, "kernel_launch: launch failed: %s\n", hipGetErrorName(le));
}
```

```cpp
#include <hip/hip_runtime.h>
#include <cstdio>
#include <cstdint>
struct Stopwatch { unsigned long long t0, acc; int on; };
#ifdef TSSEL
#ifndef TSAMP
#define TSAMP 8
#endif
#define TS_BEG(sw, id) do { if ((id) == TSSEL && (sw).on) (sw).t0 = __builtin_amdgcn_s_memrealtime(); } while (0)
#define TS_END(sw, id) do { if ((id) == TSSEL && (sw).on) (sw).acc += __builtin_amdgcn_s_memrealtime() - (sw).t0; } while (0)
#else
#define TS_BEG(sw, id) do { } while (0)
#define TS_END(sw, id) do { } while (0)
#endif
namespace pg8 {
#define PG8_LAS __attribute__((address_space(3)))
typedef unsigned short bf16_t;
typedef short bf16x8 __attribute__((ext_vector_type(8)));
typedef float f32x4 __attribute__((ext_vector_type(4)));
typedef unsigned u32x4 __attribute__((ext_vector_type(4)));
typedef unsigned u32x2 __attribute__((ext_vector_type(2)));
typedef int i32x4 __attribute__((ext_vector_type(4)));
constexpr int BM = 256, BK = 64, HALF = 128, HTB = HALF * BK * 2  , STAGE_BYTES = 8 * HTB, NXCD = 8, WGM = 8;

__host__ __device__ __forceinline__ int lds_byte(int r, int c) { const int st = (r >> 4) * 2 + (c >> 5), rr = r & 15, cc = c & 31, ob = rr * 64 + cc * 2; return st * 1024 + (ob ^ (((ob >> 9) & 1) << 5)); }
__host__ __device__ __forceinline__ void stage_rc(int b, int& R, int& C) { const int st = b / 1024, sb = b % 1024, swz = sb ^ (((sb >> 9) & 1) << 5); R = (st >> 1) * 16 + swz / 64; C = (st & 1) * 32 + (swz % 64) / 2; }
__host__ __device__ __forceinline__ int perm32(int rho) { const int n = rho >> 4, i = rho & 15; return 8 * (i >> 2) + 4 * n + (i & 3); }

struct Unit { int pm, pn; };
struct Gemm { const bf16_t* A; const bf16_t* Bt; int M, N, K; };

struct StaticOrder {
    int nM, nN, nwg, G, c;
    __host__ __device__ void init(int M, int N, int G_, int c_) { nM = M / BM; nN = N / BM; nwg = nM * nN; G = G_; c = c_; }
    __host__ __device__ bool next(int i, Unit& u) const {
        const long L = (long)i * G + c; if (L >= nwg) return false;
        int wgid = (int)L; { const int q = nwg / NXCD, r = nwg % NXCD, xcd = wgid % NXCD, off = wgid / NXCD; wgid = (xcd < r ? xcd * (q + 1) : r * (q + 1) + (xcd - r) * q) + off; }
        const int nig = WGM * nN, gid = wgid / nig, fm = gid * WGM, gsz = (nM - fm) < WGM ? (nM - fm) : WGM;
        u.pm = fm + ((wgid % nig) % gsz); u.pn = (wgid % nig) / gsz; return true;
    }
    __device__ __forceinline__ void a_ready(const Unit&) const {}
    __device__ __forceinline__ void done(const Unit&) const {}
};

typedef float f32x2c __attribute__((ext_vector_type(2))); typedef __bf16 bf16x2c __attribute__((ext_vector_type(2)));
__device__ __forceinline__ unsigned cvt_pk_bf16(float lo, float hi) { f32x2c v = {lo, hi}; bf16x2c b = __builtin_convertvector(v, bf16x2c); return __builtin_bit_cast(unsigned, b); }
typedef float f32x2 __attribute__((ext_vector_type(2)));

__device__ __forceinline__ f32x4 mma16(bf16x8 a, bf16x8 b, f32x4 c) { return __builtin_amdgcn_mfma_f32_16x16x32_bf16(a, b, c, 0, 0, 0); }
__device__ __forceinline__ i32x4 mma16(bf16x8 a, bf16x8 b, i32x4 c) { return __builtin_amdgcn_mfma_i32_16x16x64_i8(__builtin_bit_cast(i32x4, a), __builtin_bit_cast(i32x4, b), c, 0, 0, 0); }
template <class Epi, class Sched, bool ALIGN_EPI = false, bool SP2 = false>
__device__ __forceinline__ void gemm_phase(PG8_LAS unsigned char* lds, const Gemm g, const Sched& S, const Epi& E, Stopwatch& sw) {
    int tid_ = threadIdx.x; asm volatile("" : "+v"(tid_));
    const int tid = tid_, wid = __builtin_amdgcn_readfirstlane(tid >> 6), lane = tid & 63, wr = wid >> 2, wc = wid & 3, fr = lane & 15, fq = lane >> 4;
    const int K = g.K, nt = K / BK;
    unsigned voffA[2], voffB[2];
#pragma unroll
    for (int i = 0; i < 2; ++i) { int R, C; stage_rc(tid * 16 + i * 8192, R, C); const int Rb = Epi::PERM ? ((R & ~31) + perm32(R & 31)) : R;
        voffA[i] = (unsigned)(R * K + C) * 2u; voffB[i] = (unsigned)(Rb * K + C) * 2u; }
    const size_t kstep = (size_t)(BK * 2);
    const size_t hstep = (size_t)HALF * K * 2;
    const size_t tstep = 2 * hstep;
    const unsigned ldsw = (unsigned)wid * 1024u;
    const int aoff = lds_byte(wr * 64 + fr, fq * 8), boff = lds_byte(wc * 32 + fr, fq * 8);
#define PG8_SA(b, h) (((b) * 2 + (h)) * HTB)
#define PG8_SB(b, h) ((4 + (b) * 2 + (h)) * HTB)
#define PG8_STAGE(bufoff, gbase, voff) do { _Pragma("unroll") for (int _i = 0; _i < 2; ++_i) \
        __builtin_amdgcn_global_load_lds((const unsigned*)((const char*)(gbase) + (voff)[_i]), (PG8_LAS unsigned*)(lds + (bufoff) + ldsw + _i * 8192), 16, 0, 0); } while (0)
#define PG8_LDA(dst, b, h) do { _Pragma("unroll") for (int m = 0; m < 4; ++m) _Pragma("unroll") for (int k = 0; k < 2; ++k) dst[m][k] = *(const PG8_LAS bf16x8*)(lds + PG8_SA(b, h) + aoff + m * 2048 + k * 1024); } while (0)
#define PG8_LDB(dst, b, h) do { _Pragma("unroll") for (int n = 0; n < 2; ++n) _Pragma("unroll") for (int k = 0; k < 2; ++k) dst[n][k] = *(const PG8_LAS bf16x8*)(lds + PG8_SB(b, h) + boff + n * 2048 + k * 1024); } while (0)
#define PG8_MMA(ai, bj, At, Bt) do { __builtin_amdgcn_s_setprio(1); _Pragma("unroll") for (int m = 0; m < 4; ++m) _Pragma("unroll") for (int n = 0; n < 2; ++n) _Pragma("unroll") for (int k = 0; k < 2; ++k) \
        acc[ai][bj][m][n] = mma16(Bt[n][k], At[m][k], acc[ai][bj][m][n]); __builtin_amdgcn_s_setprio(0); } while (0)
#define PG8_WAIT_V(n) asm volatile("s_waitcnt vmcnt(" #n ")" ::: "memory")
#define PG8_WAIT_VN(n) asm volatile("s_waitcnt vmcnt(%0)" :: "n"(n) : "memory")
#define PG8_WAIT_L(n) asm volatile("s_waitcnt lgkmcnt(" #n ")" ::: "memory")
#define PG8_BAR __builtin_amdgcn_s_barrier()
#define PG8_SCHED __builtin_amdgcn_sched_barrier(0)
    Unit cur, nxt; int ui = 0;
    if (!S.next(0, cur)) return;
    typename Epi::acc_t acc[2][2][4][2];
#pragma unroll
    for (int a = 0; a < 2; ++a)
#pragma unroll
        for (int b = 0; b < 2; ++b)
#pragma unroll
            for (int m = 0; m < 4; ++m)
#pragma unroll
                for (int n = 0; n < 2; ++n) acc[a][b][m][n] = typename Epi::acc_t{};
    bf16x8 At[4][2], B0[2][2], B1[2][2];
    const char* cA = (const char*)g.A + (size_t)cur.pm * tstep; const char* cB = (const char*)g.Bt + (size_t)cur.pn * tstep;
    S.a_ready(cur);
    if constexpr (SP2) {
        PG8_STAGE(PG8_SB(0, 0), cB, voffB); PG8_STAGE(PG8_SB(0, 1), cB + hstep, voffB); PG8_STAGE(PG8_SA(0, 0), cA, voffA); PG8_STAGE(PG8_SA(0, 1), cA + hstep, voffA);
        if (wr == 1) PG8_BAR;
        PG8_WAIT_V(2); PG8_BAR;
        PG8_STAGE(PG8_SB(1, 0), cB + kstep, voffB); PG8_STAGE(PG8_SA(1, 0), cA + kstep, voffA); PG8_STAGE(PG8_SB(1, 1), cB + hstep + kstep, voffB);
        PG8_WAIT_V(6); PG8_BAR;
    } else {
        PG8_STAGE(PG8_SB(0, 0), cB, voffB); PG8_STAGE(PG8_SA(0, 0), cA, voffA); PG8_STAGE(PG8_SB(0, 1), cB + hstep, voffB); PG8_STAGE(PG8_SA(0, 1), cA + hstep, voffA);
        if (wr == 1) PG8_BAR;
        PG8_WAIT_V(4); PG8_BAR;
        PG8_STAGE(PG8_SB(1, 0), cB + kstep, voffB); PG8_STAGE(PG8_SA(1, 0), cA + kstep, voffA); PG8_STAGE(PG8_SB(1, 1), cB + hstep + kstep, voffB);
        PG8_WAIT_V(6); PG8_BAR;
    }
    for (;;) {
        const bool has_next = S.next(ui + 1, nxt);
        const char* nA = has_next ? (const char*)g.A + (size_t)nxt.pm * tstep : cA; const char* nB = has_next ? (const char*)g.Bt + (size_t)nxt.pn * tstep : cB;
        TS_BEG(sw, 23); TS_BEG(sw, 20);
        for (int t = 0; t < nt; t += 2) {
            if constexpr (Epi::MID) { if (t == Epi::MID_T0 || t == Epi::MID_T1) E.mid(acc, cur, t, wr, wc, fr, fq); }
            const bool last = (t == nt - 2);
            const char* a1 = cA + (size_t)(t + 1) * kstep;
            const char* a2 = last ? nA : cA + (size_t)(t + 2) * kstep; const char* b2 = last ? nB : cB + (size_t)(t + 2) * kstep;
            const char* a3 = a2 + kstep; const char* b3 = b2 + kstep;
            if (last && has_next) S.a_ready(nxt);
            if constexpr (SP2) {
            int relax = __builtin_amdgcn_readfirstlane((int)((ui > 0) && (t == 0))); asm volatile("" : "+s"(relax));
            PG8_LDB(B0, 0, 0); PG8_LDB(B1, 0, 1); PG8_SCHED; PG8_LDA(At, 0, 0); if (!relax) PG8_STAGE(PG8_SA(1, 1), a1 + hstep, voffA);
            if (relax) PG8_WAIT_VN(8 + Epi::NST); else PG8_WAIT_V(8); PG8_WAIT_L(0); PG8_BAR; PG8_MMA(0, 0, At, B0); PG8_MMA(0, 1, At, B1); PG8_BAR; PG8_SCHED;
            PG8_LDA(At, 0, 1); PG8_STAGE(PG8_SB(0, 0), b2, voffB); PG8_STAGE(PG8_SB(0, 1), b2 + hstep, voffB); PG8_STAGE(PG8_SA(0, 0), a2, voffA);
            if (relax) PG8_WAIT_VN(8 + Epi::NST); else PG8_WAIT_V(8); PG8_WAIT_L(0); PG8_BAR; PG8_MMA(1, 0, At, B0); PG8_MMA(1, 1, At, B1); PG8_BAR; PG8_SCHED;
            PG8_LDB(B0, 1, 0); PG8_LDB(B1, 1, 1); PG8_SCHED; PG8_LDA(At, 1, 0); PG8_STAGE(PG8_SA(0, 1), a2 + hstep, voffA);
            if (relax) PG8_WAIT_VN(8 + Epi::NST); else PG8_WAIT_V(8); PG8_WAIT_L(0); PG8_BAR; PG8_MMA(0, 0, At, B0); PG8_MMA(0, 1, At, B1); PG8_BAR; PG8_SCHED;
            PG8_LDA(At, 1, 1); PG8_STAGE(PG8_SB(1, 0), b3, voffB); PG8_STAGE(PG8_SB(1, 1), b3 + hstep, voffB); PG8_STAGE(PG8_SA(1, 0), a3, voffA);
            PG8_WAIT_V(8); PG8_WAIT_L(0); PG8_BAR; PG8_MMA(1, 0, At, B0); PG8_MMA(1, 1, At, B1); PG8_BAR; PG8_SCHED;
            if (last && has_next) PG8_STAGE(PG8_SA(1, 1), a3 + hstep, voffA);
            } else {
            PG8_LDB(B0, 0, 0); PG8_SCHED; PG8_LDA(At, 0, 0); PG8_STAGE(PG8_SA(1, 1), a1 + hstep, voffA);
            PG8_WAIT_L(8); PG8_BAR; PG8_WAIT_L(0); PG8_MMA(0, 0, At, B0); PG8_BAR; PG8_SCHED;
            PG8_LDB(B1, 0, 1); PG8_STAGE(PG8_SB(0, 0), b2, voffB);
            PG8_BAR; PG8_WAIT_L(0); PG8_MMA(0, 1, At, B1); PG8_BAR;
            PG8_LDA(At, 0, 1); PG8_STAGE(PG8_SA(0, 0), a2, voffA);
            PG8_BAR; PG8_WAIT_L(0); PG8_MMA(1, 0, At, B0); PG8_BAR; PG8_SCHED;
            PG8_STAGE(PG8_SB(0, 1), b2 + hstep, voffB);
            PG8_WAIT_V(6); PG8_BAR; PG8_MMA(1, 1, At, B1); PG8_BAR;
            PG8_LDB(B0, 1, 0); PG8_SCHED; PG8_LDA(At, 1, 0); PG8_STAGE(PG8_SA(0, 1), a2 + hstep, voffA);
            PG8_WAIT_L(8); PG8_BAR; PG8_WAIT_L(0); PG8_MMA(0, 0, At, B0); PG8_BAR; PG8_SCHED;
            PG8_LDB(B1, 1, 1); PG8_STAGE(PG8_SB(1, 0), b3, voffB);
            PG8_BAR; PG8_WAIT_L(0); PG8_MMA(0, 1, At, B1); PG8_BAR;
            PG8_LDA(At, 1, 1); PG8_STAGE(PG8_SA(1, 0), a3, voffA);
            PG8_BAR; PG8_WAIT_L(0); PG8_MMA(1, 0, At, B0); PG8_BAR; PG8_SCHED;
            PG8_STAGE(PG8_SB(1, 1), b3 + hstep, voffB);
            PG8_WAIT_V(6); PG8_BAR; PG8_MMA(1, 1, At, B1); PG8_BAR;
            }
        }
        TS_END(sw, 20); TS_BEG(sw, 21);
        if constexpr (ALIGN_EPI) { if (wr == 0) PG8_BAR; }
        TS_END(sw, 21); TS_BEG(sw, 22);
        if constexpr (!Epi::AFTER_DRAIN) { asm volatile("; EPI_BEGIN" ::: "memory"); E(acc, cur, wr, wc, fr, fq); asm volatile("; EPI_END" ::: "memory"); S.done(cur); }
        TS_END(sw, 22); TS_END(sw, 23);
        if (!has_next) break;
#pragma unroll
        for (int a = 0; a < 2; ++a)
#pragma unroll
            for (int b = 0; b < 2; ++b)
#pragma unroll
                for (int m = 0; m < 4; ++m)
#pragma unroll
                    for (int n = 0; n < 2; ++n) acc[a][b][m][n] = typename Epi::acc_t{};
        cur = nxt; cA = nA; cB = nB; ++ui;
        if constexpr (ALIGN_EPI) { if (wr == 1) PG8_BAR; }
    }
    PG8_WAIT_V(0);
    if constexpr (!ALIGN_EPI) { if (wr == 0) PG8_BAR; }
    PG8_BAR;
    if constexpr (Epi::AFTER_DRAIN) { E.fused(acc, cur, wr, wc, fr, fq, lds, wid, lane); S.done(cur); }
#undef PG8_SA
#undef PG8_SB
#undef PG8_STAGE
#undef PG8_LDA
#undef PG8_LDB
#undef PG8_MMA
#undef PG8_WAIT_V
#undef PG8_WAIT_VN
#undef PG8_WAIT_L
#undef PG8_BAR
#undef PG8_SCHED
}
}
namespace pg8 {
__device__ __forceinline__ float sigm(float v) { return __builtin_amdgcn_rcpf(1.0f + __builtin_amdgcn_exp2f(-1.4426950408889634f * v)); }
struct EpiProj {
    typedef f32x4 acc_t;
    static constexpr bool PERM = true, AFTER_DRAIN = false, MID = false; static constexpr int MID_T0 = -1, MID_T1 = -1, NST = 16;
    bf16_t* O; int ldc; float qscale; const float* rs; int pn0; unsigned modew;
    __device__ __forceinline__ void operator()(const f32x4 (&acc)[2][2][4][2], const Unit& u, int wr, int wc, int fr, int fq) const {
        const int pt = u.pn + pn0; const int row0 = u.pm * BM + wr * 64 + fr, col0 = pt * BM + wc * 32 + 8 * fq;
        const int mode = (int)((modew >> (2 * (pt >> 2))) & 3u);
        const float sc = mode == 1 ? qscale : 1.f;
#pragma unroll
        for (int ai = 0; ai < 2; ++ai)
#pragma unroll
            for (int m = 0; m < 4; ++m) { bf16_t* rowp = O + (size_t)(row0 + ai * HALF + m * 16) * ldc + col0; const float rr = rs[row0 + ai * HALF + m * 16];
#pragma unroll
                for (int bj = 0; bj < 2; ++bj) { f32x4 v0 = acc[ai][bj][m][0] * rr, v1 = acc[ai][bj][m][1] * rr;
                    if (mode >= 2) {
#pragma unroll
                        for (int j = 0; j < 4; ++j) { const float s0 = sigm(v0[j]), s1 = sigm(v1[j]); v0[j] = mode == 3 ? s0 : v0[j] * s0; v1[j] = mode == 3 ? s1 : v1[j] * s1; }
                    } else { v0 = v0 * sc; v1 = v1 * sc; }
                    u32x4 w; w.x = cvt_pk_bf16(v0[0], v0[1]); w.y = cvt_pk_bf16(v0[2], v0[3]); w.z = cvt_pk_bf16(v1[0], v1[1]); w.w = cvt_pk_bf16(v1[2], v1[3]);
                    *(u32x4*)(rowp + bj * HALF) = w; } }
    }
};
struct EpiRelu2 {
    typedef f32x4 acc_t;
    static constexpr bool PERM = true, AFTER_DRAIN = false, MID = false; static constexpr int MID_T0 = -1, MID_T1 = -1, NST = 16;
    bf16_t* O; int ldc; const float* rs;
    __device__ __forceinline__ void operator()(const f32x4 (&acc)[2][2][4][2], const Unit& u, int wr, int wc, int fr, int fq) const {
        const int row0 = u.pm * BM + wr * 64 + fr, col0 = u.pn * BM + wc * 32 + 8 * fq;
#pragma unroll
        for (int ai = 0; ai < 2; ++ai)
#pragma unroll
            for (int m = 0; m < 4; ++m) { bf16_t* rowp = O + (size_t)(row0 + ai * HALF + m * 16) * ldc + col0; const float rr = rs[row0 + ai * HALF + m * 16];
#pragma unroll
                for (int bj = 0; bj < 2; ++bj) { f32x4 v0 = acc[ai][bj][m][0], v1 = acc[ai][bj][m][1];
#pragma unroll
                    for (int j = 0; j < 4; ++j) { const float a = __builtin_fmaxf(v0[j], 0.f) * rr, b = __builtin_fmaxf(v1[j], 0.f) * rr; v0[j] = a * a; v1[j] = b * b; }
                    u32x4 w; w.x = cvt_pk_bf16(v0[0], v0[1]); w.y = cvt_pk_bf16(v0[2], v0[3]); w.z = cvt_pk_bf16(v1[0], v1[1]); w.w = cvt_pk_bf16(v1[2], v1[3]);
                    *(u32x4*)(rowp + bj * HALF) = w; } }
    }
};
struct EpiSq {
    typedef f32x4 acc_t;
    static constexpr bool PERM = true, AFTER_DRAIN = false, MID = false; static constexpr int MID_T0 = -1, MID_T1 = -1, NST = 24;
    bf16_t* O; int ldc; float* part;
    __device__ __forceinline__ void operator()(const f32x4 (&acc)[2][2][4][2], const Unit& u, int wr, int wc, int fr, int fq) const {
        const int row0 = u.pm * BM + wr * 64 + fr, col0 = u.pn * BM + wc * 32 + 8 * fq;
#pragma unroll
        for (int ai = 0; ai < 2; ++ai)
#pragma unroll
            for (int m = 0; m < 4; ++m) { const int row = row0 + ai * HALF + m * 16; bf16_t* rowp = O + (size_t)row * ldc + col0; float ss = 0.f;
#pragma unroll
                for (int bj = 0; bj < 2; ++bj) { const f32x4 v0 = acc[ai][bj][m][0], v1 = acc[ai][bj][m][1];
                    ss += (v0[0] * v0[0] + v0[1] * v0[1]) + (v0[2] * v0[2] + v0[3] * v0[3]) + (v1[0] * v1[0] + v1[1] * v1[1]) + (v1[2] * v1[2] + v1[3] * v1[3]);
                    u32x4 w; w.x = cvt_pk_bf16(v0[0], v0[1]); w.y = cvt_pk_bf16(v0[2], v0[3]); w.z = cvt_pk_bf16(v1[0], v1[1]); w.w = cvt_pk_bf16(v1[2], v1[3]);
                    *(u32x4*)(rowp + bj * HALF) = w; }
                ss += __shfl_xor(ss, 16); ss += __shfl_xor(ss, 32);
                if (fq == 0) part[(size_t)row * 32 + u.pn * 4 + wc] = ss; }
    }
};
struct EpiWiden {
    typedef f32x4 acc_t;
    static constexpr bool PERM = true, AFTER_DRAIN = false, MID = true; static constexpr int MID_T0 = 16, MID_T1 = 32, NST = 16;
    bf16_t* O; int ldc; const unsigned char* G; int ldg;
    static __device__ __forceinline__ float ub(unsigned w, int k) { return (float)((w >> (8 * k)) & 255u); }
    __device__ __forceinline__ void mid(f32x4 (&acc)[2][2][4][2], const Unit& u, int t, int wr, int wc, int fr, int fq) const {
        const int row0 = u.pm * BM + wr * 64 + fr, col0 = u.pn * BM + wc * 32 + 8 * fq;
        const unsigned char* gp = G + (t == MID_T0 ? 0 : 2048) + col0 + (size_t)row0 * ldg;
#pragma unroll
        for (int ai = 0; ai < 2; ++ai) { u32x2 ga[4][2], gb[4][2];
#pragma unroll
            for (int m = 0; m < 4; ++m)
#pragma unroll
                for (int bj = 0; bj < 2; ++bj) { const unsigned char* p = gp + (size_t)(ai * HALF + m * 16) * ldg + bj * HALF; ga[m][bj] = *(const u32x2*)p; gb[m][bj] = *(const u32x2*)(p + 2048); }
#pragma unroll
            for (int m = 0; m < 4; ++m)
#pragma unroll
                for (int bj = 0; bj < 2; ++bj)
#pragma unroll
                    for (int h = 0; h < 2; ++h)
#pragma unroll
                        for (int k = 0; k < 4; ++k) acc[ai][bj][m][h][k] *= ub(ga[m][bj][h], k) * __builtin_amdgcn_rcpf(ub(gb[m][bj][h], k));
            asm volatile("" : "+v"(acc[ai][0][0][0]), "+v"(acc[ai][0][0][1]), "+v"(acc[ai][1][0][0]), "+v"(acc[ai][1][0][1]), "+v"(acc[ai][0][1][0]), "+v"(acc[ai][0][1][1]), "+v"(acc[ai][1][1][0]), "+v"(acc[ai][1][1][1]),
                              "+v"(acc[ai][0][2][0]), "+v"(acc[ai][0][2][1]), "+v"(acc[ai][1][2][0]), "+v"(acc[ai][1][2][1]), "+v"(acc[ai][0][3][0]), "+v"(acc[ai][0][3][1]), "+v"(acc[ai][1][3][0]), "+v"(acc[ai][1][3][1]) :: "memory"); }
    }
    __device__ __forceinline__ void operator()(const f32x4 (&acc)[2][2][4][2], const Unit& u, int wr, int wc, int fr, int fq) const {
        const int row0 = u.pm * BM + wr * 64 + fr, col0 = u.pn * BM + wc * 32 + 8 * fq;
        const unsigned char* Gc = G + 4096 + col0;
        u32x2 gc[2][4][2];
#pragma unroll
        for (int ai = 0; ai < 2; ++ai)
#pragma unroll
            for (int m = 0; m < 4; ++m)
#pragma unroll
                for (int bj = 0; bj < 2; ++bj) gc[ai][m][bj] = *(const u32x2*)(Gc + (size_t)(row0 + ai * HALF + m * 16) * ldg + bj * HALF);
#pragma unroll
        for (int ai = 0; ai < 2; ++ai)
#pragma unroll
            for (int m = 0; m < 4; ++m) { bf16_t* rowp = O + (size_t)(row0 + ai * HALF + m * 16) * ldc + col0;
#pragma unroll
                for (int bj = 0; bj < 2; ++bj) { f32x4 v0 = acc[ai][bj][m][0], v1 = acc[ai][bj][m][1];
#pragma unroll
                    for (int k = 0; k < 4; ++k) { v0[k] *= ub(gc[ai][m][bj][0], k) * (1.0f / 255.0f); v1[k] *= ub(gc[ai][m][bj][1], k) * (1.0f / 255.0f); }
                    u32x4 w; w.x = cvt_pk_bf16(v0[0], v0[1]); w.y = cvt_pk_bf16(v0[2], v0[3]); w.z = cvt_pk_bf16(v1[0], v1[1]); w.w = cvt_pk_bf16(v1[2], v1[3]);
                    *(u32x4*)(rowp + bj * HALF) = w; } }
    }
};

struct EpiProjQ {
    typedef i32x4 acc_t;
    static constexpr bool PERM = true, AFTER_DRAIN = false, MID = false; static constexpr int MID_T0 = -1, MID_T1 = -1, NST = 16;
    bf16_t* O; int ldc; float qscale; const float* rq; const float* cmax; int pn0; unsigned modew; int cgate;
    template <int MODE> __device__ __forceinline__ void body(const i32x4 (&acc)[2][2][4][2], int row0, int col0, const float (&rr)[2][4], const f32x4 (&cc)[2][2]) const {
#pragma unroll
        for (int bj = 0; bj < 2; ++bj)
#pragma unroll
            for (int ai = 0; ai < 2; ++ai)
#pragma unroll
                for (int m = 0; m < 4; ++m) { const int row = row0 + ai * HALF + m * 16;
                    f32x4 v0 = __builtin_convertvector(acc[ai][bj][m][0], f32x4) * (cc[bj][0] * rr[ai][m]), v1 = __builtin_convertvector(acc[ai][bj][m][1], f32x4) * (cc[bj][1] * rr[ai][m]);
                    if (MODE == 2) {
#pragma unroll
                        for (int j = 0; j < 4; ++j) { v0[j] *= sigm(v0[j]); v1[j] *= sigm(v1[j]); } }
                    if (MODE == 3) { u32x2 w;
#pragma unroll
                        for (int j = 0; j < 4; ++j) { v0[j] = __builtin_fmaxf(__builtin_amdgcn_rcpf(__builtin_fmaf(__builtin_amdgcn_exp2f(v0[j]), 1.0f / 255.0f, 1.0f / 255.0f)), 1.f);
                                                      v1[j] = __builtin_fmaxf(__builtin_amdgcn_rcpf(__builtin_fmaf(__builtin_amdgcn_exp2f(v1[j]), 1.0f / 255.0f, 1.0f / 255.0f)), 1.f); }
                        { const unsigned k0 = (unsigned)__builtin_rintf(v0[0]), k1 = (unsigned)__builtin_rintf(v0[1]), k2 = (unsigned)__builtin_rintf(v0[2]), k3 = (unsigned)__builtin_rintf(v0[3]);
                          w.x = k0 | (k1 << 8) | (k2 << 16) | (k3 << 24); }
                        { const unsigned k0 = (unsigned)__builtin_rintf(v1[0]), k1 = (unsigned)__builtin_rintf(v1[1]), k2 = (unsigned)__builtin_rintf(v1[2]), k3 = (unsigned)__builtin_rintf(v1[3]);
                          w.y = k0 | (k1 << 8) | (k2 << 16) | (k3 << 24); }
                        *(u32x2*)((unsigned char*)(O + (size_t)row * ldc + cgate) + (col0 + bj * HALF - cgate)) = w; }
                    else { u32x4 w; w.x = cvt_pk_bf16(v0[0], v0[1]); w.y = cvt_pk_bf16(v0[2], v0[3]); w.z = cvt_pk_bf16(v1[0], v1[1]); w.w = cvt_pk_bf16(v1[2], v1[3]);
                        *(u32x4*)(O + (size_t)row * ldc + col0 + bj * HALF) = w; } }
    }
    __device__ __forceinline__ void operator()(const i32x4 (&acc)[2][2][4][2], const Unit& u, int wr, int wc, int fr, int fq) const {
        const int pt = u.pn + pn0; const int row0 = u.pm * BM + wr * 64 + fr, col0 = pt * BM + wc * 32 + 8 * fq;
        const int mode = (int)((modew >> (2 * (pt >> 2))) & 3u);
        const float sc = (mode == 1 ? qscale : (mode == 3 ? -1.4426950408889634f : 1.f)) * (1.0f / 127.0f);
        float rr[2][4]; f32x4 cc[2][2];
#pragma unroll
        for (int ai = 0; ai < 2; ++ai)
#pragma unroll
            for (int m = 0; m < 4; ++m) rr[ai][m] = rq[row0 + ai * HALF + m * 16];
#pragma unroll
        for (int bj = 0; bj < 2; ++bj) { cc[bj][0] = *(const f32x4*)(cmax + col0 + bj * HALF) * sc; cc[bj][1] = *(const f32x4*)(cmax + col0 + bj * HALF + 4) * sc; }
        if (mode == 3) body<3>(acc, row0, col0, rr, cc); else if (mode == 2) body<2>(acc, row0, col0, rr, cc); else body<0>(acc, row0, col0, rr, cc);
    }
};
struct EpiRelu2Q {
    typedef i32x4 acc_t;
    static constexpr bool PERM = true, AFTER_DRAIN = false, MID = false; static constexpr int MID_T0 = -1, MID_T1 = -1, NST = 16;
    bf16_t* O; int ldc; const float* rq; const float* cmax;
    __device__ __forceinline__ void operator()(const i32x4 (&acc)[2][2][4][2], const Unit& u, int wr, int wc, int fr, int fq) const {
        const int row0 = u.pm * BM + wr * 64 + fr, col0 = u.pn * BM + wc * 32 + 8 * fq;
        float rr[2][4]; f32x4 cc[2][2];
#pragma unroll
        for (int ai = 0; ai < 2; ++ai)
#pragma unroll
            for (int m = 0; m < 4; ++m) rr[ai][m] = rq[row0 + ai * HALF + m * 16];
#pragma unroll
        for (int bj = 0; bj < 2; ++bj) { cc[bj][0] = *(const f32x4*)(cmax + col0 + bj * HALF) * (1.0f / 127.0f); cc[bj][1] = *(const f32x4*)(cmax + col0 + bj * HALF + 4) * (1.0f / 127.0f); }
#pragma unroll
        for (int bj = 0; bj < 2; ++bj)
#pragma unroll
            for (int ai = 0; ai < 2; ++ai)
#pragma unroll
                for (int m = 0; m < 4; ++m) { const int row = row0 + ai * HALF + m * 16;
                    f32x4 v0 = __builtin_convertvector(acc[ai][bj][m][0], f32x4) * (cc[bj][0] * rr[ai][m]), v1 = __builtin_convertvector(acc[ai][bj][m][1], f32x4) * (cc[bj][1] * rr[ai][m]);
#pragma unroll
                    for (int j = 0; j < 4; ++j) { const float a = __builtin_fmaxf(v0[j], 0.f), b = __builtin_fmaxf(v1[j], 0.f); v0[j] = a * a; v1[j] = b * b; }
                    u32x4 w; w.x = cvt_pk_bf16(v0[0], v0[1]); w.y = cvt_pk_bf16(v0[2], v0[3]); w.z = cvt_pk_bf16(v1[0], v1[1]); w.w = cvt_pk_bf16(v1[2], v1[3]);
                    *(u32x4*)(O + (size_t)row * ldc + col0 + bj * HALF) = w; }
    }
};
}
#define DUPMASK 0
#ifndef GEMM_ALIGN
#define GEMM_ALIGN true
#endif
#ifndef GEMM_SP2
#define GEMM_SP2 true
#endif
#define STAGGER_US 0
#define UP_INT8 1
constexpr int NWAVES = 8;
constexpr bool SINGLE_LAUNCH = 1;
constexpr int BATCH = 4, SEQ = 4096, DM = 2048, DEPTH = 4, MIXW = 1024, M = BATCH * SEQ, INC = 14336, DFF = 8192;
constexpr int LDP = INC;
#ifndef PROJ_ORD_LIST
#define PROJ_ORD_LIST 8, 9, 10, 11, 12, 13, 0, 1, 2, 3, 4, 5, 6, 7
#endif
#ifndef PROJ_NS
#define PROJ_NS 14336
#endif
constexpr int PROJ_ORD[14] = {PROJ_ORD_LIST};
constexpr int proj_pos(int blk) { for (int p = 0; p < 14; ++p) if (PROJ_ORD[p] == blk) return p; return -1; }
constexpr unsigned long long proj_posword() { unsigned long long w = 0; for (int b = 0; b < 14; ++b) w |= (unsigned long long)proj_pos(b) << (4 * b); return w; }
constexpr unsigned proj_modeword() { unsigned w = 0; for (int p = 0; p < 14; ++p) { const int b = PROJ_ORD[p]; const unsigned md = b >= 8 ? 3u : (b == 7 ? 2u : (b == 1 ? 1u : 0u)); w |= md << (2 * p); } return w; }
constexpr unsigned long long PROJ_POSW = proj_posword(); constexpr unsigned PROJ_MODEW = proj_modeword();
static_assert(proj_pos(8) + 1 == proj_pos(9) && proj_pos(9) + 1 == proj_pos(10) && proj_pos(10) + 1 == proj_pos(11) && proj_pos(11) + 1 == proj_pos(12) && proj_pos(12) + 1 == proj_pos(13), "the six gate blocks stay adjacent and in order");
constexpr int C_POOL = 1024 * proj_pos(0), C_QD = 1024 * proj_pos(1), C_KD = 1024 * proj_pos(2), C_VD = 1024 * proj_pos(3), C_QR = 1024 * proj_pos(4), C_KR = 1024 * proj_pos(5), C_VR = 1024 * proj_pos(6), C_GR = 1024 * proj_pos(7), C_GATE = 1024 * proj_pos(8);
constexpr unsigned long long proj_ordword() { unsigned long long w = 0; for (int p = 0; p < 14; ++p) w |= (unsigned long long)PROJ_ORD[p] << (4 * p); return w; }
constexpr unsigned long long PROJ_ORDW = proj_ordword();
__device__ __forceinline__ int proj_oldcol(int sc) { return 1024 * (int)((PROJ_ORDW >> (4 * (sc >> 10))) & 15ull) + (sc & 1023); }
__device__ __forceinline__ int proj_newcol(int n) { return 1024 * (int)((PROJ_POSW >> (4 * (n >> 10))) & 15ull) + (n & 1023); }
constexpr int LDY = 3072;
constexpr float NORM_EPS = 1e-6f;
constexpr float LOG2E = 1.4426950408889634f;
constexpr float QSCALE = 0.125f * 1.4426950408889634f;
constexpr float RET_KSCALE = 0.08838834764831845f;

constexpr size_t MiB = 1u << 20;
constexpr size_t WS_CTL = 0, CTL_ZERO_BYTES = 1 * MiB;
constexpr size_t WS_ROT = 1 * MiB;
constexpr size_t WS_STAT = 3 * MiB;
constexpr size_t WS_POOLT = 5 * MiB;
constexpr size_t WS_RS = 7 * MiB;
constexpr size_t WS_RQ = 7 * MiB + 65536;
constexpr size_t WS_XQ = (8 + 128) * MiB;
constexpr size_t WS_WIN = 8 * MiB;
constexpr size_t WS_WB = WS_WIN + 224 * MiB;
constexpr size_t WS_WO = WS_WB + 48 * MiB;
constexpr size_t WS_WUP = WS_WO + 32 * MiB;
constexpr size_t WS_WDN = WS_WUP + 128 * MiB;
constexpr size_t WS_XN = WS_WDN + 128 * MiB;
constexpr size_t WS_MRG = WS_XN + 64 * MiB;
constexpr size_t WS_MIX = WS_MRG + 64 * MiB;
constexpr size_t WS_Y = WS_MIX + 64 * MiB;
constexpr size_t WS_KV = WS_Y + 96 * MiB;
constexpr size_t WS_SST = WS_KV + 64 * MiB;
constexpr size_t WS_PROJ = WS_SST + 32 * MiB;
constexpr size_t WS_WQDN = WS_PROJ + 448 * MiB;
constexpr size_t WS_END = WS_WQDN + 64 * MiB;

constexpr int CW_BAR = 4096;
constexpr size_t CTL_CMAX_IN = 256 * 1024, CTL_CMAX_UP = 512 * 1024, CTL_CMAX_DN = 672 * 1024;

constexpr int RING_BYTES = 131072;
constexpr int LDSCTL_OFF = 135168, MISC_OFF = LDSCTL_OFF + 320;
constexpr int LDS_BYTES = 147456;

#define GAS __attribute__((address_space(1)))
#define LAS __attribute__((address_space(3)))
typedef unsigned short bf16;
typedef unsigned v4u __attribute__((ext_vector_type(4)));
typedef unsigned v2u __attribute__((ext_vector_type(2)));
typedef float f32x4 __attribute__((ext_vector_type(4)));
typedef float f32x2 __attribute__((ext_vector_type(2)));
typedef float f32x16 __attribute__((ext_vector_type(16)));
typedef short bf16x8 __attribute__((ext_vector_type(8)));
typedef short s16x4 __attribute__((ext_vector_type(4)));
typedef GAS unsigned gu32;
#define RLX_AGENT __ATOMIC_RELAXED, __HIP_MEMORY_SCOPE_AGENT
#define LDS_WAIT() asm volatile("s_waitcnt lgkmcnt(0)" ::: "memory")
#define VM_WAIT() asm volatile("s_waitcnt vmcnt(0)" ::: "memory")
#define WG_BAR() do { asm volatile("s_waitcnt vmcnt(0) lgkmcnt(0)" ::: "memory"); __builtin_amdgcn_s_barrier(); asm volatile("" ::: "memory"); } while (0)

typedef float f32x2_t_ __attribute__((ext_vector_type(2))); typedef __bf16 bf16x2_t_ __attribute__((ext_vector_type(2)));
typedef _Float16 f16x2_t_ __attribute__((ext_vector_type(2)));
__device__ __forceinline__ unsigned pkh2(float lo, float hi) { f32x2_t_ v = {lo, hi}; f16x2_t_ h = __builtin_convertvector(v, f16x2_t_); return __builtin_bit_cast(unsigned, h); }
__device__ __forceinline__ float hlo(unsigned w) { return (float)__builtin_bit_cast(f16x2_t_, w)[0]; }
__device__ __forceinline__ float hhi(unsigned w) { return (float)__builtin_bit_cast(f16x2_t_, w)[1]; }
__device__ __forceinline__ unsigned pk2(float lo, float hi) { f32x2_t_ v = {lo, hi}; bf16x2_t_ b = __builtin_convertvector(v, bf16x2_t_); return __builtin_bit_cast(unsigned, b); }
__device__ __forceinline__ float bflo(unsigned w) { return __builtin_bit_cast(float, w << 16); }
__device__ __forceinline__ float bfhi(unsigned w) { return __builtin_bit_cast(float, w & 0xffff0000u); }
__device__ __forceinline__ float wave_sum(float v) {
#pragma unroll
    for (int o = 1; o < 64; o <<= 1) v += __shfl_xor(v, o);
    return v;
}
__device__ __forceinline__ void half_swap(unsigned& a, unsigned& b) { asm volatile("s_nop 1\n\tv_permlane32_swap_b32 %0, %1\n\ts_nop 1" : "+v"(a), "+v"(b)); }
__device__ __forceinline__ float half_swap_max(float m) { unsigned a = __builtin_bit_cast(unsigned, m), b = a; half_swap(a, b); return __builtin_fmaxf(__builtin_bit_cast(float, a), __builtin_bit_cast(float, b)); }
__device__ __forceinline__ float half_swap_sum(float m) { unsigned a = __builtin_bit_cast(unsigned, m), b = a; half_swap(a, b); return __builtin_bit_cast(float, a) + __builtin_bit_cast(float, b); }
__device__ __forceinline__ int crow(int r, int hi) { return (r & 3) + 8 * (r >> 2) + 4 * hi; }
__device__ __forceinline__ int swap23(int i) { return (i & 0x13) | ((i & 4) << 1) | ((i & 8) >> 1); }
__device__ __forceinline__ unsigned offb(int row, int ch) { return 256u * (unsigned)row + 16u * (unsigned)(ch ^ (((row & 3) << 2) | ((row >> 2) & 3))); }
__device__ __forceinline__ unsigned tr_off(int lane, int c, int t) { const int h = lane >> 5, blk = (lane >> 4) & 1, q = (lane & 15) >> 2, p = lane & 3; return offb(8 * h + 4 * t + q, 4 * c + 2 * blk + (p >> 1)) + 8u * (unsigned)(p & 1); }
typedef short v4i16_t __attribute__((ext_vector_type(4)));
__device__ __forceinline__ s16x4 ldtr(LAS unsigned char* p) { return __builtin_bit_cast(s16x4, __builtin_amdgcn_ds_read_tr16_b64_v4i16((LAS v4i16_t*)p)); }
__device__ __forceinline__ bf16x8 trfrag(LAS unsigned char* tile, unsigned o0, unsigned o1) { const s16x4 a = ldtr(tile + o0), b = ldtr(tile + o1); return (bf16x8){a[0], a[1], a[2], a[3], b[0], b[1], b[2], b[3]}; }
__device__ __forceinline__ void glds16(const void* gsrc, LAS unsigned char* dst) { __builtin_amdgcn_global_load_lds((const unsigned*)gsrc, (LAS unsigned*)dst, 16, 0, 0); }
__device__ __forceinline__ void glds16_asm(const void* gsrc, LAS unsigned char* dst) { unsigned keep; const unsigned d = (unsigned)__builtin_amdgcn_readfirstlane((int)(unsigned)(size_t)dst);
    asm volatile("s_mov_b32 %0, m0\n\ts_mov_b32 m0, %2\n\ts_nop 0\n\tglobal_load_lds_dwordx4 %1, off\n\ts_mov_b32 m0, %0" : "=&s"(keep) : "v"(gsrc), "s"(d) : "memory"); }
__device__ __forceinline__ f32x16 splat16(float v) { f32x16 r;
#pragma unroll
    for (int i = 0; i < 16; ++i) r[i] = v; return r; }
#define MFMA32(a, b, c) __builtin_amdgcn_mfma_f32_32x32x16_bf16((a), (b), (c), 0, 0, 0)

__device__ __constant__ const float kLog2Gamma[8] = {-0.04580368961312479f, -0.02272007650008353f, -0.011315313227834146f, -0.005646563141142063f, -0.0028205190623786626f, -0.0014095702546713536f, -0.0007046129765893727f, -0.0003522634716290214f};
__device__ __forceinline__ int t5_bucket(int n) {
    if (n < 16) return n;
    if (n >= 113) return 31;
    int b = 16;
    b += (n >= 19); b += (n >= 21); b += (n >= 24); b += (n >= 27); b += (n >= 31); b += (n >= 35); b += (n >= 40); b += (n >= 46);
    b += (n >= 52); b += (n >= 59); b += (n >= 67); b += (n >= 77); b += (n >= 87); b += (n >= 99);
    return b;
}

struct P0Item { const float* W; int N; bf16* WT; int ldt; int koff; const float* gain; int nrow0; unsigned* cmax; int item; };
__device__ __forceinline__ void p0_load(const P0Item& p, int lane, float (&v)[32]) {
    const int nblk = p.N / 32, kb = p.item / nblk, nb = p.item % nblk, k0 = 64 * kb, n0 = 32 * nb;
    const float* wp = p.W + (size_t)(k0 + (lane >> 5)) * p.N + n0 + (lane & 31);
#pragma unroll
    for (int i = 0; i < 32; ++i) v[i] = wp[(size_t)(2 * i) * p.N];
}
__device__ __forceinline__ void p0_stage(LAS float* scr, int lane, const float (&v)[32]) {
#pragma unroll
    for (int i = 0; i < 32; ++i) scr[(2 * i + (lane >> 5)) * 33 + (lane & 31)] = v[i];
    LDS_WAIT(); asm volatile("" ::: "memory");
}
__device__ __forceinline__ void p0_emit(const P0Item& p, LAS float* scr, int lane) {
    const int nblk = p.N / 32, kb = p.item / nblk, nb = p.item % nblk, k0 = 64 * kb, n0 = 32 * nb;
    const int c = lane & 7;
    f32x4 ga = {1.f, 1.f, 1.f, 1.f}, gb = ga; if (p.gain) { ga = *(const GAS f32x4*)(p.gain + k0 + 8 * c); gb = *(const GAS f32x4*)(p.gain + k0 + 8 * c + 4); }
#pragma unroll
    for (int j = 0; j < 4; ++j) { const int n = (lane >> 3) + 8 * j; const LAS float* s = scr + (8 * c) * 33 + n;
        const float e0 = s[0 * 33] * ga.x, e1 = s[1 * 33] * ga.y, e2 = s[2 * 33] * ga.z, e3 = s[3 * 33] * ga.w, e4 = s[4 * 33] * gb.x, e5 = s[5 * 33] * gb.y, e6 = s[6 * 33] * gb.z, e7 = s[7 * 33] * gb.w;
        v4u o; if (p.cmax) { o.x = pkh2(e0, e1); o.y = pkh2(e2, e3); o.z = pkh2(e4, e5); o.w = pkh2(e6, e7); }
        else { o.x = pk2(e0, e1); o.y = pk2(e2, e3); o.z = pk2(e4, e5); o.w = pk2(e6, e7); }
        const int nr = (p.nrow0 >= 0 ? p.nrow0 : n0) + n;
        *(GAS v4u*)(p.WT + (size_t)nr * p.ldt + p.koff + k0 + 8 * c) = o;
        if (p.cmax) { float mx = __builtin_fmaxf(__builtin_fmaxf(__builtin_fmaxf(__builtin_fabsf(e0), __builtin_fabsf(e1)), __builtin_fmaxf(__builtin_fabsf(e2), __builtin_fabsf(e3))), __builtin_fmaxf(__builtin_fmaxf(__builtin_fabsf(e4), __builtin_fabsf(e5)), __builtin_fmaxf(__builtin_fabsf(e6), __builtin_fabsf(e7)))) * 1.001f;
            mx = __builtin_fmaxf(mx, __shfl_xor(mx, 1)); mx = __builtin_fmaxf(mx, __shfl_xor(mx, 2)); mx = __builtin_fmaxf(mx, __shfl_xor(mx, 4));
            if (c == 0) __hip_atomic_fetch_max(p.cmax + nr, __builtin_bit_cast(unsigned, mx), __ATOMIC_RELAXED, __HIP_MEMORY_SCOPE_AGENT); } }
    LDS_WAIT(); asm volatile("" ::: "memory");
}
__device__ __forceinline__ float wave_max(float v) {
#pragma unroll
    for (int o = 1; o < 64; o <<= 1) v = __builtin_fmaxf(v, __shfl_xor(v, o));
    return v;
}
__device__ __forceinline__ unsigned q4(f32x4 v, float q) {
    const int a = (int)__builtin_rintf(v.x * q), b = (int)__builtin_rintf(v.y * q), c = (int)__builtin_rintf(v.z * q), d = (int)__builtin_rintf(v.w * q);
    return ((unsigned)a & 255u) | (((unsigned)b & 255u) << 8) | (((unsigned)c & 255u) << 16) | ((unsigned)d << 24);
}
__device__ __forceinline__ unsigned q4c(f32x4 v, float q) {
    v = v * q; v.x = __builtin_fminf(__builtin_fmaxf(v.x, -127.f), 127.f); v.y = __builtin_fminf(__builtin_fmaxf(v.y, -127.f), 127.f); v.z = __builtin_fminf(__builtin_fmaxf(v.z, -127.f), 127.f); v.w = __builtin_fminf(__builtin_fmaxf(v.w, -127.f), 127.f);
    return q4(v, 1.0f); }
constexpr int SROW = 4096 + 16;
__device__ __forceinline__ void strip_load(const float* W, int N, int n0, int wave, int lane, float (&v)[4][32]) {
    const float* wp = W + (size_t)(256 * wave + 32 * (lane >> 5)) * N + n0 + (lane & 31);
#pragma unroll
    for (int q = 0; q < 4; ++q)
#pragma unroll
        for (int i = 0; i < 32; ++i) v[q][i] = wp[(size_t)(64 * q + i) * N];
}
__device__ __forceinline__ void strip_stage(LAS unsigned char* lds, const float* gain, int wave, int lane, const float (&v)[4][32]) {
    const int n = lane & 31, h = lane >> 5;
#pragma unroll
    for (int q = 0; q < 4; ++q) { const int kb = 256 * wave + 64 * q + 32 * h;
#pragma unroll
        for (int j = 0; j < 4; ++j) { const f32x4 ga = *(const GAS f32x4*)(gain + kb + 8 * j), gb = *(const GAS f32x4*)(gain + kb + 8 * j + 4);
            v4u o; o.x = pkh2(v[q][8 * j] * ga.x, v[q][8 * j + 1] * ga.y); o.y = pkh2(v[q][8 * j + 2] * ga.z, v[q][8 * j + 3] * ga.w);
            o.z = pkh2(v[q][8 * j + 4] * gb.x, v[q][8 * j + 5] * gb.y); o.w = pkh2(v[q][8 * j + 6] * gb.z, v[q][8 * j + 7] * gb.w);
            *(LAS v4u*)(lds + n * SROW + 2 * (kb + 8 * j)) = o; } }
}
__device__ __forceinline__ void strip_quant(LAS unsigned char* lds, unsigned char* dst, float* cmout, int wave, int lane) {
#pragma unroll
    for (int rr = 0; rr < 4; ++rr) { const int n = 4 * wave + rr; const LAS v4u* s = (const LAS v4u*)(lds + n * SROW) + lane;
        v4u w[4]; float mx = 0.f;
#pragma unroll
        for (int j = 0; j < 4; ++j) { w[j] = s[64 * j];
            mx = __builtin_fmaxf(mx, __builtin_fmaxf(__builtin_fmaxf(__builtin_fmaxf(__builtin_fabsf(hlo(w[j].x)), __builtin_fabsf(hhi(w[j].x))), __builtin_fmaxf(__builtin_fabsf(hlo(w[j].y)), __builtin_fabsf(hhi(w[j].y)))),
                                                 __builtin_fmaxf(__builtin_fmaxf(__builtin_fabsf(hlo(w[j].z)), __builtin_fabsf(hhi(w[j].z))), __builtin_fmaxf(__builtin_fabsf(hlo(w[j].w)), __builtin_fabsf(hhi(w[j].w)))))); }
        mx = wave_max(mx); const float q = 127.0f / __builtin_fmaxf(mx, 1e-30f);
        GAS v2u* d = (GAS v2u*)(dst + (size_t)n * DM) + lane;
#pragma unroll
        for (int j = 0; j < 4; ++j) { v2u o; o.x = q4c((f32x4){hlo(w[j].x), hhi(w[j].x), hlo(w[j].y), hhi(w[j].y)}, q); o.y = q4c((f32x4){hlo(w[j].z), hhi(w[j].z), hlo(w[j].w), hhi(w[j].w)}, q); d[64 * j] = o; }
        if (lane == 0) cmout[n] = mx; }
}
__device__ __forceinline__ float quant_row(const f32x4 (&v)[8], unsigned char* xq, int lane) {
    float mx = 0.f;
#pragma unroll
    for (int j = 0; j < 8; ++j) mx = __builtin_fmaxf(mx, __builtin_fmaxf(__builtin_fmaxf(__builtin_fabsf(v[j].x), __builtin_fabsf(v[j].y)), __builtin_fmaxf(__builtin_fabsf(v[j].z), __builtin_fabsf(v[j].w))));
    mx = __builtin_fmaxf(wave_max(mx), 1e-20f);
    const float q = 127.0f / mx;
    GAS unsigned* o4 = (GAS unsigned*)xq + lane;
#pragma unroll
    for (int j = 0; j < 8; ++j) o4[64 * j] = q4(v[j], q);
    return mx * (1.0f / 127.0f);
}
__device__ __forceinline__ void prep_row(const float* xrow, bf16* orow, unsigned char* xq, float* rs, float* rq, int lane) {
    const GAS f32x4* xr = (const GAS f32x4*)xrow + lane;
    f32x4 v[8]; float s = 0.f;
#pragma unroll
    for (int j = 0; j < 8; ++j) { v[j] = xr[64 * j]; s += (v[j].x * v[j].x + v[j].y * v[j].y) + (v[j].z * v[j].z + v[j].w * v[j].w); }
    s = wave_sum(s);
    GAS v2u* o8 = (GAS v2u*)orow + lane;
#pragma unroll
    for (int j = 0; j < 8; ++j) { v2u w; w.x = pk2(v[j].x, v[j].y); w.y = pk2(v[j].z, v[j].w); o8[64 * j] = w; }
    const float dq = quant_row(v, xq, lane);
    if (lane == 0) { const float r = 1.f / sqrtf(s * (1.f / DM) + NORM_EPS); *rs = r; *rq = r * dq; }
}
__device__ __forceinline__ void resid_row(bf16* xrow, const bf16* yrow, const float* part, const float* gpost, float* rs, float* rq, float* fout, int lane, unsigned char* xq) {
    GAS v2u* xr = (GAS v2u*)xrow + lane; const GAS v2u* yr = (const GAS v2u*)yrow + lane; const GAS f32x4* gp = (const GAS f32x4*)gpost + lane;
    float ps = (lane < 32) ? part[lane] : 0.f; ps = wave_sum(ps);
    const float rs1 = 1.f / sqrtf(ps * (1.f / DM) + NORM_EPS);
    f32x4 v[8]; float s = 0.f;
#pragma unroll
    for (int j = 0; j < 8; ++j) { const v2u x = xr[64 * j]; const v2u y = yr[64 * j]; const f32x4 g = gp[64 * j];
        v[j].x = bflo(x.x) + bflo(y.x) * rs1 * g.x; v[j].y = bfhi(x.x) + bfhi(y.x) * rs1 * g.y; v[j].z = bflo(x.y) + bflo(y.y) * rs1 * g.z; v[j].w = bfhi(x.y) + bfhi(y.y) * rs1 * g.w;
        s += (v[j].x * v[j].x + v[j].y * v[j].y) + (v[j].z * v[j].z + v[j].w * v[j].w); }
    if (fout) { GAS f32x4* xo = (GAS f32x4*)fout + lane;
#pragma unroll
        for (int j = 0; j < 8; ++j) xo[64 * j] = v[j]; }
    else { s = wave_sum(s);
#pragma unroll
        for (int j = 0; j < 8; ++j) { v2u w; w.x = pk2(v[j].x, v[j].y); w.y = pk2(v[j].z, v[j].w); xr[64 * j] = w; }
        const float dq = quant_row(v, xq, lane);
        if (lane == 0) { const float r = 1.f / sqrtf(s * (1.f / DM) + NORM_EPS); *rs = r; *rq = r * dq; } }
}
#ifndef CMAX_SAMPLE
#define CMAX_SAMPLE 1
#endif
constexpr float CMAX_SAFETY = (CMAX_SAMPLE > 1) ? 1.15f : 1.0f;
__device__ __forceinline__ void colmax_item(const float* W, int N, const float* gain, unsigned* cmax, int nrow0, LAS float* scr, int item, int lane) {
    const int nblk = N / 32, kb = item / nblk, nb = item % nblk, k0 = 64 * kb, n0 = 32 * nb;
    LAS float* gs = scr + 64 * 33; gs[lane] = gain[k0 + lane]; LDS_WAIT(); asm volatile("" ::: "memory");
    float mx = 0.f;
#pragma unroll 8
    for (int i = 0; i < 32; ++i) { const int kk = 2 * i + (lane >> 5); mx = __builtin_fmaxf(mx, __builtin_fabsf(W[(size_t)(k0 + kk) * N + n0 + (lane & 31)] * gs[kk])); }
    LDS_WAIT(); asm volatile("" ::: "memory");
    mx = __builtin_fmaxf(mx, __shfl_xor(mx, 32)) * CMAX_SAFETY;
    const int nr = (nrow0 >= 0 ? nrow0 : n0) + (lane & 31);
    if (lane < 32) __hip_atomic_fetch_max(cmax + nr, __builtin_bit_cast(unsigned, mx), __ATOMIC_RELAXED, __HIP_MEMORY_SCOPE_AGENT);
}
template <int KROW> __device__ __forceinline__ void quant_wrow(const bf16* src, float cm, unsigned char* dst, int lane) {
    const float q = 127.0f / __builtin_fmaxf(cm, 1e-30f);
    const GAS v4u* s = (const GAS v4u*)src + lane;
    GAS v2u* d = (GAS v2u*)dst + lane;
#pragma unroll
    for (int j = 0; j < KROW / 512; ++j) { const v4u w = s[64 * j]; v2u o;
        o.x = q4c((f32x4){hlo(w.x), hhi(w.x), hlo(w.y), hhi(w.y)}, q); o.y = q4c((f32x4){hlo(w.z), hhi(w.z), hlo(w.w), hhi(w.w)}, q); d[64 * j] = o; }
}
__device__ __forceinline__ void prep_rows(const float* Xin, bf16* Xo, unsigned char* XQv, float* RSv, float* RQv, int m0, int mstep, int lane) {
    f32x4 v[8], n[8]; int m = m0;
    if (m < M) { const GAS f32x4* xr = (const GAS f32x4*)(Xin + (size_t)m * DM) + lane;
#pragma unroll
        for (int j = 0; j < 8; ++j) v[j] = xr[64 * j]; }
    while (m < M) { const int mn = m + mstep;
        if (mn < M) { const GAS f32x4* xr = (const GAS f32x4*)(Xin + (size_t)mn * DM) + lane;
#pragma unroll
            for (int j = 0; j < 8; ++j) n[j] = xr[64 * j]; }
        float s = 0.f;
#pragma unroll
        for (int j = 0; j < 8; ++j) s += (v[j].x * v[j].x + v[j].y * v[j].y) + (v[j].z * v[j].z + v[j].w * v[j].w);
        s = wave_sum(s);
        GAS v2u* o8 = (GAS v2u*)(Xo + (size_t)m * DM) + lane;
#pragma unroll
        for (int j = 0; j < 8; ++j) { v2u w; w.x = pk2(v[j].x, v[j].y); w.y = pk2(v[j].z, v[j].w); o8[64 * j] = w; }
        const float dq = quant_row(v, XQv + (size_t)m * DM, lane);
        if (lane == 0) { const float r = 1.f / sqrtf(s * (1.f / DM) + NORM_EPS); RSv[m] = r; RQv[m] = r * dq; }
#pragma unroll
        for (int j = 0; j < 8; ++j) v[j] = n[j];
        m = mn; }
}
__device__ __forceinline__ void resid_rows(bf16* X, const bf16* Y, const float* PART, const float* gpost, float* RSv, float* RQv, float* fout, unsigned char* XQv, int m0, int mstep, int lane) {
    f32x4 g[8];
    { const GAS f32x4* gp = (const GAS f32x4*)gpost + lane;
#pragma unroll
      for (int j = 0; j < 8; ++j) g[j] = gp[64 * j]; }
    v2u cx[8], cy[8], nx[8], ny[8]; float cp = 0.f, np = 0.f;
    int m = m0;
    if (m < M) { const GAS v2u* xr = (const GAS v2u*)(X + (size_t)m * DM) + lane; const GAS v2u* yr = (const GAS v2u*)(Y + (size_t)m * DM) + lane; cp = (lane < 32) ? PART[(size_t)m * 32 + lane] : 0.f;
#pragma unroll
        for (int j = 0; j < 8; ++j) { cx[j] = xr[64 * j]; cy[j] = yr[64 * j]; } }
    while (m < M) {
        const int mn = m + mstep;
        if (mn < M) { const GAS v2u* xr = (const GAS v2u*)(X + (size_t)mn * DM) + lane; const GAS v2u* yr = (const GAS v2u*)(Y + (size_t)mn * DM) + lane; np = (lane < 32) ? PART[(size_t)mn * 32 + lane] : 0.f;
#pragma unroll
            for (int j = 0; j < 8; ++j) { nx[j] = xr[64 * j]; ny[j] = yr[64 * j]; } }
        const float ps = wave_sum(cp); const float rs1 = 1.f / sqrtf(ps * (1.f / DM) + NORM_EPS);
        f32x4 v[8]; float s = 0.f;
#pragma unroll
        for (int j = 0; j < 8; ++j) { const v2u x = cx[j], y = cy[j];
            v[j].x = bflo(x.x) + bflo(y.x) * rs1 * g[j].x; v[j].y = bfhi(x.x) + bfhi(y.x) * rs1 * g[j].y; v[j].z = bflo(x.y) + bflo(y.y) * rs1 * g[j].z; v[j].w = bfhi(x.y) + bfhi(y.y) * rs1 * g[j].w;
            s += (v[j].x * v[j].x + v[j].y * v[j].y) + (v[j].z * v[j].z + v[j].w * v[j].w); }
        if (fout) { GAS f32x4* xo = (GAS f32x4*)(fout + (size_t)m * DM) + lane;
#pragma unroll
            for (int j = 0; j < 8; ++j) xo[64 * j] = v[j]; }
        else { s = wave_sum(s); GAS v2u* xw = (GAS v2u*)(X + (size_t)m * DM) + lane;
#pragma unroll
            for (int j = 0; j < 8; ++j) { v2u w; w.x = pk2(v[j].x, v[j].y); w.y = pk2(v[j].z, v[j].w); xw[64 * j] = w; }
            const float dq = quant_row(v, XQv + (size_t)m * DM, lane);
            if (lane == 0) { const float r = 1.f / sqrtf(s * (1.f / DM) + NORM_EPS); RSv[m] = r; RQv[m] = r * dq; } }
#pragma unroll
        for (int j = 0; j < 8; ++j) { cx[j] = nx[j]; cy[j] = ny[j]; }
        cp = np; m = mn; }
}
__device__ __forceinline__ void quant_wrow2(const bf16* srca, float cma, unsigned char* dsta, const bf16* srcb, float cmb, unsigned char* dstb, int lane) {
    const float qa = 127.0f / __builtin_fmaxf(cma, 1e-30f), qb = 127.0f / __builtin_fmaxf(cmb, 1e-30f);
    const GAS v4u* sa = (const GAS v4u*)srca + lane; const GAS v4u* sb = (const GAS v4u*)srcb + lane; GAS v2u* da = (GAS v2u*)dsta + lane; GAS v2u* db = (GAS v2u*)dstb + lane;
    v4u wa[4], wb[4];
#pragma unroll
    for (int j = 0; j < 4; ++j) { wa[j] = sa[64 * j]; wb[j] = sb[64 * j]; }
#pragma unroll
    for (int j = 0; j < 4; ++j) { v2u o; o.x = q4c((f32x4){hlo(wa[j].x), hhi(wa[j].x), hlo(wa[j].y), hhi(wa[j].y)}, qa); o.y = q4c((f32x4){hlo(wa[j].z), hhi(wa[j].z), hlo(wa[j].w), hhi(wa[j].w)}, qa); da[64 * j] = o; }
#pragma unroll
    for (int j = 0; j < 4; ++j) { v2u o; o.x = q4c((f32x4){hlo(wb[j].x), hhi(wb[j].x), hlo(wb[j].y), hhi(wb[j].y)}, qb); o.y = q4c((f32x4){hlo(wb[j].z), hhi(wb[j].z), hlo(wb[j].w), hhi(wb[j].w)}, qb); db[64 * j] = o; }
}
__device__ __forceinline__ void quant_ffrow(const bf16* src, const float* pmx, unsigned char* dst, float* rq, int lane) {
    float mx = __builtin_fmaxf(pmx[lane], pmx[64 + lane]); mx = __builtin_fmaxf(wave_max(mx), 1e-20f);
    const float q = 127.0f / mx;
    const GAS v4u* s = (const GAS v4u*)src + lane; GAS v2u* d = (GAS v2u*)dst + lane;
#pragma unroll
    for (int j = 0; j < DFF / 512; ++j) { const v4u w = s[64 * j]; v2u o;
        o.x = q4c((f32x4){bflo(w.x), bfhi(w.x), bflo(w.y), bfhi(w.y)}, q); o.y = q4c((f32x4){bflo(w.z), bfhi(w.z), bflo(w.w), bfhi(w.w)}, q); d[64 * j] = o; }
    if (lane == 0) *rq = mx * (1.0f / 127.0f);
}
__device__ __forceinline__ void colmax_block(const float* W, int N, const float* gain, unsigned* cmax, int nrow0, LAS float* scr, int nb, int kb0, int nkb, int lane) {
    const int n0 = 32 * nb; float mx = 0.f; LAS float* gs = scr + 64 * 33;
    for (int kb = kb0; kb < kb0 + nkb; ++kb) { const int k0 = 64 * kb;
        gs[lane] = gain[k0 + lane]; LDS_WAIT(); asm volatile("" ::: "memory");
#pragma unroll 8
        for (int i = 0; i < 32; ++i) { const int kk = 2 * i + (lane >> 5); mx = __builtin_fmaxf(mx, __builtin_fabsf(W[(size_t)(k0 + kk) * N + n0 + (lane & 31)] * gs[kk])); }
        LDS_WAIT(); asm volatile("" ::: "memory"); }
    mx = __builtin_fmaxf(mx, __shfl_xor(mx, 32)) * CMAX_SAFETY;
    const int nr = (nrow0 >= 0 ? nrow0 : n0) + (lane & 31);
    if (lane < 32) __hip_atomic_fetch_max(cmax + nr, __builtin_bit_cast(unsigned, mx), __ATOMIC_RELAXED, __HIP_MEMORY_SCOPE_AGENT);
}
__device__ __forceinline__ void quant_transpose_item(const float* W, int N, const float* gain, const float* cmax, unsigned char* WQ, int K, int nrow0, LAS float* scr, int item, int lane) {
    const int nblk = N / 32, kb = item / nblk, nb = item % nblk, k0 = 64 * kb, n0 = 32 * nb;
    LAS float* gs = scr + 64 * 33; gs[lane] = gain[k0 + lane];
#pragma unroll 8
    for (int i = 0; i < 32; ++i) { const int kk = 2 * i + (lane >> 5); scr[kk * 33 + (lane & 31)] = W[(size_t)(k0 + kk) * N + n0 + (lane & 31)]; }
    LDS_WAIT(); asm volatile("" ::: "memory");
    const int n = lane >> 1, hf = lane & 1;
    const int nr = (nrow0 >= 0 ? nrow0 : n0) + n;
    const float q = 127.0f / __builtin_fmaxf(cmax[nr], 1e-30f);
    const LAS float* s = scr + (32 * hf) * 33 + n;
    v4u o[2];
#pragma unroll
    for (int h2 = 0; h2 < 2; ++h2)
#pragma unroll
        for (int w = 0; w < 4; ++w) { const int kq = 16 * h2 + 4 * w; const LAS float* p = s + kq * 33; const LAS float* g = gs + 32 * hf + kq; o[h2][w] = q4c((f32x4){p[0] * g[0], p[33] * g[1], p[66] * g[2], p[99] * g[3]}, q); }
    GAS v4u* dst = (GAS v4u*)(WQ + (size_t)nr * K + k0 + 32 * hf);
    dst[0] = o[0]; dst[1] = o[1];
    LDS_WAIT(); asm volatile("" ::: "memory");
}

__device__ __forceinline__ void pool_unit(LAS unsigned char* lds, const bf16* proj, const bf16* poolT, const float* pscale, bf16* Y, int tb, int g, int tid, int lane, int wid) {
    asm volatile("" : "+v"(tid)); lane = tid & 63;
    const int win = 2 << g, hi = lane >> 5, r32 = lane & 31;
    const int t0 = tb * 128;
    bf16x8 bfr[16];
    { const bf16* bp = poolT + ((size_t)g * 256 + 32 * wid + r32) * 256 + 8 * hi;
#pragma unroll
      for (int s = 0; s < 16; ++s) bfr[s] = *(const GAS bf16x8*)(bp + 16 * s); }
    { const int cc = tid & 31, tsb = tid >> 5;
      const bf16* up = proj + (size_t)t0 * LDP + C_POOL + g * 256 + cc * 8;
      const int pos0 = (t0 & (SEQ - 1)) + tsb * 8;
      float aw[8];
#pragma unroll
      for (int e = 0; e < 8; ++e) aw[e] = 0.f;
      for (int j = 1; j < win; ++j) { if (pos0 - j >= 0) { const v4u w = *(const GAS v4u*)(up + (long)(tsb * 8 - j) * LDP);
          aw[0] += bflo(w.x); aw[1] += bfhi(w.x); aw[2] += bflo(w.y); aw[3] += bfhi(w.y); aw[4] += bflo(w.z); aw[5] += bfhi(w.z); aw[6] += bflo(w.w); aw[7] += bfhi(w.w); } }
#pragma unroll
      for (int tt = 0; tt < 8; ++tt) {
          const int pos = pos0 + tt; const v4u w = *(const GAS v4u*)(up + (long)(tsb * 8 + tt) * LDP);
          float cu[8] = {bflo(w.x), bfhi(w.x), bflo(w.y), bfhi(w.y), bflo(w.z), bfhi(w.z), bflo(w.w), bfhi(w.w)};
#pragma unroll
          for (int e = 0; e < 8; ++e) aw[e] += cu[e];
          const float inv = 1.f / (float)(pos + 1 < win ? pos + 1 : win);
          v4u o; o.x = pk2(aw[0] * inv - cu[0], aw[1] * inv - cu[1]); o.y = pk2(aw[2] * inv - cu[2], aw[3] * inv - cu[3]); o.z = pk2(aw[4] * inv - cu[4], aw[5] * inv - cu[5]); o.w = pk2(aw[6] * inv - cu[6], aw[7] * inv - cu[7]);
          *(LAS v4u*)(lds + cc * 2048 + (tsb * 8 + tt) * 16) = o;
          if (pos - (win - 1) >= 0) { const v4u z = *(const GAS v4u*)(up + (long)(tsb * 8 + tt - (win - 1)) * LDP);
              aw[0] -= bflo(z.x); aw[1] -= bfhi(z.x); aw[2] -= bflo(z.y); aw[3] -= bfhi(z.y); aw[4] -= bflo(z.z); aw[5] -= bfhi(z.z); aw[6] -= bflo(z.w); aw[7] -= bfhi(z.w); }
      } }
    WG_BAR();
    f32x16 acc[4];
#pragma unroll
    for (int k = 0; k < 4; ++k) acc[k] = splat16(0.f);
#pragma unroll
    for (int s = 0; s < 16; ++s)
#pragma unroll
        for (int k = 0; k < 4; ++k) { const bf16x8 a = *(const LAS bf16x8*)(lds + (2 * s + hi) * 2048 + (32 * k + r32) * 16); acc[k] = MFMA32(a, bfr[s], acc[k]); }
    const int oc = g * 256 + 32 * wid + r32; const float ps = pscale[oc];
#pragma unroll
    for (int k = 0; k < 4; ++k)
#pragma unroll
        for (int r = 0; r < 16; ++r) { const int tok = 32 * k + crow(r, hi); Y[(size_t)(t0 + tok) * LDY + oc] = (bf16)(pk2(acc[k][r] * ps, 0.f) & 0xffffu); }
    WG_BAR();
}

#ifndef ATT_UNROLL2
#define ATT_UNROLL2 0
#endif
__device__ __forceinline__ void attn_unit(LAS unsigned char* lds, const bf16* proj, bf16* Y, const float* relb, const float* hgain, float lam, float oscale, int b, int h, int qb, int tid, int lane, int wid, Stopwatch& sw) {
    asm volatile("" : "+v"(tid)); lane = tid & 63;
    TS_BEG(sw, 7); TS_BEG(sw, 8);
    const int r32 = lane & 31, hi = lane >> 5, mp = wid >> 2, wq = wid & 3;
    const int q0 = qb * 128, qw = q0 + 32 * wq;
    const size_t rowbase = (size_t)b * SEQ;
    LAS float* tab = (LAS float*)(lds + 98304);
    if (tid < 129) tab[tid] = relb[t5_bucket(tid) * 8 + h] * LOG2E;
    const float bias31 = relb[31 * 8 + h] * LOG2E;
    LAS unsigned char* qlds = lds + 100352 + wid * 4096 + hi * 512 + r32 * 16;
    { const bf16* qp = proj + (rowbase + qw + r32) * LDP + C_QD + h * 128 + mp * 64 + hi * 8;
#pragma unroll
      for (int d0 = 0; d0 < 4; ++d0) *(LAS bf16x8*)(qlds + d0 * 1024) = *(const GAS bf16x8*)(qp + d0 * 16); }
    const bf16* k0src = proj + (rowbase + (lane & 32) + swap23(r32)) * LDP + C_KD + h * 128 + wid * 8;
    const bf16* k1src = k0src + 64;
    const bf16* vsrc[2];
#pragma unroll
    for (int i = 0; i < 2; ++i) { const int vrow = 8 * wid + 4 * i + (lane >> 4); const int ch = (lane & 15) ^ (((vrow & 3) << 2) | ((vrow >> 2) & 3)); vsrc[i] = proj + (rowbase + vrow) * LDP + C_VD + h * 128 + ch * 8; }
#define ATT_DMA(t, sb_) do { const size_t ko_ = (size_t)(t) * 64 * LDP; \
        glds16_asm(k0src + ko_, (sb_) + wid * 1024); glds16_asm(k1src + ko_, (sb_) + 8192 + wid * 1024); glds16_asm(vsrc[0] + ko_, (sb_) + 16384 + wid * 2048); glds16_asm(vsrc[1] + ko_, (sb_) + 16384 + wid * 2048 + 1024); } while (0)
    unsigned va[4][2];
#pragma unroll
    for (int c = 0; c < 4; ++c) { va[c][0] = 16384u + tr_off(lane, c, 0); va[c][1] = 16384u + tr_off(lane, c, 1); }
    const unsigned kboff = mp * 8192 + hi * 1024 + r32 * 16;
    const int NT = 2 * qb + 2;
    ATT_DMA(0, lds); ATT_DMA(1, lds + 32768);
    float m_run = -1e30f, l_run = 0.f;
    f32x16 o[4];
#pragma unroll
    for (int c = 0; c < 4; ++c) o[c] = splat16(0.f);
    const int qi = qw + r32;
#define ATT_QK(S0, S1, sbp, cin) do { S0 = splat16(cin); S1 = S0; \
        _Pragma("unroll") for (int d0 = 0; d0 < 4; ++d0) { const bf16x8 kf0_ = *(const LAS bf16x8*)((sbp) + kboff + d0 * 2048), kf1_ = *(const LAS bf16x8*)((sbp) + kboff + d0 * 2048 + 512), q_ = *(const LAS bf16x8*)(qlds + d0 * 1024); \
            S0 = MFMA32(kf0_, q_, S0); S1 = MFMA32(kf1_, q_, S1); } } while (0)
    WG_BAR();
    TS_END(sw, 8);
    f32x16 sA0, sA1, sB0, sB1;
    typedef __bf16 bf2_t_ __attribute__((ext_vector_type(2)));
    const bf2_t_ one2 = __builtin_bit_cast(bf2_t_, 0x3F803F80u);
    { const bool far0 = (63 + 128 <= qw); ATT_QK(sA0, sA1, lds, far0 ? bias31 : 0.f);
      if (!far0) {
#pragma unroll
          for (int r = 0; r < 16; ++r) { const int key = 16 * (r >> 3) + 8 * hi + (r & 7); const int d0_ = qi - key, d1_ = d0_ - 32;
              const float b0 = tab[d0_ < 0 ? 0 : (d0_ > 128 ? 128 : d0_)], b1 = tab[d1_ < 0 ? 0 : (d1_ > 128 ? 128 : d1_)];
              sA0[r] = d0_ < 0 ? -1e30f : sA0[r] + b0; sA1[r] = d1_ < 0 ? -1e30f : sA1[r] + b1; } }
      float mt = __builtin_fmaxf(sA0[0], sA1[0]);
#pragma unroll
      for (int r = 1; r < 16; ++r) mt = __builtin_fmaxf(mt, __builtin_fmaxf(sA0[r], sA1[r]));
      mt = half_swap_max(mt); m_run = mt;
#pragma unroll
      for (int r = 0; r < 16; ++r) { sA0[r] -= mt; sA1[r] -= mt; } }
    int sc = 0, sn = 32768, sn2 = 65536;
#define SB() __builtin_amdgcn_sched_barrier(0)
#define EX2(P, i) do { P[i] = __builtin_amdgcn_exp2f(P[i]); P[(i) + 1] = __builtin_amdgcn_exp2f(P[(i) + 1]); } while (0)
#define MX4(P, i) __builtin_fmaxf(__builtin_fmaxf(P[i], P[(i) + 1]), __builtin_fmaxf(P[(i) + 2], P[(i) + 3]))
#define PK8(P, i) ({ v4u w_; w_.x = pk2(P[i], P[(i) + 1]); w_.y = pk2(P[(i) + 2], P[(i) + 3]); w_.z = pk2(P[(i) + 4], P[(i) + 5]); w_.w = pk2(P[(i) + 6], P[(i) + 7]); __builtin_bit_cast(bf16x8, w_); })
#define VRD(dst, ks) do { _Pragma("unroll") for (int c_ = 0; c_ < 4; ++c_) dst[c_] = trfrag(sb, va[c_][0] + 4096u * (ks), va[c_][1] + 4096u * (ks)); } while (0)
#define PVM(vf_, pk_) do { _Pragma("unroll") for (int c_ = 0; c_ < 4; ++c_) o[c_] = MFMA32(vf_[c_], pk_, o[c_]); } while (0)
#define PVMX(vf_, pk_, N_, i_) do { o[0] = MFMA32(vf_[0], pk_, o[0]); EX2(N_, (i_)); SB(); o[1] = MFMA32(vf_[1], pk_, o[1]); EX2(N_, (i_) + 2); SB(); \
                                    o[2] = MFMA32(vf_[2], pk_, o[2]); EX2(N_, (i_) + 4); SB(); o[3] = MFMA32(vf_[3], pk_, o[3]); EX2(N_, (i_) + 6); SB(); } while (0)
    bf16x8 qreg[4];
#pragma unroll
    for (int d0 = 0; d0 < 4; ++d0) qreg[d0] = *(const LAS bf16x8*)(qlds + d0 * 1024);
    bf16x8 pw0, pw1, pw2, pw3;
    {
#pragma unroll
      for (int r = 0; r < 16; r += 2) { EX2(sA0, r); EX2(sA1, r); }
      float sm_ = 0.f;
#pragma unroll
      for (int r = 0; r < 16; ++r) sm_ += sA0[r] + sA1[r];
      l_run += sm_; pw0 = PK8(sA0, 0); pw1 = PK8(sA0, 8); pw2 = PK8(sA1, 0); pw3 = PK8(sA1, 8); }
#define ATT_TILE(T) do { \
        if ((T) + 2 < NT) ATT_DMA((T) + 2, lds + sn2); \
        const int k0 = 64 * (T); const bool actT = (k0 <= qw + 31), actN = ((T) + 1 < NT) && (k0 + 64 <= qw + 31); \
        LAS unsigned char* sb = lds + sc; LAS unsigned char* sbn = lds + sn; \
        const bool farn = (k0 + 64 + 63 + 128 <= qw); const float cin = (farn ? bias31 : 0.f) - m_run; \
        f32x16 N0 = splat16(cin), N1 = N0; bf16x8 vfA[4], vfB[4]; \
        if (actN) { \
            bf16x8 kf[4], qf[2]; \
            SB(); \
            _Pragma("unroll") for (int d0 = 0; d0 < 2; ++d0) { kf[2 * d0] = *(const LAS bf16x8*)(sbn + kboff + d0 * 2048); kf[2 * d0 + 1] = *(const LAS bf16x8*)(sbn + kboff + d0 * 2048 + 512); qf[d0] = qreg[d0]; } \
            SB(); \
            N0 = MFMA32(kf[0], qf[0], N0); N1 = MFMA32(kf[1], qf[0], N1); N0 = MFMA32(kf[2], qf[1], N0); N1 = MFMA32(kf[3], qf[1], N1); SB(); \
            _Pragma("unroll") for (int d0 = 0; d0 < 2; ++d0) { kf[2 * d0] = *(const LAS bf16x8*)(sbn + kboff + (d0 + 2) * 2048); kf[2 * d0 + 1] = *(const LAS bf16x8*)(sbn + kboff + (d0 + 2) * 2048 + 512); qf[d0] = qreg[d0 + 2]; } \
            SB(); \
            N0 = MFMA32(kf[0], qf[0], N0); N1 = MFMA32(kf[1], qf[0], N1); N0 = MFMA32(kf[2], qf[1], N0); N1 = MFMA32(kf[3], qf[1], N1); SB(); \
            if (!farn) { const int k1 = k0 + 64; \
                _Pragma("unroll") for (int r = 0; r < 16; ++r) { const int key = k1 + 16 * (r >> 3) + 8 * hi + (r & 7); const int d0_ = qi - key, d1_ = d0_ - 32; \
                    const float b0 = tab[d0_ < 0 ? 0 : (d0_ > 128 ? 128 : d0_)], b1 = tab[d1_ < 0 ? 0 : (d1_ > 128 ? 128 : d1_)]; \
                    N0[r] = d0_ < 0 ? -1e30f : N0[r] + b0; N1[r] = d1_ < 0 ? -1e30f : N1[r] + b1; } } \
        } \
        if (actT) {                                                               \
            SB(); VRD(vfA, 0); VRD(vfB, 1); SB(); \
            PVMX(vfA, pw0, N0, 0); VRD(vfA, 2); SB(); \
            PVMX(vfB, pw1, N0, 8); VRD(vfB, 3); SB(); \
            PVMX(vfA, pw2, N1, 0); \
            PVMX(vfB, pw3, N1, 8); \
        } \
        if (actN) {                                                               \
            float sm_ = 0.f; _Pragma("unroll") for (int r = 0; r < 16; ++r) sm_ += N0[r] + N1[r]; \
            if (__any(!(sm_ <= 8192.f))) {                                        \
                float mx = __builtin_fmaxf(__builtin_fmaxf(__builtin_fmaxf(MX4(N0, 0), MX4(N0, 4)), __builtin_fmaxf(MX4(N0, 8), MX4(N0, 12))), __builtin_fmaxf(__builtin_fmaxf(MX4(N1, 0), MX4(N1, 4)), __builtin_fmaxf(MX4(N1, 8), MX4(N1, 12)))); \
                mx = half_swap_max(mx); const float big = __builtin_fmaxf(mx, 1.f); const float dl = __builtin_amdgcn_logf(big), f = __builtin_amdgcn_rcpf(big); m_run += dl; \
                _Pragma("unroll") for (int c = 0; c < 4; ++c) _Pragma("unroll") for (int r = 0; r < 16; ++r) o[c][r] *= f; \
                l_run *= f; sm_ *= f; _Pragma("unroll") for (int r = 0; r < 16; ++r) { N0[r] *= f; N1[r] *= f; } } \
            l_run += sm_; \
            pw0 = PK8(N0, 0); pw1 = PK8(N0, 8); pw2 = PK8(N1, 0); pw3 = PK8(N1, 8); } \
        { const int tmp = sc; sc = sn; sn = sn2; sn2 = tmp; } \
        WG_BAR(); } while (0)
    for (int t = 0; t < NT; ++t) ATT_TILE(t);
#undef ATT_TILE
#undef PVMX
#undef SB
#undef EX2
#undef MX4
#undef PK8
#undef VRD
#undef PVM
#undef DSUM
#undef ATT_DMA
#undef ATT_QK
    TS_BEG(sw, 9);
    l_run = half_swap_sum(l_run);
    const float inv = 1.f / l_run;
    LAS float* xch = (LAS float*)lds;
    if (mp == 1) {
#pragma unroll
        for (int c = 0; c < 4; ++c)
#pragma unroll
            for (int r = 0; r < 16; ++r) xch[((wq * 64 + c * 16 + r) << 6) + lane] = o[c][r] * inv;
    }
    WG_BAR();
    if (mp == 0) {
        float ss = 0.f;
#pragma unroll
        for (int c = 0; c < 4; ++c)
#pragma unroll
            for (int r = 0; r < 16; ++r) { const float d = o[c][r] * inv - lam * xch[((wq * 64 + c * 16 + r) << 6) + lane]; o[c][r] = d; ss += d * d; }
        ss = half_swap_sum(ss);
        const float rs = oscale / sqrtf(ss * (1.f / 128.f) + NORM_EPS);
        bf16* yp = Y + (rowbase + qi) * LDY + 1024 + h * 128;
#pragma unroll
        for (int c = 0; c < 4; ++c)
#pragma unroll
            for (int r4 = 0; r4 < 4; ++r4) { const int dv = 32 * c + 8 * r4 + 4 * hi; const f32x4 g = *(const GAS f32x4*)(hgain + dv);
                v2u w; w.x = pk2(o[c][4 * r4] * rs * g.x, o[c][4 * r4 + 1] * rs * g.y); w.y = pk2(o[c][4 * r4 + 2] * rs * g.z, o[c][4 * r4 + 3] * rs * g.w);
                *(GAS v2u*)(yp + dv) = w; }
    }
    WG_BAR();
    TS_END(sw, 9); TS_END(sw, 7);
}

template <int MODE  > __device__ __forceinline__ void ret_stage_rot(LAS unsigned char* tile, const bf16* src  , const f32x2* rot  , float sc, float l2g, int tid) {
#pragma unroll
    for (int i = 0; i < 2; ++i) { const int item = tid + 512 * i, j = item >> 3, cc = item & 7;
        const v4u lo = *(const GAS v4u*)(src + (size_t)j * LDP + 8 * cc), hh = *(const GAS v4u*)(src + (size_t)j * LDP + 64 + 8 * cc);
        const GAS f32x4* rp = (const GAS f32x4*)(rot + (size_t)j * 64 + 8 * cc);
        const f32x4 c0 = rp[0], c1 = rp[1], c2 = rp[2], c3 = rp[3];
        const float cs[8] = {c0.x, c0.z, c1.x, c1.z, c2.x, c2.z, c3.x, c3.z}, sn[8] = {c0.y, c0.w, c1.y, c1.w, c2.y, c2.w, c3.y, c3.w};
        const float a[8] = {bflo(lo.x), bfhi(lo.x), bflo(lo.y), bfhi(lo.y), bflo(lo.z), bfhi(lo.z), bflo(lo.w), bfhi(lo.w)};
        const float bb[8] = {bflo(hh.x), bfhi(hh.x), bflo(hh.y), bfhi(hh.y), bflo(hh.z), bfhi(hh.z), bflo(hh.w), bfhi(hh.w)};
        const float s = MODE == 1 ? sc * __builtin_amdgcn_exp2f((float)(127 - j) * l2g) : sc;
        float o1[8], o2[8];
#pragma unroll
        for (int e = 0; e < 8; ++e) { o1[e] = (a[e] * cs[e] - bb[e] * sn[e]) * s; o2[e] = (bb[e] * cs[e] + a[e] * sn[e]) * s; }
        v4u w; w.x = pk2(o1[0], o1[1]); w.y = pk2(o1[2], o1[3]); w.z = pk2(o1[4], o1[5]); w.w = pk2(o1[6], o1[7]); *(LAS v4u*)(tile + offb(j, cc)) = w;
        w.x = pk2(o2[0], o2[1]); w.y = pk2(o2[2], o2[3]); w.z = pk2(o2[4], o2[5]); w.w = pk2(o2[6], o2[7]); *(LAS v4u*)(tile + offb(j, cc + 8)) = w; }
}
__device__ __forceinline__ void ret_stage_plain(LAS unsigned char* tile, const bf16* src, int ld, int tid) {
#pragma unroll
    for (int i = 0; i < 4; ++i) { const int item = tid + 512 * i, row = item >> 4, ch = item & 15; *(LAS v4u*)(tile + offb(row, ch)) = *(const GAS v4u*)(src + (size_t)row * ld + 8 * ch); }
}
__device__ __forceinline__ void retA_unit(LAS unsigned char* lds, const bf16* proj, const f32x2* rot, float* KV, int u, int tid, int lane, int wid) {
    asm volatile("" : "+v"(tid)); lane = tid & 63;
    const int bh = u >> 5, c = u & 31, b = bh >> 3, h = bh & 7, hi = lane >> 5, r32 = lane & 31;
    const size_t t0 = (size_t)b * SEQ + c * 128; const float l2g = kLog2Gamma[h];
    ret_stage_rot<1>(lds, proj + t0 * LDP + C_KR + h * 128, rot + (size_t)c * 128 * 64, RET_KSCALE, l2g, tid);
    ret_stage_plain(lds + 32768, proj + t0 * LDP + C_VR + h * 128, LDP, tid);
    WG_BAR();
    const int db = wid & 3, eb0 = 2 * (wid >> 2);
    const unsigned a0 = tr_off(lane, db, 0), a1 = tr_off(lane, db, 1);
    unsigned b0[2], b1[2];
#pragma unroll
    for (int k = 0; k < 2; ++k) { b0[k] = 32768u + tr_off(lane, eb0 + k, 0); b1[k] = 32768u + tr_off(lane, eb0 + k, 1); }
    f32x16 acc[2] = {splat16(0.f), splat16(0.f)};
#pragma unroll
    for (int ks = 0; ks < 8; ++ks) { const bf16x8 A = trfrag(lds, a0 + 4096u * ks, a1 + 4096u * ks);
#pragma unroll
        for (int k = 0; k < 2; ++k) { const bf16x8 B = trfrag(lds, b0[k] + 4096u * ks, b1[k] + 4096u * ks); acc[k] = MFMA32(A, B, acc[k]); } }
    float* kvp = KV + (size_t)u * 16384;
#pragma unroll
    for (int k = 0; k < 2; ++k)
#pragma unroll
        for (int r = 0; r < 16; ++r) kvp[(32 * db + crow(r, hi)) * 128 + 32 * (eb0 + k) + r32] = acc[k][r];
    WG_BAR();
}
struct RetCPre { v4u q[4], k[4], v[4], s[4]; };
__device__ __forceinline__ void retC_load(RetCPre& P, const bf16* proj, const bf16* SST, int u, int tid) {
    const int bh = u >> 5, c = u & 31, b = bh >> 3, h = bh & 7; const size_t t0 = (size_t)b * SEQ + c * 128;
    const bf16* qs = proj + t0 * LDP + C_QR + h * 128; const bf16* ks = proj + t0 * LDP + C_KR + h * 128; const bf16* vs = proj + t0 * LDP + C_VR + h * 128; const bf16* ss = SST + (size_t)u * 16384;
#pragma unroll
    for (int i = 0; i < 2; ++i) { const int item = tid + 512 * i, j = item >> 3, cc = item & 7;
        P.q[2 * i] = *(const GAS v4u*)(qs + (size_t)j * LDP + 8 * cc); P.q[2 * i + 1] = *(const GAS v4u*)(qs + (size_t)j * LDP + 64 + 8 * cc);
        P.k[2 * i] = *(const GAS v4u*)(ks + (size_t)j * LDP + 8 * cc); P.k[2 * i + 1] = *(const GAS v4u*)(ks + (size_t)j * LDP + 64 + 8 * cc); }
#pragma unroll
    for (int i = 0; i < 4; ++i) { const int item = tid + 512 * i, row = item >> 4, ch = item & 15; P.v[i] = *(const GAS v4u*)(vs + (size_t)row * LDP + 8 * ch); if (c > 0) P.s[i] = *(const GAS v4u*)(ss + (size_t)row * 128 + 8 * ch); }
}
__device__ __forceinline__ void ret_rot_store1(LAS unsigned char* tile, const v4u lo, const v4u hh, const float (&cs)[8], const float (&sn)[8], int j, int cc, float s) {
    const float a[8] = {bflo(lo.x), bfhi(lo.x), bflo(lo.y), bfhi(lo.y), bflo(lo.z), bfhi(lo.z), bflo(lo.w), bfhi(lo.w)};
    const float bb[8] = {bflo(hh.x), bfhi(hh.x), bflo(hh.y), bfhi(hh.y), bflo(hh.z), bfhi(hh.z), bflo(hh.w), bfhi(hh.w)};
    float o1[8], o2[8];
#pragma unroll
    for (int e = 0; e < 8; ++e) { o1[e] = (a[e] * cs[e] - bb[e] * sn[e]) * s; o2[e] = (bb[e] * cs[e] + a[e] * sn[e]) * s; }
    v4u w; w.x = pk2(o1[0], o1[1]); w.y = pk2(o1[2], o1[3]); w.z = pk2(o1[4], o1[5]); w.w = pk2(o1[6], o1[7]); *(LAS v4u*)(tile + offb(j, cc)) = w;
    w.x = pk2(o2[0], o2[1]); w.y = pk2(o2[2], o2[3]); w.z = pk2(o2[4], o2[5]); w.w = pk2(o2[6], o2[7]); *(LAS v4u*)(tile + offb(j, cc + 8)) = w;
}
__device__ __forceinline__ void retC_unit(LAS unsigned char* lds, const bf16* proj, const f32x2* rot, const bf16* SST, bf16* Y, int u, int tid, int lane, int wid, Stopwatch& sw) {
    asm volatile("" : "+v"(tid)); lane = tid & 63;
    TS_BEG(sw, 1); TS_BEG(sw, 2);
    RetCPre P; retC_load(P, proj, SST, u, tid);
    const int bh = u >> 5, c = u & 31, b = bh >> 3, h = bh & 7, hi = lane >> 5, r32 = lane & 31;
    const size_t t0 = (size_t)b * SEQ + c * 128; const float l2g = kLog2Gamma[h];
#pragma unroll
    for (int i = 0; i < 2; ++i) { const int item = tid + 512 * i, j = item >> 3, cc = item & 7;
        const GAS f32x4* rp = (const GAS f32x4*)(rot + ((size_t)c * 128 + j) * 64 + 8 * cc); const f32x4 c0 = rp[0], c1 = rp[1], c2 = rp[2], c3 = rp[3];
        const float cs[8] = {c0.x, c0.z, c1.x, c1.z, c2.x, c2.z, c3.x, c3.z}, sn[8] = {c0.y, c0.w, c1.y, c1.w, c2.y, c2.w, c3.y, c3.w};
        ret_rot_store1(lds, P.q[2 * i], P.q[2 * i + 1], cs, sn, j, cc, 1.f); ret_rot_store1(lds + 32768, P.k[2 * i], P.k[2 * i + 1], cs, sn, j, cc, RET_KSCALE);
        asm volatile("" ::: "memory"); }
#pragma unroll
    for (int i = 0; i < 4; ++i) { const int item = tid + 512 * i, row = item >> 4, ch = item & 15; *(LAS v4u*)(lds + 65536 + offb(row, ch)) = P.v[i]; if (c > 0) *(LAS v4u*)(lds + 98304 + offb(row, ch)) = P.s[i]; }
    TS_BEG(sw, 5); WG_BAR(); TS_END(sw, 5);
    TS_END(sw, 2); TS_BEG(sw, 3);
    const int eh = wid >> 2, ib = eh ? 3 - (wid & 3) : (wid & 3), il = 32 * ib + r32;
    v2u gw_[2][4];
    { const bf16* gp_ = proj + (t0 + il) * LDP + C_GR + h * 128;
#pragma unroll
      for (int k = 0; k < 2; ++k)
#pragma unroll
          for (int r4 = 0; r4 < 4; ++r4) gw_[k][r4] = *(const GAS v2u*)(gp_ + 32 * (2 * eh + k) + 8 * r4 + 4 * hi); }
    bf16x8 qf[8];
#pragma unroll
    for (int ks = 0; ks < 8; ++ks) qf[ks] = *(const LAS bf16x8*)(lds + offb(il, 2 * ks + hi));
    unsigned v0[2], v1[2];
#pragma unroll
    for (int k = 0; k < 2; ++k) { v0[k] = tr_off(lane, 2 * eh + k, 0); v1[k] = tr_off(lane, 2 * eh + k, 1); }
    f32x16 acc[2] = {splat16(0.f), splat16(0.f)};
    if (c > 0) {
#pragma unroll
        for (int ks = 0; ks < 8; ++ks)
#pragma unroll
            for (int k = 0; k < 2; ++k) { const bf16x8 A = trfrag(lds + 98304, v0[k] + 4096u * ks, v1[k] + 4096u * ks); acc[k] = MFMA32(A, qf[ks], acc[k]); }
        const float qd = __builtin_amdgcn_exp2f((float)(il + 1) * l2g);
#pragma unroll
        for (int k = 0; k < 2; ++k)
#pragma unroll
            for (int r = 0; r < 16; ++r) acc[k][r] *= qd;
    }
    for (int jb = 0; jb <= ib; ++jb) {
        f32x16 sc = splat16(0.f);
        const int krow = 32 * jb + swap23(r32);
#pragma unroll
        for (int ks = 0; ks < 8; ++ks) { const bf16x8 A = *(const LAS bf16x8*)(lds + 32768 + offb(krow, 2 * ks + hi)); sc = MFMA32(A, qf[ks], sc); }
#pragma unroll
        for (int r = 0; r < 16; ++r) { const int j = 32 * jb + 16 * (r >> 3) + 8 * hi + (r & 7); const int dj = il - j; sc[r] = dj >= 0 ? sc[r] * __builtin_amdgcn_exp2f((float)dj * l2g) : 0.f; }
        bf16x8 pk[2];
        { v4u w; w.x = pk2(sc[0], sc[1]); w.y = pk2(sc[2], sc[3]); w.z = pk2(sc[4], sc[5]); w.w = pk2(sc[6], sc[7]); pk[0] = __builtin_bit_cast(bf16x8, w);
          w.x = pk2(sc[8], sc[9]); w.y = pk2(sc[10], sc[11]); w.z = pk2(sc[12], sc[13]); w.w = pk2(sc[14], sc[15]); pk[1] = __builtin_bit_cast(bf16x8, w); }
#pragma unroll
        for (int s = 0; s < 2; ++s)
#pragma unroll
            for (int k = 0; k < 2; ++k) { const unsigned ko = 4096u * (unsigned)(2 * jb + s); const bf16x8 A = trfrag(lds + 65536, v0[k] + ko, v1[k] + ko); acc[k] = MFMA32(A, pk[s], acc[k]); }
    }
    TS_END(sw, 3); TS_BEG(sw, 4);
    float ss = 0.f;
#pragma unroll
    for (int k = 0; k < 2; ++k)
#pragma unroll
        for (int r = 0; r < 16; ++r) ss += acc[k][r] * acc[k][r];
    ss = half_swap_sum(ss);
    LAS float* xs = (LAS float*)(lds + 131072);
    if (hi == 0) xs[eh * 128 + il] = ss;
    WG_BAR();
    const float rs = 1.f / sqrtf((xs[il] + xs[128 + il]) * (1.f / 128.f) + NORM_EPS);
    const bf16* gp = proj + (t0 + il) * LDP + C_GR + h * 128; bf16* yp = Y + (t0 + il) * LDY + 2048 + h * 128;
#pragma unroll
    for (int k = 0; k < 2; ++k)
#pragma unroll
        for (int r4 = 0; r4 < 4; ++r4) { const int e = 32 * (2 * eh + k) + 8 * r4 + 4 * hi; const v2u gw = gw_[k][r4];
            v2u w; w.x = pk2(acc[k][4 * r4] * rs * bflo(gw.x), acc[k][4 * r4 + 1] * rs * bfhi(gw.x)); w.y = pk2(acc[k][4 * r4 + 2] * rs * bflo(gw.y), acc[k][4 * r4 + 3] * rs * bfhi(gw.y));
            *(GAS v2u*)(yp + e) = w; }
    WG_BAR();
    TS_END(sw, 4); TS_END(sw, 1);
}
#define XB_TMO      128
#define XB_XCNT(j)  (256  + 64 * (j))
#define XB_XSUB(j)  (1280 + 64 * (j))
#define XB_XGEN(j)  (2304 + 64 * (j))
#define XB_TOP      3328
#define XB_TOPGEN   3392
#define XCD_BAR_WORDS 3456
#define XB_SPIN_CAP (1u << 18)

__device__ __forceinline__ unsigned xb_ld(unsigned* p)              { return __hip_atomic_load(p, __ATOMIC_RELAXED, __HIP_MEMORY_SCOPE_AGENT); }
__device__ __forceinline__ unsigned xb_add(unsigned* p, unsigned v) { return __hip_atomic_fetch_add(p, v, __ATOMIC_RELAXED, __HIP_MEMORY_SCOPE_AGENT); }
__device__ __forceinline__ unsigned xb_xcc_id() { return (unsigned)__builtin_amdgcn_s_getreg((3 << 11) | 20) & 0xFu; }
#define XB_SPIN(cond, bar) do { unsigned _sp = 0; while (cond) { __builtin_amdgcn_s_sleep(1); \
    if ((++_sp & 255u) == 0u) { if (xb_ld(&(bar)[XB_TMO])) break; if (_sp > XB_SPIN_CAP) { atomicAdd(&(bar)[XB_TMO], 1u); break; } } } } while (0)

struct XcdBarrier {
    unsigned* bar; unsigned x;
    volatile LAS unsigned* st;
};

__device__ __forceinline__ XcdBarrier xcd_barrier_post(unsigned* bar, volatile LAS unsigned* st) {
    XcdBarrier b; b.bar = bar; b.x = xb_xcc_id(); b.st = st;
    if (threadIdx.x == 0) (void)xb_add(&bar[XB_XCNT(b.x)], 1u);
    return b;
}
__device__ __forceinline__ void xcd_barrier_complete(unsigned* bar, unsigned x, unsigned& nloc, unsigned& nx) {
    const unsigned G = gridDim.x * gridDim.y * gridDim.z;
    unsigned sum, cnt, mine, sp = 0u;
    for (;;) {
        sum = 0u; cnt = 0u; mine = 0u;
#pragma unroll
        for (unsigned j = 0; j < 16; ++j) { const unsigned c = xb_ld(&bar[XB_XCNT(j)]); sum += c; cnt += (c > 0u) ? 1u : 0u; mine = (j == x) ? c : mine; }
        if (sum == G) break;
        __builtin_amdgcn_s_sleep(1);
        if ((++sp & 255u) == 0u) { if (xb_ld(&bar[XB_TMO])) break; if (sp > XB_SPIN_CAP) { atomicAdd(&bar[XB_TMO], 1u); break; } }
    }
    nloc = mine > 0u ? mine : 1u; nx = cnt > 0u ? cnt : 1u;
}

__device__ __forceinline__ void xcd_barrier(const XcdBarrier& b) {
    asm volatile("s_waitcnt vmcnt(0)" ::: "memory");
    __syncthreads();
    if (threadIdx.x == 0) {
        unsigned* bar = b.bar;
        __builtin_amdgcn_s_waitcnt(0);
        unsigned nloc = b.st[0], nx = b.st[1];
        if (nloc == 0u) { xcd_barrier_complete(bar, b.x, nloc, nx); b.st[0] = nloc; b.st[1] = nx; }
        const unsigned old = xb_add(&bar[XB_XSUB(b.x)], 1u);
        const unsigned gen = old / nloc;
        if (old + 1u == (gen + 1u) * nloc) {
            __builtin_amdgcn_fence(__ATOMIC_RELEASE, "agent");
            asm volatile("s_waitcnt vmcnt(0)" ::: "memory");
            const unsigned og = xb_add(&bar[XB_TOP], 1u);
            const unsigned tg = og / nx;
            if (og + 1u == (tg + 1u) * nx) xb_add(&bar[XB_TOPGEN], 1u);
            else XB_SPIN(xb_ld(&bar[XB_TOPGEN]) == tg, bar);
            __builtin_amdgcn_fence(__ATOMIC_ACQUIRE, "agent");
            xb_add(&bar[XB_XGEN(b.x)], 1u);
            asm volatile("s_waitcnt vmcnt(0)" ::: "memory");
        } else {
            XB_SPIN(xb_ld(&bar[XB_XGEN(b.x)]) == gen, bar);
            __builtin_amdgcn_fence(__ATOMIC_ACQUIRE, "agent");
            asm volatile("s_waitcnt vmcnt(0)" ::: "memory");
        }
    }
    __syncthreads();
}
#ifndef NAIVE
#define NAIVE 0
#endif
__device__ __forceinline__ void naive_pool(LAS unsigned char* lds, const bf16* proj, const float* poolw  , const float* pscale, bf16* Y, int vcu, int G, int tid) {
    LAS float* dl = (LAS float*)lds; LAS float* part = dl + 256;
    for (int it = vcu; it < M * 4; it += G) { const int t = it >> 2, g = it & 3, win = 2 << g, pos = t & (SEQ - 1);
        if (tid < 256) { const int lo = pos + 1 - win < 0 ? 0 : pos + 1 - win; float s = 0.f;
            for (int p = lo; p <= pos; ++p) s += bflo((unsigned)proj[(size_t)(t - (pos - p)) * LDP + C_POOL + g * 256 + tid]);
            const float cur = bflo((unsigned)proj[(size_t)t * LDP + C_POOL + g * 256 + tid]);
            dl[tid] = s / (float)(pos + 1 - lo) - cur; }
        __syncthreads();
        const int o = tid & 255, hf = tid >> 8; float a = 0.f;
        for (int c = hf * 128; c < hf * 128 + 128; ++c) a += dl[c] * poolw[((size_t)g * 256 + c) * 256 + o];
        if (hf) part[o] = a;
        __syncthreads();
        if (!hf) Y[(size_t)t * LDY + g * 256 + o] = (bf16)(pk2((a + part[o]) * pscale[g * 256 + o], 0.f) & 0xffffu);
        __syncthreads(); }
}
__device__ __forceinline__ void naive_ret(LAS unsigned char* lds, const bf16* proj, bf16* Y, int vcu, int G, int tid) {
    LAS float* qs = (LAS float*)lds; LAS float* ks = qs + 128; LAS float* vs = ks + 128; LAS float* po = vs + 128; LAS float* red = po + 512;
    for (int bh = vcu; bh < 32; bh += G) { const int b = bh >> 3, h = bh & 7; const float gam = 1.0f - exp2f(-5.0f - (float)h);
        float S[32];
#pragma unroll
        for (int i = 0; i < 32; ++i) S[i] = 0.f;
        const int e = tid & 127, dg = tid >> 7;
        for (int pos = 0; pos < SEQ; ++pos) { const size_t row = (size_t)b * SEQ + pos; const bf16* pr = proj + row * LDP + h * 128;
            if (tid < 128) { const int i = tid & 63; const float invf = exp2f(-((float)i / 63.0f) * 13.287712379549449f); const float ang = (float)pos * invf;
                const double rev = (double)ang * 0.15915494309189535; const float fr = (float)(rev - __builtin_rint(rev)); const float cs = __builtin_amdgcn_cosf(fr), sn = __builtin_amdgcn_sinf(fr);
                const float q1 = bflo((unsigned)pr[C_QR + i]), q2 = bflo((unsigned)pr[C_QR + 64 + i]), k1 = bflo((unsigned)pr[C_KR + i]), k2 = bflo((unsigned)pr[C_KR + 64 + i]);
                if (tid < 64) { qs[i] = q1 * cs - q2 * sn; ks[i] = (k1 * cs - k2 * sn) * RET_KSCALE; } else { qs[64 + i] = q2 * cs + q1 * sn; ks[64 + i] = (k2 * cs + k1 * sn) * RET_KSCALE; }
                vs[tid] = bflo((unsigned)pr[C_VR + tid]); }
            __syncthreads();
            float a = 0.f; const float ve = vs[e];
#pragma unroll
            for (int i = 0; i < 32; ++i) { const int d = dg * 32 + i; S[i] = gam * S[i] + ks[d] * ve; a += qs[d] * S[i]; }
            po[dg * 128 + e] = a;
            __syncthreads();
            if (tid < 128) { const float o = po[e] + po[128 + e] + po[256 + e] + po[384 + e]; const float s2 = wave_sum(o * o); if ((tid & 63) == 0) red[tid >> 6] = s2; po[e] = o; }
            __syncthreads();
            if (tid < 128) { const float rs = 1.0f / sqrtf((red[0] + red[1]) * (1.f / 128.f) + NORM_EPS); const float gt = bflo((unsigned)pr[C_GR + e]);
                Y[row * LDY + 2048 + h * 128 + e] = (bf16)(pk2(po[e] * rs * gt, 0.f) & 0xffffu); }
            __syncthreads(); } }
}
__device__ __forceinline__ void naive_attn(const bf16* proj, bf16* Y, const float* relb, const float* hgain, float lam, float oscale, int gw, int NGW, int lane) {
    for (int it = gw; it < 32 * SEQ; it += NGW) { const int bh = it / SEQ, q = it % SEQ, b = bh >> 3, h = bh & 7; const size_t rowbase = (size_t)b * SEQ;
        const bf16* qp = proj + (rowbase + q) * LDP + C_QD + h * 128;
        const float qa = bflo((unsigned)qp[lane]), qb = bflo((unsigned)qp[64 + lane]);
        float mx0 = -1e30f, mx1 = -1e30f;
        const int nkb = q / 64 + 1;
        for (int pass = 0; pass < 2; ++pass) {
            float l0 = 0.f, l1 = 0.f, o0a = 0.f, o0b = 0.f, o1a = 0.f, o1b = 0.f;
            for (int kb = 0; kb < nkb; ++kb) { const int key = kb * 64 + lane; const bool valid = key <= q; const int kc = valid ? key : q;
                const bf16* kp = proj + (rowbase + kc) * LDP + C_KD + h * 128; float s0 = 0.f, s1 = 0.f;
#pragma unroll
                for (int d8 = 0; d8 < 8; ++d8) { const v4u w0 = *(const GAS v4u*)(kp + 8 * d8), w1 = *(const GAS v4u*)(kp + 64 + 8 * d8);
#pragma unroll
                    for (int j = 0; j < 4; ++j) { const int d = 8 * d8 + 2 * j;
                        const float q0a = __builtin_bit_cast(float, __builtin_amdgcn_readlane(__builtin_bit_cast(int, qa), d)), q0b = __builtin_bit_cast(float, __builtin_amdgcn_readlane(__builtin_bit_cast(int, qa), d + 1));
                        const float q1a = __builtin_bit_cast(float, __builtin_amdgcn_readlane(__builtin_bit_cast(int, qb), d)), q1b = __builtin_bit_cast(float, __builtin_amdgcn_readlane(__builtin_bit_cast(int, qb), d + 1));
                        s0 += q0a * bflo(w0[j]) + q0b * bfhi(w0[j]); s1 += q1a * bflo(w1[j]) + q1b * bfhi(w1[j]); } }
                const float bs = relb[t5_bucket(q - kc) * 8 + h] * LOG2E; s0 += bs; s1 += bs;
                if (pass == 0) { if (valid) { mx0 = fmaxf(mx0, s0); mx1 = fmaxf(mx1, s1); } }
                else { const float p0 = valid ? exp2f(s0 - mx0) : 0.f, p1 = valid ? exp2f(s1 - mx1) : 0.f; l0 += p0; l1 += p1;
                    for (int kk = 0; kk < 64; ++kk) { const int k2 = kb * 64 + kk; if (k2 > q) break; const float a0 = __shfl(p0, kk), a1 = __shfl(p1, kk);
                        const bf16* vp = proj + (rowbase + k2) * LDP + C_VD + h * 128; const float va = bflo((unsigned)vp[lane]), vb = bflo((unsigned)vp[64 + lane]);
                        o0a += a0 * va; o0b += a0 * vb; o1a += a1 * va; o1b += a1 * vb; } } }
            if (pass == 0) {
#pragma unroll
                for (int o = 1; o < 64; o <<= 1) { mx0 = fmaxf(mx0, __shfl_xor(mx0, o)); mx1 = fmaxf(mx1, __shfl_xor(mx1, o)); } }
            else { l0 = wave_sum(l0); l1 = wave_sum(l1);
                const float da = o0a / l0 - lam * o1a / l1, db = o0b / l0 - lam * o1b / l1; const float ss = wave_sum(da * da + db * db);
                const float rs = oscale / sqrtf(ss * (1.f / 128.f) + NORM_EPS); bf16* yp = Y + (rowbase + q) * LDY + 1024 + h * 128;
                yp[lane] = (bf16)(pk2(da * rs * hgain[lane], 0.f) & 0xffffu); yp[64 + lane] = (bf16)(pk2(db * rs * hgain[64 + lane], 0.f) & 0xffffu); } } }
}
constexpr int NPH_LAYER = 10, NPH = 1 + DEPTH * NPH_LAYER;
struct Args { const float* in[15]; float* out; unsigned char* ws; int p_lo, p_hi; };
__global__ void __launch_bounds__(NWAVES * 64, 2) fwd(Args args) {
    extern __shared__ __attribute__((aligned(16))) unsigned char lds_raw[];
    LAS unsigned char* lds = (LAS unsigned char*)lds_raw;
#define LTID() ({ int t_ = threadIdx.x; asm volatile("" : "+v"(t_)); t_; })
    const int tid0 = threadIdx.x, wave = __builtin_amdgcn_readfirstlane(tid0 >> 6);
    const int G = gridDim.x; const int bx = blockIdx.x; const int vcu = (G % 8 == 0) ? (bx % 8) * (G / 8) + bx / 8 : bx;
    unsigned char* ws = args.ws;
    gu32* ctl = (gu32*)(ws + WS_CTL);
    for (int u = tid0; u < (LDS_BYTES - LDSCTL_OFF) / 4; u += NWAVES * 64) ((LAS unsigned*)(lds + LDSCTL_OFF))[u] = 0u;
    __syncthreads();
    volatile LAS unsigned* MISC = (volatile LAS unsigned*)(lds + MISC_OFF);
    XcdBarrier bar; bar.bar = (unsigned*)(ctl + CW_BAR); bar.x = 0; bar.st = nullptr;
    if (SINGLE_LAUNCH) bar = xcd_barrier_post((unsigned*)(ctl + CW_BAR), MISC + 8);
    const int lo = args.p_lo, hi_ph = args.p_hi;
#define IN(k) (lo <= (k) && (k) < hi_ph)
#ifndef PHMASK
#define PHMASK 0xffff
#endif
#define PHM(i) (((PHMASK) >> (i)) & 1)
#ifndef UMASK
#define UMASK 7
#endif
#define UEN(i) (((UMASK) >> (i)) & 1)
#ifndef DUPMASK
#define DUPMASK 0
#endif
#define REPS(i) ((((DUPMASK) >> (i)) & 1) ? 2 : 1)
#define SEAM(k) do { if (SINGLE_LAUNCH && IN(k) && IN((k) + 1)) { sw_.on = 1; TS_BEG(sw_, 30); TS_BEG(sw_, 31 + ((k) - 1 + NPH_LAYER) % NPH_LAYER); xcd_barrier(bar); TS_END(sw_, 31 + ((k) - 1 + NPH_LAYER) % NPH_LAYER); TS_END(sw_, 30); } } while (0)
#ifndef DOWN_INT8
#define DOWN_INT8 0
#endif
#ifndef UP_INT8
#define UP_INT8 1
#endif
#ifndef STAGGER_US
#define STAGGER_US 0
#endif
#define STAGGER() do { if (STAGGER_US > 0) { const unsigned long long t0_ = __builtin_amdgcn_s_memrealtime(); const unsigned long long dt_ = (unsigned long long)(STAGGER_US * 100) * (unsigned)((bx >> 3) & 3); \
        while (__builtin_amdgcn_s_memrealtime() - t0_ < dt_) __builtin_amdgcn_s_sleep(8); } } while (0)
#ifndef FUSE_THIN
#define FUSE_THIN 0
#endif
    const bool fuse_thin = FUSE_THIN && SINGLE_LAUNCH && (G == 256);
    constexpr int CW_PANEL = 16384;
#define PANEL_TAIL(S_, TI, GPOST, FOUT) do { \
        pg8::Unit u0_; (void)(S_).next(0, u0_); \
        gu32* cnt_ = ctl + CW_PANEL + ((TI) * 64 + u0_.pm) * 64; \
        if (tid0 == 0) { __builtin_amdgcn_fence(__ATOMIC_RELEASE, "agent"); asm volatile("s_waitcnt vmcnt(0)" ::: "memory"); (void)__hip_atomic_fetch_add(cnt_, 1u, RLX_AGENT); \
            unsigned sp_ = 0; while (__hip_atomic_load(cnt_, RLX_AGENT) < 4u) { __builtin_amdgcn_s_sleep(1); if (++sp_ > (1u << 21)) break; } \
            __builtin_amdgcn_fence(__ATOMIC_ACQUIRE, "agent"); asm volatile("s_waitcnt vmcnt(0)" ::: "memory"); } \
        __syncthreads(); \
        { const int lane_ = LTID() & 63; const int r0_ = u0_.pm * 256 + (u0_.pn & 3) * 64; float* fo_ = (FOUT); \
          for (int r_ = wave; r_ < 64; r_ += NWAVES) { const size_t m_ = (size_t)(r0_ + r_); resid_row(XN + m_ * DM, MIX + m_ * DM, STAT + m_ * 32, (GPOST), RS + m_, RQ + m_, fo_ ? fo_ + m_ * DM : (float*)nullptr, lane_, XQ + m_ * DM); } } \
    } while (0)

    const float* x_in = args.in[0]; const float* rel_bias = args.in[1];
    const float* g_pre_mix = args.in[2]; const float* g_post_mix = args.in[3]; const float* g_pre_mlp = args.in[4]; const float* g_post_mlp = args.in[5];
    const float* w_in = args.in[6]; const float* pool_w = args.in[7]; const float* pool_scale = args.in[8]; const float* diff_lambda = args.in[9]; const float* diff_hn = args.in[10];
    const float* w_branch = args.in[11]; const float* w_out = args.in[12]; const float* w_up = args.in[13]; const float* w_down = args.in[14];
    float* xres = args.out;
    bf16* WIN = (bf16*)(ws + WS_WIN); bf16* WB = (bf16*)(ws + WS_WB); bf16* WO = (bf16*)(ws + WS_WO); bf16* WUP = (bf16*)(ws + WS_WUP); bf16* WDN = (bf16*)(ws + WS_WDN); bf16* POOLT = (bf16*)(ws + WS_POOLT);
    bf16* XN = (bf16*)(ws + WS_XN); bf16* MRG = (bf16*)(ws + WS_MRG); bf16* MIX = (bf16*)(ws + WS_MIX); bf16* Y = (bf16*)(ws + WS_Y); bf16* PROJ = (bf16*)(ws + WS_PROJ); bf16* FF = PROJ;
    unsigned char* XQ = ws + WS_XQ; unsigned char* WQIN = ws + WS_WIN; unsigned char* WQUP = ws + WS_WIN + 160 * MiB; bf16* WTMP_IN = (bf16*)(ws + WS_PROJ); bf16* WTMP_UP = (bf16*)(ws + WS_PROJ + 224 * MiB);     bf16* WINB = (bf16*)(ws + WS_WUP);     float* CMIN = (float*)(ws + WS_CTL + CTL_CMAX_IN); float* CMUP = (float*)(ws + WS_CTL + CTL_CMAX_UP);
    bf16* WTMP_DN = (bf16*)(ws + WS_WDN);     unsigned char* WQDN = ws + WS_WQDN;     float* CMDN = (float*)(ws + WS_CTL + CTL_CMAX_DN);
    float* PMAX = (float*)(ws + WS_KV);     unsigned char* FFQ = ws + WS_PROJ + 256 * MiB;     float* RQF = (float*)(ws + WS_RQ + 65536);
    float* RS = (float*)(ws + WS_RS); float* RQ = (float*)(ws + WS_RQ); float* KV = (float*)(ws + WS_KV); bf16* SST = (bf16*)(ws + WS_SST); float* STAT = (float*)(ws + WS_STAT); f32x2* ROT = (f32x2*)(ws + WS_ROT);
    const int gw = vcu * NWAVES + wave, NGW = G * NWAVES;
    Stopwatch sw_; sw_.t0 = 0ull; sw_.acc = 0ull; sw_.on = 1;
#ifndef TSPH
#define TSPH 0
#endif
#define TS_PHASE(p) do { sw_.on = (TSPH == 0 || TSPH == (p)); } while (0)

    if (PHM(0) && IN(0)) for (int rep_ = 0; rep_ < REPS(0); ++rep_) {
        const int tid = LTID(), lane = tid & 63;
        LAS float* scr = (LAS float*)(lds + wave * 16384);
        constexpr int I_IN = (DM / 64) * (INC / 32), I_B = (MIXW / 64) * (DM / 32), I_O = (DM / 64) * (DM / 32), I_UP = (DM / 64) * (DFF / 32), I_DN = (DFF / 64) * (DM / 32), I_P = (256 / 64) * (256 / 32);
        constexpr int I_LAYER = I_IN + 3 * I_B + I_O + I_UP + I_DN + 4 * I_P;
        static_assert(!DOWN_INT8, "this prologue builds no int8 w_down copy");
        static_assert(C_GATE + 6144 <= PROJ_NS, "the branch gates (stored as u8 by the int8 projection epilogue) must be in the int8 part");
        { constexpr int NS_IN = PROJ_NS / 32, NS_UP = UP_INT8 ? DFF / 32 : 0, NS_LAYER = NS_IN + NS_UP, NS_ALL = DEPTH * NS_LAYER;
#define STRIP_RESOLVE(S, W_, N_, N0_, GAIN_, DST_, CM_) do { const int l = (S) / NS_LAYER; int r = (S) - l * NS_LAYER; \
            if (r < NS_IN) { W_ = w_in + (size_t)l * DM * INC; N_ = INC; N0_ = proj_oldcol(32 * r); GAIN_ = g_pre_mix + l * DM; DST_ = WQIN + ((size_t)l * PROJ_NS + 32 * r) * DM; CM_ = CMIN + l * INC + 32 * r; } \
            else { r -= NS_IN; W_ = w_up + (size_t)l * DM * DFF; N_ = DFF; N0_ = 32 * r; GAIN_ = g_pre_mlp + l * DM; DST_ = WQUP + ((size_t)l * DFF + 32 * r) * DM; CM_ = CMUP + l * DFF + 32 * r; } } while (0)
          float v_[4][32]; int s = vcu; const float* cw_ = nullptr; int cn_ = 0, c0_ = 0; const float* cg_ = nullptr; unsigned char* cd_ = nullptr; float* cc_ = nullptr;
          if (s < NS_ALL) { STRIP_RESOLVE(s, cw_, cn_, c0_, cg_, cd_, cc_); strip_load(cw_, cn_, c0_, wave, lane, v_); }
          while (s < NS_ALL) {
              strip_stage(lds, cg_, wave, lane, v_);
              __syncthreads();
              const int nx_ = s + G; unsigned char* nd_ = nullptr; float* nc_ = nullptr; const float* ng_ = nullptr;
              if (nx_ < NS_ALL) { STRIP_RESOLVE(nx_, cw_, cn_, c0_, ng_, nd_, nc_); strip_load(cw_, cn_, c0_, wave, lane, v_); }
              strip_quant(lds, cd_, cc_, wave, lane);
              __syncthreads();
              cg_ = ng_; cd_ = nd_; cc_ = nc_; s = nx_; }
#undef STRIP_RESOLVE
        }
        constexpr int NBB = (INC - PROJ_NS) / 32, NBB1 = NBB > 0 ? NBB : 1, I_INB = (DM / 64) * NBB, I_UPW = UP_INT8 ? 0 : I_UP, I_LAYERW = I_INB + 3 * I_B + I_O + I_UPW + I_DN + 4 * I_P;
#define P0_RESOLVE(IT, P) do { const int l = (IT) / I_LAYERW; int r = (IT) - l * I_LAYERW; \
            if (r < I_INB) { const int kb = r / NBB1, sc = PROJ_NS + 32 * (r - kb * NBB1), n0 = proj_oldcol(sc);             \
                P = P0Item{w_in + (size_t)l * DM * INC, INC, WINB + (size_t)l * (INC - PROJ_NS) * DM, DM, 0, g_pre_mix + l * DM, sc - PROJ_NS, (unsigned*)nullptr, kb * (INC / 32) + (n0 >> 5)}; break; } r -= I_INB; \
            if (r < 3 * I_B) { const int n = r / I_B; r -= n * I_B; P = P0Item{w_branch + ((size_t)l * 3 + n) * MIXW * DM, DM, WB + (size_t)l * DM * 3072, 3072, n * MIXW, (const float*)nullptr, -1, (unsigned*)nullptr, r}; break; } r -= 3 * I_B; \
            if (r < I_O) { P = P0Item{w_out + (size_t)l * DM * DM, DM, WO + (size_t)l * DM * DM, DM, 0, (const float*)nullptr, -1, (unsigned*)nullptr, r}; break; } r -= I_O; \
            if (r < I_UPW) { P = P0Item{w_up + (size_t)l * DM * DFF, DFF, WUP + (size_t)l * DFF * DM, DM, 0, g_pre_mlp + l * DM, -1, (unsigned*)nullptr, r}; break; } r -= I_UPW; \
            if (r < I_DN) { P = P0Item{w_down + (size_t)l * DFF * DM, DM, WDN + (size_t)l * DM * DFF, DFF, 0, (const float*)nullptr, -1, (unsigned*)nullptr, r}; break; } r -= I_DN; \
            { const int g = r / I_P; r -= g * I_P; P = P0Item{pool_w + ((size_t)l * 4 + g) * 65536, 256, POOLT + ((size_t)l * 4 + g) * 65536, 256, 0, (const float*)nullptr, -1, (unsigned*)nullptr, r}; } } while (0)
        { float v_[32]; P0Item cur_, nxt_; int it = gw;
          if (it < DEPTH * I_LAYERW) { P0_RESOLVE(it, cur_); p0_load(cur_, lane, v_); }
          while (it < DEPTH * I_LAYERW) {
              p0_stage(scr, lane, v_);
              const int nx_ = it + NGW;
              if (nx_ < DEPTH * I_LAYERW) { P0_RESOLVE(nx_, nxt_); p0_load(nxt_, lane, v_); }
              p0_emit(cur_, scr, lane);
              cur_ = nxt_; it = nx_; } }
#undef P0_RESOLVE
        for (int i = vcu * 512 + tid; i < SEQ * 64; i += G * 512) { const int pos = i >> 6, f = i & 63;
            const float invf = __builtin_amdgcn_exp2f(-(float)f * (13.287712379549449f / 63.0f));
            const float ang = (float)pos * invf; const double rev = (double)ang * 0.15915494309189535; const float fr = (float)(rev - __builtin_rint(rev));
            ROT[i] = (f32x2){__builtin_amdgcn_cosf(fr), __builtin_amdgcn_sinf(fr)}; }
        prep_rows(x_in, XN, XQ, RS, RQ, gw, NGW, lane);
    }
    SEAM(0);

    for (int l = 0; l < DEPTH; ++l) {
        const int pb = 1 + l * NPH_LAYER;
        const float lambda_init = 0.8f - 0.6f * __expf(-0.3f * (float)l);
#ifndef GREP1
#define GREP1 1
#endif
        for (int gr_ = 0; gr_ < GREP1; ++gr_) {
        if (PHM(1) && IN(pb + 0)) for (int rep_ = 0; rep_ < REPS(1); ++rep_) {
            TS_PHASE(1);
            if (PROJ_NS > 0) {
                pg8::Gemm g{(const bf16*)XQ, (const bf16*)(WQIN + (size_t)l * PROJ_NS * DM), M, PROJ_NS, DM / 2}; pg8::StaticOrder S; S.init(M, PROJ_NS, G, bx);
                pg8::EpiProjQ E{PROJ, LDP, QSCALE, RQ, CMIN + l * INC, 0, PROJ_MODEW, C_GATE};
                pg8::gemm_phase<pg8::EpiProjQ, pg8::StaticOrder, GEMM_ALIGN, GEMM_SP2>(lds, g, S, E, sw_); }
            if (PROJ_NS < INC) {
                pg8::Gemm g{XN, WINB + (size_t)l * (INC - PROJ_NS) * DM, M, INC - PROJ_NS, DM}; pg8::StaticOrder S; S.init(M, INC - PROJ_NS, G, bx);
                pg8::EpiProj E{PROJ, LDP, QSCALE, RS, PROJ_NS / 256, PROJ_MODEW};
                pg8::gemm_phase<pg8::EpiProj, pg8::StaticOrder, GEMM_ALIGN, GEMM_SP2>(lds, g, S, E, sw_); }
#ifdef DUPBAR
            if (rep_ + 1 < REPS(1)) xcd_barrier(bar);
#endif
        }
        SEAM(pb + 0);
        if (PHM(2) && IN(pb + 1)) for (int rep_ = 0; rep_ < REPS(2); ++rep_) {
            const int tid = LTID(), lane = tid & 63;
            if (NAIVE & 1) naive_pool(lds, PROJ, pool_w + (size_t)l * 4 * 65536, pool_scale + l * MIXW, Y, vcu, G, tid);
            else if (UEN(0)) for (int r2_ = 0; r2_ < REPS(11); ++r2_) for (int u = vcu; u < 512; u += G) pool_unit(lds, PROJ, POOLT + (size_t)l * 4 * 65536, pool_scale + l * MIXW, Y, u >> 2, u & 3, tid, lane, wave);
            if (NAIVE & 4) naive_ret(lds, PROJ, Y, vcu, G, tid);
            else if (UEN(1)) for (int r2_ = 0; r2_ < REPS(12); ++r2_) for (int u = vcu; u < 1024; u += G) retA_unit(lds, PROJ, ROT, KV, u, tid, lane, wave);
            if (UEN(2)) { const float* lp = diff_lambda + l * 256;
              const float s1 = wave_sum(lp[lane] * lp[64 + lane]), s2 = wave_sum(lp[128 + lane] * lp[192 + lane]);
              const float lam = __expf(s1) - __expf(s2) + lambda_init;
              if (NAIVE & 2) naive_attn(PROJ, Y, rel_bias, diff_hn + l * 128, lam, 1.f - lambda_init, gw, NGW, lane);
              else for (int r2_ = 0; r2_ < REPS(13); ++r2_) for (int i = 0; i < 4 * ((256 + G - 1) / G); ++i) { const int v = vcu + (i >> 2) * G; if (v >= 256) break;
                  const int bh = v >> 3, s = v & 7, k = i & 3; const int qb = (k == 0) ? 31 - s : (k == 1) ? 16 + s : (k == 2) ? 15 - s : s;
                  attn_unit(lds, PROJ, Y, rel_bias, diff_hn + l * 128, lam, 1.f - lambda_init, bh >> 3, bh & 7, qb, tid, lane, wave, sw_); } }
        }
        SEAM(pb + 1);
        if (!(NAIVE & 4) && PHM(3) && IN(pb + 2)) for (int rep_ = 0; rep_ < REPS(3); ++rep_) {
            const int tid = LTID();
            for (int gid = vcu * 512 + tid; gid < 32 * 4096; gid += G * 512) { const int bh = gid >> 12, i4 = gid & 4095; const float dec = __builtin_amdgcn_exp2f(128.f * kLog2Gamma[bh & 7]);
                f32x4 S = {0.f, 0.f, 0.f, 0.f};
                const GAS f32x4* kp = (const GAS f32x4*)(KV + (size_t)bh * 32 * 16384) + i4; GAS v2u* sp = (GAS v2u*)(SST + (size_t)bh * 32 * 16384) + i4;
                f32x4 kc[8], kn[8];
#pragma unroll
                for (int i = 0; i < 8; ++i) kc[i] = kp[(size_t)i * 4096];
#pragma unroll
                for (int r = 0; r < 4; ++r) {
                    if (r < 3) {
#pragma unroll
                        for (int i = 0; i < 8; ++i) if (8 * (r + 1) + i < 31) kn[i] = kp[(size_t)(8 * (r + 1) + i) * 4096]; }
#pragma unroll
                    for (int i = 0; i < 8; ++i) if (8 * r + i < 31) { S = S * dec + kc[i]; v2u w; w.x = pk2(S.x, S.y); w.y = pk2(S.z, S.w); sp[(size_t)(8 * r + i + 1) * 4096] = w; }
#pragma unroll
                    for (int i = 0; i < 8; ++i) kc[i] = kn[i]; } }
        }
        SEAM(pb + 2);
        if (!(NAIVE & 4) && PHM(4) && IN(pb + 3)) for (int rep_ = 0; rep_ < REPS(4); ++rep_) { const int tid = LTID(), lane = tid & 63; for (int u = vcu; u < 1024; u += G) retC_unit(lds, PROJ, ROT, SST, Y, u, tid, lane, wave, sw_); }
        SEAM(pb + 3);
        if (PHM(5) && IN(pb + 4)) for (int rep_ = 0; rep_ < REPS(5); ++rep_) {
            TS_PHASE(2); pg8::Gemm g{Y, WB + (size_t)l * DM * 3072, M, DM, 3072}; pg8::StaticOrder S; S.init(M, DM, G, bx);
            pg8::EpiWiden E{MRG, DM, (const unsigned char*)(PROJ + C_GATE), LDP * 2};
            pg8::gemm_phase<pg8::EpiWiden, pg8::StaticOrder, GEMM_ALIGN, GEMM_SP2>(lds, g, S, E, sw_);
        }
        SEAM(pb + 4);
        if (PHM(6) && IN(pb + 5)) for (int rep_ = 0; rep_ < REPS(6); ++rep_) {
            TS_PHASE(3); pg8::Gemm g{MRG, WO + (size_t)l * DM * DM, M, DM, DM}; pg8::StaticOrder S; S.init(M, DM, G, bx);
            pg8::EpiSq E{MIX, DM, STAT};
            pg8::gemm_phase<pg8::EpiSq, pg8::StaticOrder, GEMM_ALIGN, GEMM_SP2>(lds, g, S, E, sw_);
            if (fuse_thin && GREP1 == 1 && REPS(6) == 1) PANEL_TAIL(S, l * 2, g_post_mix + l * DM, (float*)nullptr);
        }
        if (gr_ + 1 < GREP1) xcd_barrier(bar);
        }
        SEAM(pb + 5);
        if (!(fuse_thin && GREP1 == 1 && REPS(6) == 1)) {
        if (PHM(7) && IN(pb + 6)) {
            const int lane = LTID() & 63;
            resid_rows(XN, MIX, STAT, g_post_mix + l * DM, RS, RQ, (float*)nullptr, XQ, gw, NGW, lane);
        }
        SEAM(pb + 6);
        }
#ifndef MLP_HALVES
#define MLP_HALVES 0
#endif
#if MLP_HALVES
        if (PHM(8) && IN(pb + 7)) {
            constexpr int MH = M / 2;
            for (int st_ = 0; st_ < 3; ++st_) {
                if (st_ >= 1) { const int h_ = st_ - 1;
                    pg8::Gemm g{FF + (size_t)h_ * MH * DFF, WDN + (size_t)l * DM * DFF, MH, DM, DFF}; pg8::StaticOrder S; S.init(MH, DM, G, bx);
                    pg8::EpiSq E{MIX + (size_t)h_ * MH * DM, DM, STAT + (size_t)h_ * MH * 32};
                    pg8::gemm_phase<pg8::EpiSq, pg8::StaticOrder, GEMM_ALIGN, GEMM_SP2>(lds, g, S, E, sw_); }
                if (st_ <= 1) { const int h_ = st_;
                    pg8::Gemm g{XN + (size_t)h_ * MH * DM, WUP + (size_t)l * DFF * DM, MH, DFF, DM}; pg8::StaticOrder S; S.init(MH, DFF, G, bx);
                    pg8::EpiRelu2 E{FF + (size_t)h_ * MH * DFF, DFF, RS + (size_t)h_ * MH};
                    pg8::gemm_phase<pg8::EpiRelu2, pg8::StaticOrder, GEMM_ALIGN, GEMM_SP2>(lds, g, S, E, sw_); }
                if (st_ < 2 && SINGLE_LAUNCH) xcd_barrier(bar);
            }
        }
        SEAM(pb + 8);
#else
#ifndef GREP2
#define GREP2 1
#endif
        for (int gr2_ = 0; gr2_ < GREP2; ++gr2_) {
        if (PHM(8) && IN(pb + 7)) for (int rep_ = 0; rep_ < REPS(8); ++rep_) {
#if UP_INT8
            TS_PHASE(4); pg8::Gemm g{(const bf16*)XQ, (const bf16*)(WQUP + (size_t)l * DFF * DM), M, DFF, DM / 2}; pg8::StaticOrder S; S.init(M, DFF, G, bx);
            pg8::EpiRelu2Q E{FF, DFF, RQ, CMUP + l * DFF};
            pg8::gemm_phase<pg8::EpiRelu2Q, pg8::StaticOrder, GEMM_ALIGN, GEMM_SP2>(lds, g, S, E, sw_);
#else
            pg8::Gemm g{XN, WUP + (size_t)l * DFF * DM, M, DFF, DM}; pg8::StaticOrder S; S.init(M, DFF, G, bx);
            pg8::EpiRelu2 E{FF, DFF, RS};
            STAGGER();
            pg8::gemm_phase<pg8::EpiRelu2, pg8::StaticOrder, GEMM_ALIGN, GEMM_SP2>(lds, g, S, E, sw_);
#endif
        }
        SEAM(pb + 7);
        if (PHM(9) && IN(pb + 8)) for (int rep_ = 0; rep_ < REPS(9); ++rep_) {
#if DOWN_INT8
            { const int lane = LTID() & 63;
              for (int m = gw; m < M; m += NGW) quant_ffrow(FF + (size_t)m * DFF, PMAX + (size_t)m * 128, FFQ + (size_t)m * DFF, RQF + m, lane); }
            if (SINGLE_LAUNCH) xcd_barrier(bar);
            pg8::Gemm g{(const bf16*)FFQ, (const bf16*)(WQDN + (size_t)l * DM * DFF), M, DM, DFF / 2}; pg8::StaticOrder S; S.init(M, DM, G, bx);
            pg8::EpiSqQ E{MIX, DM, STAT, RQF, CMDN + l * DM};
            pg8::gemm_phase<pg8::EpiSqQ, pg8::StaticOrder, GEMM_ALIGN, GEMM_SP2>(lds, g, S, E, sw_);
#else
            TS_PHASE(5); pg8::Gemm g{FF, WDN + (size_t)l * DM * DFF, M, DM, DFF}; pg8::StaticOrder S; S.init(M, DM, G, bx);
            pg8::EpiSq E{MIX, DM, STAT};
            pg8::gemm_phase<pg8::EpiSq, pg8::StaticOrder, GEMM_ALIGN, GEMM_SP2>(lds, g, S, E, sw_);
#endif
            if (fuse_thin && REPS(9) == 1) PANEL_TAIL(S, l * 2 + 1, g_post_mlp + l * DM, (l == DEPTH - 1) ? xres : (float*)nullptr);
        }
        if (gr2_ + 1 < GREP2) xcd_barrier(bar);
        }
        SEAM(pb + 8);
#endif
        if (!(fuse_thin && REPS(9) == 1)) {
        if (PHM(10) && IN(pb + 9)) {
            const int lane = LTID() & 63;
            const bool lastl = (l == DEPTH - 1);
            resid_rows(XN, MIX, STAT, g_post_mlp + l * DM, RS, RQ, lastl ? xres : (float*)nullptr, XQ, gw, NGW, lane);
        }
        SEAM(pb + 9);
        }
    }
#ifdef TSSEL
    { const unsigned long long t0_ = __builtin_amdgcn_s_memrealtime(); const unsigned long long dt_ = sw_.acc * (unsigned long long)TSAMP;
      while (__builtin_amdgcn_s_memrealtime() - t0_ < dt_) __builtin_amdgcn_s_sleep(16); }
#endif
#undef IN
#undef SEAM
}

extern "C" void kernel_launch(void* const* d_in, const int* in_sizes, int n_in, void* d_out, int out_size, void* d_ws, size_t ws_size, hipStream_t stream) {
    static int grid = 0;
    if (grid == 0) {
        if (n_in != 15 || in_sizes[0] != M * DM || out_size != M * DM || ws_size < WS_END) { fprintf(stderr, "kernel_launch: unexpected shapes / workspace (n_in %d, ws %zu, need %zu); nothing launched\n", n_in, ws_size, (size_t)WS_END); grid = -1; return; }
        int dev = 0, cus = 0, per_cu = 0;
        if (hipGetDevice(&dev) != hipSuccess || hipDeviceGetAttribute(&cus, hipDeviceAttributeMultiprocessorCount, dev) != hipSuccess) { grid = -1; return; }
        if (hipFuncSetAttribute((const void*)fwd, hipFuncAttributeMaxDynamicSharedMemorySize, LDS_BYTES) != hipSuccess) { fprintf(stderr, "kernel_launch: hipFuncSetAttribute failed\n"); grid = -1; return; }
        if (hipOccupancyMaxActiveBlocksPerMultiprocessor(&per_cu, (const void*)fwd, NWAVES * 64, LDS_BYTES) != hipSuccess || per_cu < 1) fprintf(stderr, "kernel_launch: note: occupancy query reports %d workgroups per CU\n", per_cu);
        (void)hipGetLastError();
        grid = cus;
    }
    if (grid < 0) return;
    if (hipMemsetAsync((char*)d_ws + WS_CTL, 0, CTL_ZERO_BYTES, stream) != hipSuccess) return;
    Args a{};
    for (int i = 0; i < 15; ++i) a.in[i] = (const float*)d_in[i];
    a.out = (float*)d_out; a.ws = (unsigned char*)d_ws;
    if (SINGLE_LAUNCH) {
        a.p_lo = 0; a.p_hi = NPH;
        hipLaunchKernelGGL(fwd, dim3(grid), dim3(NWAVES * 64), LDS_BYTES, stream, a);
    } else {
        for (int p = 0; p < NPH; ++p) { a.p_lo = p; a.p_hi = p + 1; hipLaunchKernelGGL(fwd, dim3(grid), dim3(NWAVES * 64), LDS_BYTES, stream, a); }
    }
    const hipError_t le = hipPeekAtLastError();
    if (le != hipSuccess) fprintf(stderr, "kernel_launch: launch failed: %s\n", hipGetErrorName(le));
}
```

```cpp
#include <hip/hip_runtime.h>
#include <cstdio>
#include <cstdint>
struct Stopwatch { unsigned long long t0, acc; int on; };
#ifdef TSSEL
#ifndef TSAMP
#define TSAMP 8
#endif
#define TS_BEG(sw, id) do { if ((id) == TSSEL && (sw).on) (sw).t0 = __builtin_amdgcn_s_memrealtime(); } while (0)
#define TS_END(sw, id) do { if ((id) == TSSEL && (sw).on) (sw).acc += __builtin_amdgcn_s_memrealtime() - (sw).t0; } while (0)
#else
#define TS_BEG(sw, id) do { } while (0)
#define TS_END(sw, id) do { } while (0)
#endif
namespace pg8 {
#define PG8_LAS __attribute__((address_space(3)))
typedef unsigned short bf16_t;
typedef short bf16x8 __attribute__((ext_vector_type(8)));
typedef float f32x4 __attribute__((ext_vector_type(4)));
typedef unsigned u32x4 __attribute__((ext_vector_type(4)));
typedef unsigned u32x2 __attribute__((ext_vector_type(2)));
typedef int i32x4 __attribute__((ext_vector_type(4)));
constexpr int BM = 256, BK = 64, HALF = 128, HTB = HALF * BK * 2  , STAGE_BYTES = 8 * HTB, NXCD = 8, WGM = 8;

__host__ __device__ __forceinline__ int lds_byte(int r, int c) { const int st = (r >> 4) * 2 + (c >> 5), rr = r & 15, cc = c & 31, ob = rr * 64 + cc * 2; return st * 1024 + (ob ^ (((ob >> 9) & 1) << 5)); }
__host__ __device__ __forceinline__ void stage_rc(int b, int& R, int& C) { const int st = b / 1024, sb = b % 1024, swz = sb ^ (((sb >> 9) & 1) << 5); R = (st >> 1) * 16 + swz / 64; C = (st & 1) * 32 + (swz % 64) / 2; }
__host__ __device__ __forceinline__ int perm32(int rho) { const int n = rho >> 4, i = rho & 15; return 8 * (i >> 2) + 4 * n + (i & 3); }

struct Unit { int pm, pn; };
struct Gemm { const bf16_t* A; const bf16_t* Bt; int M, N, K; };

struct StaticOrder {
    int nM, nN, nwg, G, c;
    __host__ __device__ void init(int M, int N, int G_, int c_) { nM = M / BM; nN = N / BM; nwg = nM * nN; G = G_; c = c_; }
    __host__ __device__ bool next(int i, Unit& u) const {
        const long L = (long)i * G + c; if (L >= nwg) return false;
        int wgid = (int)L; { const int q = nwg / NXCD, r = nwg % NXCD, xcd = wgid % NXCD, off = wgid / NXCD; wgid = (xcd < r ? xcd * (q + 1) : r * (q + 1) + (xcd - r) * q) + off; }
        const int nig = WGM * nN, gid = wgid / nig, fm = gid * WGM, gsz = (nM - fm) < WGM ? (nM - fm) : WGM;
        u.pm = fm + ((wgid % nig) % gsz); u.pn = (wgid % nig) / gsz; return true;
    }
    __device__ __forceinline__ void a_ready(const Unit&) const {}
    __device__ __forceinline__ void done(const Unit&) const {}
};

typedef float f32x2c __attribute__((ext_vector_type(2))); typedef __bf16 bf16x2c __attribute__((ext_vector_type(2)));
__device__ __forceinline__ unsigned cvt_pk_bf16(float lo, float hi) { f32x2c v = {lo, hi}; bf16x2c b = __builtin_convertvector(v, bf16x2c); return __builtin_bit_cast(unsigned, b); }
typedef float f32x2 __attribute__((ext_vector_type(2)));

__device__ __forceinline__ f32x4 mma16(bf16x8 a, bf16x8 b, f32x4 c) { return __builtin_amdgcn_mfma_f32_16x16x32_bf16(a, b, c, 0, 0, 0); }
__device__ __forceinline__ i32x4 mma16(bf16x8 a, bf16x8 b, i32x4 c) { return __builtin_amdgcn_mfma_i32_16x16x64_i8(__builtin_bit_cast(i32x4, a), __builtin_bit_cast(i32x4, b), c, 0, 0, 0); }
struct EpiProjQ; struct EpiRelu2Q;
template <class A_, class B_> struct same_t { static constexpr bool v = false; }; template <class A_> struct same_t<A_, A_> { static constexpr bool v = true; };
template <class Epi, class Sched, bool ALIGN_EPI = false, bool SP2 = false>
__device__ __forceinline__ void gemm_phase(PG8_LAS unsigned char* lds, const Gemm g, const Sched& S, const Epi& E, Stopwatch& sw) {
    int tid_ = threadIdx.x; asm volatile("" : "+v"(tid_));
    const int tid = tid_, wid = __builtin_amdgcn_readfirstlane(tid >> 6), lane = tid & 63, wr = wid >> 2, wc = wid & 3, fr = lane & 15, fq = lane >> 4;
    const int K = g.K, nt = K / BK;
    unsigned voffA[2], voffB[2];
#pragma unroll
    for (int i = 0; i < 2; ++i) { int R, C; stage_rc(tid * 16 + i * 8192, R, C); const int Rb = Epi::PERM ? ((R & ~31) + perm32(R & 31)) : R;
        voffA[i] = (unsigned)(R * K + C) * 2u; voffB[i] = (unsigned)(Rb * K + C) * 2u; }
    const size_t kstep = (size_t)(BK * 2);
    const size_t hstep = (size_t)HALF * K * 2;
    const size_t tstep = 2 * hstep;
    const unsigned ldsw = (unsigned)wid * 1024u;
    const int aoff = lds_byte(wr * 64 + fr, fq * 8), boff = lds_byte(wc * 32 + fr, fq * 8);
#define PG8_SA(b, h) (((b) * 2 + (h)) * HTB)
#define PG8_SB(b, h) ((4 + (b) * 2 + (h)) * HTB)
#define PG8_STAGE(bufoff, gbase, voff) do { _Pragma("unroll") for (int _i = 0; _i < 2; ++_i) \
        __builtin_amdgcn_global_load_lds((const unsigned*)((const char*)(gbase) + (voff)[_i]), (PG8_LAS unsigned*)(lds + (bufoff) + ldsw + _i * 8192), 16, 0, 0); } while (0)
#define PG8_LDA(dst, b, h) do { _Pragma("unroll") for (int m = 0; m < 4; ++m) _Pragma("unroll") for (int k = 0; k < 2; ++k) dst[m][k] = *(const PG8_LAS bf16x8*)(lds + PG8_SA(b, h) + aoff + m * 2048 + k * 1024); } while (0)
#define PG8_LDB(dst, b, h) do { _Pragma("unroll") for (int n = 0; n < 2; ++n) _Pragma("unroll") for (int k = 0; k < 2; ++k) dst[n][k] = *(const PG8_LAS bf16x8*)(lds + PG8_SB(b, h) + boff + n * 2048 + k * 1024); } while (0)
#define PG8_MMA(ai, bj, At, Bt) do { __builtin_amdgcn_s_setprio(1); _Pragma("unroll") for (int m = 0; m < 4; ++m) _Pragma("unroll") for (int n = 0; n < 2; ++n) _Pragma("unroll") for (int k = 0; k < 2; ++k) \
        acc[ai][bj][m][n] = mma16(Bt[n][k], At[m][k], acc[ai][bj][m][n]); __builtin_amdgcn_s_setprio(0); } while (0)
#define PG8_WAIT_V(n) asm volatile("s_waitcnt vmcnt(" #n ")" ::: "memory")
#define PG8_WAIT_VN(n) asm volatile("s_waitcnt vmcnt(%0)" :: "n"(n) : "memory")
#define PG8_WAIT_L(n) asm volatile("s_waitcnt lgkmcnt(" #n ")" ::: "memory")
#define PG8_BAR __builtin_amdgcn_s_barrier()
#define PG8_SCHED __builtin_amdgcn_sched_barrier(0)
    Unit cur, nxt; int ui = 0;
    if (!S.next(0, cur)) return;
    typename Epi::acc_t acc[2][2][4][2];
#pragma unroll
    for (int a = 0; a < 2; ++a)
#pragma unroll
        for (int b = 0; b < 2; ++b)
#pragma unroll
            for (int m = 0; m < 4; ++m)
#pragma unroll
                for (int n = 0; n < 2; ++n) acc[a][b][m][n] = typename Epi::acc_t{};
    bf16x8 At[4][2], B0[2][2], B1[2][2];
    const char* cA = (const char*)g.A + (size_t)cur.pm * tstep; const char* cB = (const char*)g.Bt + (size_t)cur.pn * tstep;
    S.a_ready(cur);
    if constexpr (SP2) {
        PG8_STAGE(PG8_SB(0, 0), cB, voffB); PG8_STAGE(PG8_SB(0, 1), cB + hstep, voffB); PG8_STAGE(PG8_SA(0, 0), cA, voffA); PG8_STAGE(PG8_SA(0, 1), cA + hstep, voffA);
        if (wr == 1) PG8_BAR;
        PG8_WAIT_V(2); PG8_BAR;
        PG8_STAGE(PG8_SB(1, 0), cB + kstep, voffB); PG8_STAGE(PG8_SA(1, 0), cA + kstep, voffA); PG8_STAGE(PG8_SB(1, 1), cB + hstep + kstep, voffB);
        PG8_WAIT_V(6); PG8_BAR;
    } else {
        PG8_STAGE(PG8_SB(0, 0), cB, voffB); PG8_STAGE(PG8_SA(0, 0), cA, voffA); PG8_STAGE(PG8_SB(0, 1), cB + hstep, voffB); PG8_STAGE(PG8_SA(0, 1), cA + hstep, voffA);
        if (wr == 1) PG8_BAR;
        PG8_WAIT_V(4); PG8_BAR;
        PG8_STAGE(PG8_SB(1, 0), cB + kstep, voffB); PG8_STAGE(PG8_SA(1, 0), cA + kstep, voffA); PG8_STAGE(PG8_SB(1, 1), cB + hstep + kstep, voffB);
        PG8_WAIT_V(6); PG8_BAR;
    }
    for (;;) {
        const bool has_next = S.next(ui + 1, nxt);
        const char* nA = has_next ? (const char*)g.A + (size_t)nxt.pm * tstep : cA; const char* nB = has_next ? (const char*)g.Bt + (size_t)nxt.pn * tstep : cB;
        TS_BEG(sw, 23); TS_BEG(sw, 20);
        for (int t = 0; t < nt; t += 2) {
            if constexpr (Epi::MID) { if (t == Epi::MID_T0 || t == Epi::MID_T1) E.mid(acc, cur, t, wr, wc, fr, fq); }
            const bool last = (t == nt - 2);
            const char* a1 = cA + (size_t)(t + 1) * kstep;
            const char* a2 = last ? nA : cA + (size_t)(t + 2) * kstep; const char* b2 = last ? nB : cB + (size_t)(t + 2) * kstep;
            const char* a3 = a2 + kstep; const char* b3 = b2 + kstep;
            if (last && has_next) S.a_ready(nxt);
            if constexpr (SP2) {
            int relax = __builtin_amdgcn_readfirstlane((int)((ui > 0) && (t == 0))); asm volatile("" : "+s"(relax));
            PG8_LDB(B0, 0, 0); PG8_LDB(B1, 0, 1); PG8_SCHED; PG8_LDA(At, 0, 0); if (!relax) PG8_STAGE(PG8_SA(1, 1), a1 + hstep, voffA);
            if (relax) PG8_WAIT_VN(8 + Epi::NST); else PG8_WAIT_V(8); PG8_WAIT_L(0); PG8_BAR; PG8_MMA(0, 0, At, B0); PG8_MMA(0, 1, At, B1); PG8_BAR; PG8_SCHED;
            PG8_LDA(At, 0, 1); PG8_STAGE(PG8_SB(0, 0), b2, voffB); PG8_STAGE(PG8_SB(0, 1), b2 + hstep, voffB); PG8_STAGE(PG8_SA(0, 0), a2, voffA);
            if (relax) PG8_WAIT_VN(8 + Epi::NST); else PG8_WAIT_V(8); PG8_WAIT_L(0); PG8_BAR; PG8_MMA(1, 0, At, B0); PG8_MMA(1, 1, At, B1); PG8_BAR; PG8_SCHED;
            PG8_LDB(B0, 1, 0); PG8_LDB(B1, 1, 1); PG8_SCHED; PG8_LDA(At, 1, 0); PG8_STAGE(PG8_SA(0, 1), a2 + hstep, voffA);
            if (relax) PG8_WAIT_VN(8 + Epi::NST); else PG8_WAIT_V(8); PG8_WAIT_L(0); PG8_BAR; PG8_MMA(0, 0, At, B0); PG8_MMA(0, 1, At, B1); PG8_BAR; PG8_SCHED;
            PG8_LDA(At, 1, 1); PG8_STAGE(PG8_SB(1, 0), b3, voffB); PG8_STAGE(PG8_SB(1, 1), b3 + hstep, voffB); PG8_STAGE(PG8_SA(1, 0), a3, voffA);
            PG8_WAIT_V(8); PG8_WAIT_L(0); PG8_BAR; PG8_MMA(1, 0, At, B0); PG8_MMA(1, 1, At, B1); PG8_BAR; PG8_SCHED;
            if (last && has_next) PG8_STAGE(PG8_SA(1, 1), a3 + hstep, voffA);
            } else {
            PG8_LDB(B0, 0, 0); PG8_SCHED; PG8_LDA(At, 0, 0); PG8_STAGE(PG8_SA(1, 1), a1 + hstep, voffA);
            PG8_WAIT_L(8); PG8_BAR; PG8_WAIT_L(0); PG8_MMA(0, 0, At, B0); PG8_BAR; PG8_SCHED;
            PG8_LDB(B1, 0, 1); PG8_STAGE(PG8_SB(0, 0), b2, voffB);
            PG8_BAR; PG8_WAIT_L(0); PG8_MMA(0, 1, At, B1); PG8_BAR;
            PG8_LDA(At, 0, 1); PG8_STAGE(PG8_SA(0, 0), a2, voffA);
            PG8_BAR; PG8_WAIT_L(0); PG8_MMA(1, 0, At, B0); PG8_BAR; PG8_SCHED;
            PG8_STAGE(PG8_SB(0, 1), b2 + hstep, voffB);
            PG8_WAIT_V(6); PG8_BAR; PG8_MMA(1, 1, At, B1); PG8_BAR;
            PG8_LDB(B0, 1, 0); PG8_SCHED; PG8_LDA(At, 1, 0); PG8_STAGE(PG8_SA(0, 1), a2 + hstep, voffA);
            PG8_WAIT_L(8); PG8_BAR; PG8_WAIT_L(0); PG8_MMA(0, 0, At, B0); PG8_BAR; PG8_SCHED;
            PG8_LDB(B1, 1, 1); PG8_STAGE(PG8_SB(1, 0), b3, voffB);
            PG8_BAR; PG8_WAIT_L(0); PG8_MMA(0, 1, At, B1); PG8_BAR;
            PG8_LDA(At, 1, 1); PG8_STAGE(PG8_SA(1, 0), a3, voffA);
            PG8_BAR; PG8_WAIT_L(0); PG8_MMA(1, 0, At, B0); PG8_BAR; PG8_SCHED;
            PG8_STAGE(PG8_SB(1, 1), b3 + hstep, voffB);
            PG8_WAIT_V(6); PG8_BAR; PG8_MMA(1, 1, At, B1); PG8_BAR;
            }
        }
        TS_END(sw, 20); TS_BEG(sw, 21);
        if constexpr (ALIGN_EPI) { if (wr == 0) PG8_BAR; }
        TS_END(sw, 21); TS_BEG(sw, 22);
#ifdef TSSEL
        if constexpr (same_t<Epi, EpiProjQ>::v || same_t<Epi, EpiRelu2Q>::v) { if (TSSEL == 24) {
            TS_BEG(sw, 24); const int row0_ = cur.pm * BM + wr * 64 + fr, col0_ = cur.pn * BM + wc * 32 + 8 * fq; float x_ = 0.f;
#pragma unroll
            for (int i_ = 0; i_ < 8; ++i_) x_ += E.rq[row0_ + (i_ >> 2) * HALF + (i_ & 3) * 16];
            const f32x4 c0_ = *(const f32x4*)(E.cmax + col0_), c1_ = *(const f32x4*)(E.cmax + col0_ + HALF); x_ += c0_[0] + c1_[3];
            asm volatile("s_waitcnt vmcnt(0)" : "+v"(x_) :: "memory"); TS_END(sw, 24); } }
#endif
        if constexpr (!Epi::AFTER_DRAIN) { asm volatile("; EPI_BEGIN" ::: "memory"); E(acc, cur, wr, wc, fr, fq); asm volatile("; EPI_END" ::: "memory"); S.done(cur); }
        TS_END(sw, 22); TS_END(sw, 23);
        if (!has_next) break;
#pragma unroll
        for (int a = 0; a < 2; ++a)
#pragma unroll
            for (int b = 0; b < 2; ++b)
#pragma unroll
                for (int m = 0; m < 4; ++m)
#pragma unroll
                    for (int n = 0; n < 2; ++n) acc[a][b][m][n] = typename Epi::acc_t{};
        cur = nxt; cA = nA; cB = nB; ++ui;
        if constexpr (ALIGN_EPI) { if (wr == 1) PG8_BAR; }
    }
    PG8_WAIT_V(0);
    if constexpr (!ALIGN_EPI) { if (wr == 0) PG8_BAR; }
    PG8_BAR;
    if constexpr (Epi::AFTER_DRAIN) { E.fused(acc, cur, wr, wc, fr, fq, lds, wid, lane); S.done(cur); }
#undef PG8_SA
#undef PG8_SB
#undef PG8_STAGE
#undef PG8_LDA
#undef PG8_LDB
#undef PG8_MMA
#undef PG8_WAIT_V
#undef PG8_WAIT_VN
#undef PG8_WAIT_L
#undef PG8_BAR
#undef PG8_SCHED
}
}
namespace pg8 {
__device__ __forceinline__ float sigm(float v) { return __builtin_amdgcn_rcpf(1.0f + __builtin_amdgcn_exp2f(-1.4426950408889634f * v)); }
struct EpiProj {
    typedef f32x4 acc_t;
    static constexpr bool PERM = true, AFTER_DRAIN = false, MID = false; static constexpr int MID_T0 = -1, MID_T1 = -1, NST = 16;
    bf16_t* O; int ldc; float qscale; const float* rs; int pn0; unsigned modew;
    __device__ __forceinline__ void operator()(const f32x4 (&acc)[2][2][4][2], const Unit& u, int wr, int wc, int fr, int fq) const {
        const int pt = u.pn + pn0; const int row0 = u.pm * BM + wr * 64 + fr, col0 = pt * BM + wc * 32 + 8 * fq;
        const int mode = (int)((modew >> (2 * (pt >> 2))) & 3u);
        const float sc = mode == 1 ? qscale : 1.f;
#pragma unroll
        for (int ai = 0; ai < 2; ++ai)
#pragma unroll
            for (int m = 0; m < 4; ++m) { bf16_t* rowp = O + (size_t)(row0 + ai * HALF + m * 16) * ldc + col0; const float rr = rs[row0 + ai * HALF + m * 16];
#pragma unroll
                for (int bj = 0; bj < 2; ++bj) { f32x4 v0 = acc[ai][bj][m][0] * rr, v1 = acc[ai][bj][m][1] * rr;
                    if (mode >= 2) {
#pragma unroll
                        for (int j = 0; j < 4; ++j) { const float s0 = sigm(v0[j]), s1 = sigm(v1[j]); v0[j] = mode == 3 ? s0 : v0[j] * s0; v1[j] = mode == 3 ? s1 : v1[j] * s1; }
                    } else { v0 = v0 * sc; v1 = v1 * sc; }
                    u32x4 w; w.x = cvt_pk_bf16(v0[0], v0[1]); w.y = cvt_pk_bf16(v0[2], v0[3]); w.z = cvt_pk_bf16(v1[0], v1[1]); w.w = cvt_pk_bf16(v1[2], v1[3]);
                    *(u32x4*)(rowp + bj * HALF) = w; } }
    }
};
struct EpiRelu2 {
    typedef f32x4 acc_t;
    static constexpr bool PERM = true, AFTER_DRAIN = false, MID = false; static constexpr int MID_T0 = -1, MID_T1 = -1, NST = 16;
    bf16_t* O; int ldc; const float* rs;
    __device__ __forceinline__ void operator()(const f32x4 (&acc)[2][2][4][2], const Unit& u, int wr, int wc, int fr, int fq) const {
        const int row0 = u.pm * BM + wr * 64 + fr, col0 = u.pn * BM + wc * 32 + 8 * fq;
#pragma unroll
        for (int ai = 0; ai < 2; ++ai)
#pragma unroll
            for (int m = 0; m < 4; ++m) { bf16_t* rowp = O + (size_t)(row0 + ai * HALF + m * 16) * ldc + col0; const float rr = rs[row0 + ai * HALF + m * 16];
#pragma unroll
                for (int bj = 0; bj < 2; ++bj) { f32x4 v0 = acc[ai][bj][m][0], v1 = acc[ai][bj][m][1];
#pragma unroll
                    for (int j = 0; j < 4; ++j) { const float a = __builtin_fmaxf(v0[j], 0.f) * rr, b = __builtin_fmaxf(v1[j], 0.f) * rr; v0[j] = a * a; v1[j] = b * b; }
                    u32x4 w; w.x = cvt_pk_bf16(v0[0], v0[1]); w.y = cvt_pk_bf16(v0[2], v0[3]); w.z = cvt_pk_bf16(v1[0], v1[1]); w.w = cvt_pk_bf16(v1[2], v1[3]);
                    *(u32x4*)(rowp + bj * HALF) = w; } }
    }
};
struct EpiSq {
    typedef f32x4 acc_t;
    static constexpr bool PERM = true, AFTER_DRAIN = false, MID = false; static constexpr int MID_T0 = -1, MID_T1 = -1, NST = 24;
    bf16_t* O; int ldc; float* part;
    __device__ __forceinline__ void operator()(const f32x4 (&acc)[2][2][4][2], const Unit& u, int wr, int wc, int fr, int fq) const {
        const int row0 = u.pm * BM + wr * 64 + fr, col0 = u.pn * BM + wc * 32 + 8 * fq;
#pragma unroll
        for (int ai = 0; ai < 2; ++ai)
#pragma unroll
            for (int m = 0; m < 4; ++m) { const int row = row0 + ai * HALF + m * 16; bf16_t* rowp = O + (size_t)row * ldc + col0; float ss = 0.f;
#pragma unroll
                for (int bj = 0; bj < 2; ++bj) { const f32x4 v0 = acc[ai][bj][m][0], v1 = acc[ai][bj][m][1];
                    ss += (v0[0] * v0[0] + v0[1] * v0[1]) + (v0[2] * v0[2] + v0[3] * v0[3]) + (v1[0] * v1[0] + v1[1] * v1[1]) + (v1[2] * v1[2] + v1[3] * v1[3]);
                    u32x4 w; w.x = cvt_pk_bf16(v0[0], v0[1]); w.y = cvt_pk_bf16(v0[2], v0[3]); w.z = cvt_pk_bf16(v1[0], v1[1]); w.w = cvt_pk_bf16(v1[2], v1[3]);
                    *(u32x4*)(rowp + bj * HALF) = w; }
                ss += __shfl_xor(ss, 16); ss += __shfl_xor(ss, 32);
                if (fq == 0) part[(size_t)row * 32 + u.pn * 4 + wc] = ss; }
    }
};
struct EpiWiden {
    typedef f32x4 acc_t;
    static constexpr bool PERM = true, AFTER_DRAIN = false, MID = true; static constexpr int MID_T0 = 16, MID_T1 = 32, NST = 16;
    bf16_t* O; int ldc; const unsigned char* G; int ldg;
    static __device__ __forceinline__ float ub(unsigned w, int k) { return (float)((w >> (8 * k)) & 255u); }
    __device__ __forceinline__ void mid(f32x4 (&acc)[2][2][4][2], const Unit& u, int t, int wr, int wc, int fr, int fq) const {
        const int row0 = u.pm * BM + wr * 64 + fr, col0 = u.pn * BM + wc * 32 + 8 * fq;
        const unsigned char* gp = G + (t == MID_T0 ? 0 : 2048) + col0 + (size_t)row0 * ldg;
#pragma unroll
        for (int ai = 0; ai < 2; ++ai) { u32x2 ga[4][2], gb[4][2];
#pragma unroll
            for (int m = 0; m < 4; ++m)
#pragma unroll
                for (int bj = 0; bj < 2; ++bj) { const unsigned char* p = gp + (size_t)(ai * HALF + m * 16) * ldg + bj * HALF; ga[m][bj] = *(const u32x2*)p; gb[m][bj] = *(const u32x2*)(p + 2048); }
#pragma unroll
            for (int m = 0; m < 4; ++m)
#pragma unroll
                for (int bj = 0; bj < 2; ++bj)
#pragma unroll
                    for (int h = 0; h < 2; ++h)
#pragma unroll
                        for (int k = 0; k < 4; ++k) acc[ai][bj][m][h][k] *= ub(ga[m][bj][h], k) * __builtin_amdgcn_rcpf(ub(gb[m][bj][h], k));
            asm volatile("" : "+v"(acc[ai][0][0][0]), "+v"(acc[ai][0][0][1]), "+v"(acc[ai][1][0][0]), "+v"(acc[ai][1][0][1]), "+v"(acc[ai][0][1][0]), "+v"(acc[ai][0][1][1]), "+v"(acc[ai][1][1][0]), "+v"(acc[ai][1][1][1]),
                              "+v"(acc[ai][0][2][0]), "+v"(acc[ai][0][2][1]), "+v"(acc[ai][1][2][0]), "+v"(acc[ai][1][2][1]), "+v"(acc[ai][0][3][0]), "+v"(acc[ai][0][3][1]), "+v"(acc[ai][1][3][0]), "+v"(acc[ai][1][3][1]) :: "memory"); }
    }
    __device__ __forceinline__ void operator()(const f32x4 (&acc)[2][2][4][2], const Unit& u, int wr, int wc, int fr, int fq) const {
        const int row0 = u.pm * BM + wr * 64 + fr, col0 = u.pn * BM + wc * 32 + 8 * fq;
        const unsigned char* Gc = G + 4096 + col0;
        u32x2 gc[2][4][2];
#pragma unroll
        for (int ai = 0; ai < 2; ++ai)
#pragma unroll
            for (int m = 0; m < 4; ++m)
#pragma unroll
                for (int bj = 0; bj < 2; ++bj) gc[ai][m][bj] = *(const u32x2*)(Gc + (size_t)(row0 + ai * HALF + m * 16) * ldg + bj * HALF);
#pragma unroll
        for (int ai = 0; ai < 2; ++ai)
#pragma unroll
            for (int m = 0; m < 4; ++m) { bf16_t* rowp = O + (size_t)(row0 + ai * HALF + m * 16) * ldc + col0;
#pragma unroll
                for (int bj = 0; bj < 2; ++bj) { f32x4 v0 = acc[ai][bj][m][0], v1 = acc[ai][bj][m][1];
#pragma unroll
                    for (int k = 0; k < 4; ++k) { v0[k] *= ub(gc[ai][m][bj][0], k) * (1.0f / 255.0f); v1[k] *= ub(gc[ai][m][bj][1], k) * (1.0f / 255.0f); }
                    u32x4 w; w.x = cvt_pk_bf16(v0[0], v0[1]); w.y = cvt_pk_bf16(v0[2], v0[3]); w.z = cvt_pk_bf16(v1[0], v1[1]); w.w = cvt_pk_bf16(v1[2], v1[3]);
                    *(u32x4*)(rowp + bj * HALF) = w; } }
    }
};

struct EpiProjQ {
    typedef i32x4 acc_t;
    static constexpr bool PERM = true, AFTER_DRAIN = false, MID = false; static constexpr int MID_T0 = -1, MID_T1 = -1, NST = 16;
    bf16_t* O; int ldc; float qscale; const float* rq; const float* cmax; int pn0; unsigned modew; int cgate;
    template <int MODE> __device__ __forceinline__ void body(const i32x4 (&acc)[2][2][4][2], int row0, int col0, const float (&rr)[2][4], const f32x4 (&cc)[2][2]) const {
#pragma unroll
        for (int bj = 0; bj < 2; ++bj)
#pragma unroll
            for (int ai = 0; ai < 2; ++ai)
#pragma unroll
                for (int m = 0; m < 4; ++m) { const int row = row0 + ai * HALF + m * 16;
                    f32x4 v0 = __builtin_convertvector(acc[ai][bj][m][0], f32x4) * (cc[bj][0] * rr[ai][m]), v1 = __builtin_convertvector(acc[ai][bj][m][1], f32x4) * (cc[bj][1] * rr[ai][m]);
                    if (MODE == 2) {
#pragma unroll
                        for (int j = 0; j < 4; ++j) { v0[j] *= sigm(v0[j]); v1[j] *= sigm(v1[j]); } }
                    if (MODE == 3) { u32x2 w;
#pragma unroll
                        for (int j = 0; j < 4; ++j) { v0[j] = __builtin_fmaxf(__builtin_amdgcn_rcpf(__builtin_fmaf(__builtin_amdgcn_exp2f(v0[j]), 1.0f / 255.0f, 1.0f / 255.0f)), 1.f);
                                                      v1[j] = __builtin_fmaxf(__builtin_amdgcn_rcpf(__builtin_fmaf(__builtin_amdgcn_exp2f(v1[j]), 1.0f / 255.0f, 1.0f / 255.0f)), 1.f); }
                        { const unsigned k0 = (unsigned)__builtin_rintf(v0[0]), k1 = (unsigned)__builtin_rintf(v0[1]), k2 = (unsigned)__builtin_rintf(v0[2]), k3 = (unsigned)__builtin_rintf(v0[3]);
                          w.x = k0 | (k1 << 8) | (k2 << 16) | (k3 << 24); }
                        { const unsigned k0 = (unsigned)__builtin_rintf(v1[0]), k1 = (unsigned)__builtin_rintf(v1[1]), k2 = (unsigned)__builtin_rintf(v1[2]), k3 = (unsigned)__builtin_rintf(v1[3]);
                          w.y = k0 | (k1 << 8) | (k2 << 16) | (k3 << 24); }
                        *(u32x2*)((unsigned char*)(O + (size_t)row * ldc + cgate) + (col0 + bj * HALF - cgate)) = w; }
                    else { u32x4 w; w.x = cvt_pk_bf16(v0[0], v0[1]); w.y = cvt_pk_bf16(v0[2], v0[3]); w.z = cvt_pk_bf16(v1[0], v1[1]); w.w = cvt_pk_bf16(v1[2], v1[3]);
                        *(u32x4*)(O + (size_t)row * ldc + col0 + bj * HALF) = w; } }
    }
    __device__ __forceinline__ void operator()(const i32x4 (&acc)[2][2][4][2], const Unit& u, int wr, int wc, int fr, int fq) const {
        const int pt = u.pn + pn0; const int row0 = u.pm * BM + wr * 64 + fr, col0 = pt * BM + wc * 32 + 8 * fq;
        const int mode = (int)((modew >> (2 * (pt >> 2))) & 3u);
        const float sc = (mode == 1 ? qscale : (mode == 3 ? -1.4426950408889634f : 1.f)) * (1.0f / 127.0f);
        float rr[2][4]; f32x4 cc[2][2];
#pragma unroll
        for (int ai = 0; ai < 2; ++ai)
#pragma unroll
            for (int m = 0; m < 4; ++m) rr[ai][m] = rq[row0 + ai * HALF + m * 16];
#pragma unroll
        for (int bj = 0; bj < 2; ++bj) { cc[bj][0] = *(const f32x4*)(cmax + col0 + bj * HALF) * sc; cc[bj][1] = *(const f32x4*)(cmax + col0 + bj * HALF + 4) * sc; }
        if (mode == 3) body<3>(acc, row0, col0, rr, cc); else if (mode == 2) body<2>(acc, row0, col0, rr, cc); else body<0>(acc, row0, col0, rr, cc);
    }
};
struct EpiRelu2Q {
    typedef i32x4 acc_t;
    static constexpr bool PERM = true, AFTER_DRAIN = false, MID = false; static constexpr int MID_T0 = -1, MID_T1 = -1, NST = 16;
    bf16_t* O; int ldc; const float* rq; const float* cmax;
    __device__ __forceinline__ void operator()(const i32x4 (&acc)[2][2][4][2], const Unit& u, int wr, int wc, int fr, int fq) const {
        const int row0 = u.pm * BM + wr * 64 + fr, col0 = u.pn * BM + wc * 32 + 8 * fq;
        float rr[2][4]; f32x4 cc[2][2];
#pragma unroll
        for (int ai = 0; ai < 2; ++ai)
#pragma unroll
            for (int m = 0; m < 4; ++m) rr[ai][m] = rq[row0 + ai * HALF + m * 16];
#pragma unroll
        for (int bj = 0; bj < 2; ++bj) { cc[bj][0] = *(const f32x4*)(cmax + col0 + bj * HALF) * (1.0f / 127.0f); cc[bj][1] = *(const f32x4*)(cmax + col0 + bj * HALF + 4) * (1.0f / 127.0f); }
#pragma unroll
        for (int bj = 0; bj < 2; ++bj)
#pragma unroll
            for (int ai = 0; ai < 2; ++ai)
#pragma unroll
                for (int m = 0; m < 4; ++m) { const int row = row0 + ai * HALF + m * 16;
                    f32x4 v0 = __builtin_convertvector(acc[ai][bj][m][0], f32x4) * (cc[bj][0] * rr[ai][m]), v1 = __builtin_convertvector(acc[ai][bj][m][1], f32x4) * (cc[bj][1] * rr[ai][m]);
#pragma unroll
                    for (int j = 0; j < 4; ++j) { const float a = __builtin_fmaxf(v0[j], 0.f), b = __builtin_fmaxf(v1[j], 0.f); v0[j] = a * a; v1[j] = b * b; }
                    u32x4 w; w.x = cvt_pk_bf16(v0[0], v0[1]); w.y = cvt_pk_bf16(v0[2], v0[3]); w.z = cvt_pk_bf16(v1[0], v1[1]); w.w = cvt_pk_bf16(v1[2], v1[3]);
                    *(u32x4*)(O + (size_t)row * ldc + col0 + bj * HALF) = w; }
    }
};
}
#define DUPMASK 0
#ifndef GEMM_ALIGN
#define GEMM_ALIGN true
#endif
#ifndef GEMM_SP2
#define GEMM_SP2 true
#endif
#define STAGGER_US 0
#define UP_INT8 1
constexpr int NWAVES = 8;
constexpr bool SINGLE_LAUNCH = 1;
constexpr int BATCH = 4, SEQ = 4096, DM = 2048, DEPTH = 4, MIXW = 1024, M = BATCH * SEQ, INC = 14336, DFF = 8192;
constexpr int LDP = INC;
#ifndef PROJ_ORD_LIST
#define PROJ_ORD_LIST 8, 9, 10, 11, 12, 13, 0, 1, 2, 3, 4, 5, 6, 7
#endif
#ifndef PROJ_NS
#define PROJ_NS 14336
#endif
constexpr int PROJ_ORD[14] = {PROJ_ORD_LIST};
constexpr int proj_pos(int blk) { for (int p = 0; p < 14; ++p) if (PROJ_ORD[p] == blk) return p; return -1; }
constexpr unsigned long long proj_posword() { unsigned long long w = 0; for (int b = 0; b < 14; ++b) w |= (unsigned long long)proj_pos(b) << (4 * b); return w; }
constexpr unsigned proj_modeword() { unsigned w = 0; for (int p = 0; p < 14; ++p) { const int b = PROJ_ORD[p]; const unsigned md = b >= 8 ? 3u : (b == 7 ? 2u : (b == 1 ? 1u : 0u)); w |= md << (2 * p); } return w; }
constexpr unsigned long long PROJ_POSW = proj_posword(); constexpr unsigned PROJ_MODEW = proj_modeword();
static_assert(proj_pos(8) + 1 == proj_pos(9) && proj_pos(9) + 1 == proj_pos(10) && proj_pos(10) + 1 == proj_pos(11) && proj_pos(11) + 1 == proj_pos(12) && proj_pos(12) + 1 == proj_pos(13), "the six gate blocks stay adjacent and in order");
constexpr int C_POOL = 1024 * proj_pos(0), C_QD = 1024 * proj_pos(1), C_KD = 1024 * proj_pos(2), C_VD = 1024 * proj_pos(3), C_QR = 1024 * proj_pos(4), C_KR = 1024 * proj_pos(5), C_VR = 1024 * proj_pos(6), C_GR = 1024 * proj_pos(7), C_GATE = 1024 * proj_pos(8);
constexpr unsigned long long proj_ordword() { unsigned long long w = 0; for (int p = 0; p < 14; ++p) w |= (unsigned long long)PROJ_ORD[p] << (4 * p); return w; }
constexpr unsigned long long PROJ_ORDW = proj_ordword();
__device__ __forceinline__ int proj_oldcol(int sc) { return 1024 * (int)((PROJ_ORDW >> (4 * (sc >> 10))) & 15ull) + (sc & 1023); }
__device__ __forceinline__ int proj_newcol(int n) { return 1024 * (int)((PROJ_POSW >> (4 * (n >> 10))) & 15ull) + (n & 1023); }
constexpr int LDY = 3072;
constexpr float NORM_EPS = 1e-6f;
constexpr float LOG2E = 1.4426950408889634f;
constexpr float QSCALE = 0.125f * 1.4426950408889634f;
constexpr float RET_KSCALE = 0.08838834764831845f;

constexpr size_t MiB = 1u << 20;
constexpr size_t WS_CTL = 0, CTL_ZERO_BYTES = 1 * MiB;
constexpr size_t WS_ROT = 1 * MiB;
constexpr size_t WS_STAT = 3 * MiB;
constexpr size_t WS_POOLT = 5 * MiB;
constexpr size_t WS_RS = 7 * MiB;
constexpr size_t WS_RQ = 7 * MiB + 65536;
constexpr size_t WS_XQ = (8 + 128) * MiB;
constexpr size_t WS_WIN = 8 * MiB;
constexpr size_t WS_WB = WS_WIN + 224 * MiB;
constexpr size_t WS_WO = WS_WB + 48 * MiB;
constexpr size_t WS_WUP = WS_WO + 32 * MiB;
constexpr size_t WS_WDN = WS_WUP + 128 * MiB;
constexpr size_t WS_XN = WS_WDN + 128 * MiB;
constexpr size_t WS_MRG = WS_XN + 64 * MiB;
constexpr size_t WS_MIX = WS_MRG + 64 * MiB;
constexpr size_t WS_Y = WS_MIX + 64 * MiB;
constexpr size_t WS_KV = WS_Y + 96 * MiB;
constexpr size_t WS_SST = WS_KV + 64 * MiB;
constexpr size_t WS_PROJ = WS_SST + 32 * MiB;
constexpr size_t WS_WQDN = WS_PROJ + 448 * MiB;
constexpr size_t WS_FF = WS_WQDN;
constexpr size_t WS_END = WS_FF + 256 * MiB;

constexpr int CW_BAR = 4096;
constexpr size_t CTL_CMAX_IN = 256 * 1024, CTL_CMAX_UP = 512 * 1024, CTL_CMAX_DN = 672 * 1024;

constexpr int RING_BYTES = 131072;
constexpr int LDSCTL_OFF = 135168, MISC_OFF = LDSCTL_OFF + 320;
constexpr int LDS_BYTES = 147456;

#define GAS __attribute__((address_space(1)))
#define LAS __attribute__((address_space(3)))
typedef unsigned short bf16;
typedef unsigned v4u __attribute__((ext_vector_type(4)));
typedef unsigned v2u __attribute__((ext_vector_type(2)));
typedef float f32x4 __attribute__((ext_vector_type(4)));
typedef float f32x2 __attribute__((ext_vector_type(2)));
typedef float f32x16 __attribute__((ext_vector_type(16)));
typedef short bf16x8 __attribute__((ext_vector_type(8)));
typedef short s16x4 __attribute__((ext_vector_type(4)));
typedef GAS unsigned gu32;
#define RLX_AGENT __ATOMIC_RELAXED, __HIP_MEMORY_SCOPE_AGENT
#define LDS_WAIT() asm volatile("s_waitcnt lgkmcnt(0)" ::: "memory")
#define VM_WAIT() asm volatile("s_waitcnt vmcnt(0)" ::: "memory")
#define WG_BAR() do { asm volatile("s_waitcnt vmcnt(0) lgkmcnt(0)" ::: "memory"); __builtin_amdgcn_s_barrier(); asm volatile("" ::: "memory"); } while (0)

typedef float f32x2_t_ __attribute__((ext_vector_type(2))); typedef __bf16 bf16x2_t_ __attribute__((ext_vector_type(2)));
typedef _Float16 f16x2_t_ __attribute__((ext_vector_type(2)));
__device__ __forceinline__ unsigned pkh2(float lo, float hi) { f32x2_t_ v = {lo, hi}; f16x2_t_ h = __builtin_convertvector(v, f16x2_t_); return __builtin_bit_cast(unsigned, h); }
__device__ __forceinline__ float hlo(unsigned w) { return (float)__builtin_bit_cast(f16x2_t_, w)[0]; }
__device__ __forceinline__ float hhi(unsigned w) { return (float)__builtin_bit_cast(f16x2_t_, w)[1]; }
__device__ __forceinline__ unsigned pk2(float lo, float hi) { f32x2_t_ v = {lo, hi}; bf16x2_t_ b = __builtin_convertvector(v, bf16x2_t_); return __builtin_bit_cast(unsigned, b); }
__device__ __forceinline__ float bflo(unsigned w) { return __builtin_bit_cast(float, w << 16); }
__device__ __forceinline__ float bfhi(unsigned w) { return __builtin_bit_cast(float, w & 0xffff0000u); }
__device__ __forceinline__ float wave_sum(float v) {
#pragma unroll
    for (int o = 1; o < 64; o <<= 1) v += __shfl_xor(v, o);
    return v;
}
__device__ __forceinline__ void half_swap(unsigned& a, unsigned& b) { asm volatile("s_nop 1\n\tv_permlane32_swap_b32 %0, %1\n\ts_nop 1" : "+v"(a), "+v"(b)); }
__device__ __forceinline__ float half_swap_max(float m) { unsigned a = __builtin_bit_cast(unsigned, m), b = a; half_swap(a, b); return __builtin_fmaxf(__builtin_bit_cast(float, a), __builtin_bit_cast(float, b)); }
__device__ __forceinline__ float half_swap_sum(float m) { unsigned a = __builtin_bit_cast(unsigned, m), b = a; half_swap(a, b); return __builtin_bit_cast(float, a) + __builtin_bit_cast(float, b); }
__device__ __forceinline__ int crow(int r, int hi) { return (r & 3) + 8 * (r >> 2) + 4 * hi; }
__device__ __forceinline__ int swap23(int i) { return (i & 0x13) | ((i & 4) << 1) | ((i & 8) >> 1); }
__device__ __forceinline__ unsigned offb(int row, int ch) { return 256u * (unsigned)row + 16u * (unsigned)(ch ^ (((row & 3) << 2) | ((row >> 2) & 3))); }
__device__ __forceinline__ unsigned tr_off(int lane, int c, int t) { const int h = lane >> 5, blk = (lane >> 4) & 1, q = (lane & 15) >> 2, p = lane & 3; return offb(8 * h + 4 * t + q, 4 * c + 2 * blk + (p >> 1)) + 8u * (unsigned)(p & 1); }
typedef short v4i16_t __attribute__((ext_vector_type(4)));
__device__ __forceinline__ s16x4 ldtr(LAS unsigned char* p) { return __builtin_bit_cast(s16x4, __builtin_amdgcn_ds_read_tr16_b64_v4i16((LAS v4i16_t*)p)); }
__device__ __forceinline__ bf16x8 trfrag(LAS unsigned char* tile, unsigned o0, unsigned o1) { const s16x4 a = ldtr(tile + o0), b = ldtr(tile + o1); return (bf16x8){a[0], a[1], a[2], a[3], b[0], b[1], b[2], b[3]}; }
__device__ __forceinline__ void glds16(const void* gsrc, LAS unsigned char* dst) { __builtin_amdgcn_global_load_lds((const unsigned*)gsrc, (LAS unsigned*)dst, 16, 0, 0); }
__device__ __forceinline__ void glds16_asm(const void* gsrc, LAS unsigned char* dst) { unsigned keep; const unsigned d = (unsigned)__builtin_amdgcn_readfirstlane((int)(unsigned)(size_t)dst);
    asm volatile("s_mov_b32 %0, m0\n\ts_mov_b32 m0, %2\n\ts_nop 0\n\tglobal_load_lds_dwordx4 %1, off\n\ts_mov_b32 m0, %0" : "=&s"(keep) : "v"(gsrc), "s"(d) : "memory"); }
__device__ __forceinline__ f32x16 splat16(float v) { f32x16 r;
#pragma unroll
    for (int i = 0; i < 16; ++i) r[i] = v; return r; }
#define MFMA32(a, b, c) __builtin_amdgcn_mfma_f32_32x32x16_bf16((a), (b), (c), 0, 0, 0)

__device__ __constant__ const float kLog2Gamma[8] = {-0.04580368961312479f, -0.02272007650008353f, -0.011315313227834146f, -0.005646563141142063f, -0.0028205190623786626f, -0.0014095702546713536f, -0.0007046129765893727f, -0.0003522634716290214f};
__device__ __forceinline__ int t5_bucket(int n) {
    if (n < 16) return n;
    if (n >= 113) return 31;
    int b = 16;
    b += (n >= 19); b += (n >= 21); b += (n >= 24); b += (n >= 27); b += (n >= 31); b += (n >= 35); b += (n >= 40); b += (n >= 46);
    b += (n >= 52); b += (n >= 59); b += (n >= 67); b += (n >= 77); b += (n >= 87); b += (n >= 99);
    return b;
}

struct P0Item { const float* W; int N; bf16* WT; int ldt; int koff; const float* gain; int nrow0; unsigned* cmax; int item; };
__device__ __forceinline__ void p0_load(const P0Item& p, int lane, float (&v)[32]) {
    const int nblk = p.N / 32, kb = p.item / nblk, nb = p.item % nblk, k0 = 64 * kb, n0 = 32 * nb;
    const float* wp = p.W + (size_t)(k0 + (lane >> 5)) * p.N + n0 + (lane & 31);
#pragma unroll
    for (int i = 0; i < 32; ++i) v[i] = __builtin_nontemporal_load(wp + (size_t)(2 * i) * p.N);
}
__device__ __forceinline__ void p0_stage(LAS float* scr, int lane, const float (&v)[32]) {
#pragma unroll
    for (int i = 0; i < 32; ++i) scr[(2 * i + (lane >> 5)) * 33 + (lane & 31)] = v[i];
    LDS_WAIT(); asm volatile("" ::: "memory");
}
__device__ __forceinline__ void p0_emit(const P0Item& p, LAS float* scr, int lane) {
    const int nblk = p.N / 32, kb = p.item / nblk, nb = p.item % nblk, k0 = 64 * kb, n0 = 32 * nb;
    const int c = lane & 7;
    f32x4 ga = {1.f, 1.f, 1.f, 1.f}, gb = ga; if (p.gain) { ga = *(const GAS f32x4*)(p.gain + k0 + 8 * c); gb = *(const GAS f32x4*)(p.gain + k0 + 8 * c + 4); }
#pragma unroll
    for (int j = 0; j < 4; ++j) { const int n = (lane >> 3) + 8 * j; const LAS float* s = scr + (8 * c) * 33 + n;
        const float e0 = s[0 * 33] * ga.x, e1 = s[1 * 33] * ga.y, e2 = s[2 * 33] * ga.z, e3 = s[3 * 33] * ga.w, e4 = s[4 * 33] * gb.x, e5 = s[5 * 33] * gb.y, e6 = s[6 * 33] * gb.z, e7 = s[7 * 33] * gb.w;
        v4u o; if (p.cmax) { o.x = pkh2(e0, e1); o.y = pkh2(e2, e3); o.z = pkh2(e4, e5); o.w = pkh2(e6, e7); }
        else { o.x = pk2(e0, e1); o.y = pk2(e2, e3); o.z = pk2(e4, e5); o.w = pk2(e6, e7); }
        const int nr = (p.nrow0 >= 0 ? p.nrow0 : n0) + n;
        __builtin_nontemporal_store(o, (GAS v4u*)(p.WT + (size_t)nr * p.ldt + p.koff + k0 + 8 * c));
        if (p.cmax) { float mx = __builtin_fmaxf(__builtin_fmaxf(__builtin_fmaxf(__builtin_fabsf(e0), __builtin_fabsf(e1)), __builtin_fmaxf(__builtin_fabsf(e2), __builtin_fabsf(e3))), __builtin_fmaxf(__builtin_fmaxf(__builtin_fabsf(e4), __builtin_fabsf(e5)), __builtin_fmaxf(__builtin_fabsf(e6), __builtin_fabsf(e7)))) * 1.001f;
            mx = __builtin_fmaxf(mx, __shfl_xor(mx, 1)); mx = __builtin_fmaxf(mx, __shfl_xor(mx, 2)); mx = __builtin_fmaxf(mx, __shfl_xor(mx, 4));
            if (c == 0) __hip_atomic_fetch_max(p.cmax + nr, __builtin_bit_cast(unsigned, mx), __ATOMIC_RELAXED, __HIP_MEMORY_SCOPE_AGENT); } }
    LDS_WAIT(); asm volatile("" ::: "memory");
}
__device__ __forceinline__ float wave_max(float v) {
#pragma unroll
    for (int o = 1; o < 64; o <<= 1) v = __builtin_fmaxf(v, __shfl_xor(v, o));
    return v;
}
__device__ __forceinline__ unsigned q4(f32x4 v, float q) {
    const int a = (int)__builtin_rintf(v.x * q), b = (int)__builtin_rintf(v.y * q), c = (int)__builtin_rintf(v.z * q), d = (int)__builtin_rintf(v.w * q);
    return ((unsigned)a & 255u) | (((unsigned)b & 255u) << 8) | (((unsigned)c & 255u) << 16) | ((unsigned)d << 24);
}
__device__ __forceinline__ unsigned q4c(f32x4 v, float q) {
    v = v * q; v.x = __builtin_fminf(__builtin_fmaxf(v.x, -127.f), 127.f); v.y = __builtin_fminf(__builtin_fmaxf(v.y, -127.f), 127.f); v.z = __builtin_fminf(__builtin_fmaxf(v.z, -127.f), 127.f); v.w = __builtin_fminf(__builtin_fmaxf(v.w, -127.f), 127.f);
    return q4(v, 1.0f); }
constexpr int SROW = 4096 + 16;
__device__ __forceinline__ void strip_load(const float* W, int N, int n0, int wave, int lane, float (&v)[4][32]) {
    const float* wp = W + (size_t)(256 * wave + 32 * (lane >> 5)) * N + n0 + (lane & 31);
#pragma unroll
    for (int q = 0; q < 4; ++q)
#pragma unroll
        for (int i = 0; i < 32; ++i) v[q][i] = __builtin_nontemporal_load(wp + (size_t)(64 * q + i) * N);
}
__device__ __forceinline__ void strip_stage(LAS unsigned char* lds, const float* gain, int wave, int lane, const float (&v)[4][32]) {
    const int n = lane & 31, h = lane >> 5;
#pragma unroll
    for (int q = 0; q < 4; ++q) { const int kb = 256 * wave + 64 * q + 32 * h;
#pragma unroll
        for (int j = 0; j < 4; ++j) { const f32x4 ga = *(const GAS f32x4*)(gain + kb + 8 * j), gb = *(const GAS f32x4*)(gain + kb + 8 * j + 4);
            v4u o; o.x = pkh2(v[q][8 * j] * ga.x, v[q][8 * j + 1] * ga.y); o.y = pkh2(v[q][8 * j + 2] * ga.z, v[q][8 * j + 3] * ga.w);
            o.z = pkh2(v[q][8 * j + 4] * gb.x, v[q][8 * j + 5] * gb.y); o.w = pkh2(v[q][8 * j + 6] * gb.z, v[q][8 * j + 7] * gb.w);
            *(LAS v4u*)(lds + n * SROW + 2 * (kb + 8 * j)) = o; } }
}
__device__ __forceinline__ void strip_quant(LAS unsigned char* lds, unsigned char* dst, float* cmout, int wave, int lane) {
#pragma unroll
    for (int rr = 0; rr < 4; ++rr) { const int n = 4 * wave + rr; const LAS v4u* s = (const LAS v4u*)(lds + n * SROW) + lane;
        v4u w[4]; float mx = 0.f;
#pragma unroll
        for (int j = 0; j < 4; ++j) { w[j] = s[64 * j];
            mx = __builtin_fmaxf(mx, __builtin_fmaxf(__builtin_fmaxf(__builtin_fmaxf(__builtin_fabsf(hlo(w[j].x)), __builtin_fabsf(hhi(w[j].x))), __builtin_fmaxf(__builtin_fabsf(hlo(w[j].y)), __builtin_fabsf(hhi(w[j].y)))),
                                                 __builtin_fmaxf(__builtin_fmaxf(__builtin_fabsf(hlo(w[j].z)), __builtin_fabsf(hhi(w[j].z))), __builtin_fmaxf(__builtin_fabsf(hlo(w[j].w)), __builtin_fabsf(hhi(w[j].w)))))); }
        mx = wave_max(mx); const float q = 127.0f / __builtin_fmaxf(mx, 1e-30f);
        GAS v2u* d = (GAS v2u*)(dst + (size_t)n * DM) + lane;
#pragma unroll
        for (int j = 0; j < 4; ++j) { v2u o; o.x = q4c((f32x4){hlo(w[j].x), hhi(w[j].x), hlo(w[j].y), hhi(w[j].y)}, q); o.y = q4c((f32x4){hlo(w[j].z), hhi(w[j].z), hlo(w[j].w), hhi(w[j].w)}, q); __builtin_nontemporal_store(o, d + 64 * j); }
        if (lane == 0) cmout[n] = mx; }
}
__device__ __forceinline__ float quant_row(const f32x4 (&v)[8], unsigned char* xq, int lane) {
    float mx = 0.f;
#pragma unroll
    for (int j = 0; j < 8; ++j) mx = __builtin_fmaxf(mx, __builtin_fmaxf(__builtin_fmaxf(__builtin_fabsf(v[j].x), __builtin_fabsf(v[j].y)), __builtin_fmaxf(__builtin_fabsf(v[j].z), __builtin_fabsf(v[j].w))));
    mx = __builtin_fmaxf(wave_max(mx), 1e-20f);
    const float q = 127.0f / mx;
    GAS unsigned* o4 = (GAS unsigned*)xq + lane;
#pragma unroll
    for (int j = 0; j < 8; ++j) o4[64 * j] = q4(v[j], q);
    return mx * (1.0f / 127.0f);
}
__device__ __forceinline__ void prep_row(const float* xrow, bf16* orow, unsigned char* xq, float* rs, float* rq, int lane) {
    const GAS f32x4* xr = (const GAS f32x4*)xrow + lane;
    f32x4 v[8]; float s = 0.f;
#pragma unroll
    for (int j = 0; j < 8; ++j) { v[j] = xr[64 * j]; s += (v[j].x * v[j].x + v[j].y * v[j].y) + (v[j].z * v[j].z + v[j].w * v[j].w); }
    s = wave_sum(s);
    GAS v2u* o8 = (GAS v2u*)orow + lane;
#pragma unroll
    for (int j = 0; j < 8; ++j) { v2u w; w.x = pk2(v[j].x, v[j].y); w.y = pk2(v[j].z, v[j].w); o8[64 * j] = w; }
    const float dq = quant_row(v, xq, lane);
    if (lane == 0) { const float r = 1.f / sqrtf(s * (1.f / DM) + NORM_EPS); *rs = r; *rq = r * dq; }
}
__device__ __forceinline__ void resid_row(bf16* xrow, const bf16* yrow, const float* part, const float* gpost, float* rs, float* rq, float* fout, int lane, unsigned char* xq) {
    GAS v2u* xr = (GAS v2u*)xrow + lane; const GAS v2u* yr = (const GAS v2u*)yrow + lane; const GAS f32x4* gp = (const GAS f32x4*)gpost + lane;
    float ps = (lane < 32) ? part[lane] : 0.f; ps = wave_sum(ps);
    const float rs1 = 1.f / sqrtf(ps * (1.f / DM) + NORM_EPS);
    f32x4 v[8]; float s = 0.f;
#pragma unroll
    for (int j = 0; j < 8; ++j) { const v2u x = xr[64 * j]; const v2u y = yr[64 * j]; const f32x4 g = gp[64 * j];
        v[j].x = bflo(x.x) + bflo(y.x) * rs1 * g.x; v[j].y = bfhi(x.x) + bfhi(y.x) * rs1 * g.y; v[j].z = bflo(x.y) + bflo(y.y) * rs1 * g.z; v[j].w = bfhi(x.y) + bfhi(y.y) * rs1 * g.w;
        s += (v[j].x * v[j].x + v[j].y * v[j].y) + (v[j].z * v[j].z + v[j].w * v[j].w); }
    if (fout) { GAS f32x4* xo = (GAS f32x4*)fout + lane;
#pragma unroll
        for (int j = 0; j < 8; ++j) xo[64 * j] = v[j]; }
    else { s = wave_sum(s);
#pragma unroll
        for (int j = 0; j < 8; ++j) { v2u w; w.x = pk2(v[j].x, v[j].y); w.y = pk2(v[j].z, v[j].w); xr[64 * j] = w; }
        const float dq = quant_row(v, xq, lane);
        if (lane == 0) { const float r = 1.f / sqrtf(s * (1.f / DM) + NORM_EPS); *rs = r; *rq = r * dq; } }
}
#ifndef CMAX_SAMPLE
#define CMAX_SAMPLE 1
#endif
constexpr float CMAX_SAFETY = (CMAX_SAMPLE > 1) ? 1.15f : 1.0f;
__device__ __forceinline__ void colmax_item(const float* W, int N, const float* gain, unsigned* cmax, int nrow0, LAS float* scr, int item, int lane) {
    const int nblk = N / 32, kb = item / nblk, nb = item % nblk, k0 = 64 * kb, n0 = 32 * nb;
    LAS float* gs = scr + 64 * 33; gs[lane] = gain[k0 + lane]; LDS_WAIT(); asm volatile("" ::: "memory");
    float mx = 0.f;
#pragma unroll 8
    for (int i = 0; i < 32; ++i) { const int kk = 2 * i + (lane >> 5); mx = __builtin_fmaxf(mx, __builtin_fabsf(W[(size_t)(k0 + kk) * N + n0 + (lane & 31)] * gs[kk])); }
    LDS_WAIT(); asm volatile("" ::: "memory");
    mx = __builtin_fmaxf(mx, __shfl_xor(mx, 32)) * CMAX_SAFETY;
    const int nr = (nrow0 >= 0 ? nrow0 : n0) + (lane & 31);
    if (lane < 32) __hip_atomic_fetch_max(cmax + nr, __builtin_bit_cast(unsigned, mx), __ATOMIC_RELAXED, __HIP_MEMORY_SCOPE_AGENT);
}
template <int KROW> __device__ __forceinline__ void quant_wrow(const bf16* src, float cm, unsigned char* dst, int lane) {
    const float q = 127.0f / __builtin_fmaxf(cm, 1e-30f);
    const GAS v4u* s = (const GAS v4u*)src + lane;
    GAS v2u* d = (GAS v2u*)dst + lane;
#pragma unroll
    for (int j = 0; j < KROW / 512; ++j) { const v4u w = s[64 * j]; v2u o;
        o.x = q4c((f32x4){hlo(w.x), hhi(w.x), hlo(w.y), hhi(w.y)}, q); o.y = q4c((f32x4){hlo(w.z), hhi(w.z), hlo(w.w), hhi(w.w)}, q); d[64 * j] = o; }
}
__device__ __forceinline__ void prep_rows(const float* Xin, bf16* Xo, unsigned char* XQv, float* RSv, float* RQv, int m0, int mstep, int lane) {
    f32x4 v[8], n[8]; int m = m0;
    if (m < M) { const GAS f32x4* xr = (const GAS f32x4*)(Xin + (size_t)m * DM) + lane;
#pragma unroll
        for (int j = 0; j < 8; ++j) v[j] = __builtin_nontemporal_load(xr + 64 * j); }
    while (m < M) { const int mn = m + mstep;
        if (mn < M) { const GAS f32x4* xr = (const GAS f32x4*)(Xin + (size_t)mn * DM) + lane;
#pragma unroll
            for (int j = 0; j < 8; ++j) n[j] = __builtin_nontemporal_load(xr + 64 * j); }
        float s = 0.f;
#pragma unroll
        for (int j = 0; j < 8; ++j) s += (v[j].x * v[j].x + v[j].y * v[j].y) + (v[j].z * v[j].z + v[j].w * v[j].w);
        s = wave_sum(s);
        GAS v2u* o8 = (GAS v2u*)(Xo + (size_t)m * DM) + lane;
#pragma unroll
        for (int j = 0; j < 8; ++j) { v2u w; w.x = pk2(v[j].x, v[j].y); w.y = pk2(v[j].z, v[j].w); o8[64 * j] = w; }
        const float dq = quant_row(v, XQv + (size_t)m * DM, lane);
        if (lane == 0) { const float r = 1.f / sqrtf(s * (1.f / DM) + NORM_EPS); RSv[m] = r; RQv[m] = r * dq; }
#pragma unroll
        for (int j = 0; j < 8; ++j) v[j] = n[j];
        m = mn; }
}
__device__ __forceinline__ void resid_rows(bf16* X, const bf16* Y, const float* PART, const float* gpost, float* RSv, float* RQv, float* fout, unsigned char* XQv, int m0, int mstep, int lane, int M_end = M) {
#define M M_end
    f32x4 g[8];
    { const GAS f32x4* gp = (const GAS f32x4*)gpost + lane;
#pragma unroll
      for (int j = 0; j < 8; ++j) g[j] = gp[64 * j]; }
    v2u cx[8], cy[8], nx[8], ny[8]; float cp = 0.f, np = 0.f;
    int m = m0;
    if (m < M) { const GAS v2u* xr = (const GAS v2u*)(X + (size_t)m * DM) + lane; const GAS v2u* yr = (const GAS v2u*)(Y + (size_t)m * DM) + lane; cp = (lane < 32) ? PART[(size_t)m * 32 + lane] : 0.f;
#pragma unroll
        for (int j = 0; j < 8; ++j) { cx[j] = xr[64 * j]; cy[j] = yr[64 * j]; } }
    while (m < M) {
        const int mn = m + mstep;
        if (mn < M) { const GAS v2u* xr = (const GAS v2u*)(X + (size_t)mn * DM) + lane; const GAS v2u* yr = (const GAS v2u*)(Y + (size_t)mn * DM) + lane; np = (lane < 32) ? PART[(size_t)mn * 32 + lane] : 0.f;
#pragma unroll
            for (int j = 0; j < 8; ++j) { nx[j] = xr[64 * j]; ny[j] = yr[64 * j]; } }
        const float ps = wave_sum(cp); const float rs1 = 1.f / sqrtf(ps * (1.f / DM) + NORM_EPS);
        f32x4 v[8]; float s = 0.f;
#pragma unroll
        for (int j = 0; j < 8; ++j) { const v2u x = cx[j], y = cy[j];
            v[j].x = bflo(x.x) + bflo(y.x) * rs1 * g[j].x; v[j].y = bfhi(x.x) + bfhi(y.x) * rs1 * g[j].y; v[j].z = bflo(x.y) + bflo(y.y) * rs1 * g[j].z; v[j].w = bfhi(x.y) + bfhi(y.y) * rs1 * g[j].w;
            s += (v[j].x * v[j].x + v[j].y * v[j].y) + (v[j].z * v[j].z + v[j].w * v[j].w); }
        if (fout) { GAS f32x4* xo = (GAS f32x4*)(fout + (size_t)m * DM) + lane;
#pragma unroll
            for (int j = 0; j < 8; ++j) xo[64 * j] = v[j]; }
        else { s = wave_sum(s); GAS v2u* xw = (GAS v2u*)(X + (size_t)m * DM) + lane;
#pragma unroll
            for (int j = 0; j < 8; ++j) { v2u w; w.x = pk2(v[j].x, v[j].y); w.y = pk2(v[j].z, v[j].w); xw[64 * j] = w; }
            const float dq = quant_row(v, XQv + (size_t)m * DM, lane);
            if (lane == 0) { const float r = 1.f / sqrtf(s * (1.f / DM) + NORM_EPS); RSv[m] = r; RQv[m] = r * dq; } }
#pragma unroll
        for (int j = 0; j < 8; ++j) { cx[j] = nx[j]; cy[j] = ny[j]; }
        cp = np; m = mn; }
}
#undef M
__device__ __forceinline__ void quant_wrow2(const bf16* srca, float cma, unsigned char* dsta, const bf16* srcb, float cmb, unsigned char* dstb, int lane) {
    const float qa = 127.0f / __builtin_fmaxf(cma, 1e-30f), qb = 127.0f / __builtin_fmaxf(cmb, 1e-30f);
    const GAS v4u* sa = (const GAS v4u*)srca + lane; const GAS v4u* sb = (const GAS v4u*)srcb + lane; GAS v2u* da = (GAS v2u*)dsta + lane; GAS v2u* db = (GAS v2u*)dstb + lane;
    v4u wa[4], wb[4];
#pragma unroll
    for (int j = 0; j < 4; ++j) { wa[j] = sa[64 * j]; wb[j] = sb[64 * j]; }
#pragma unroll
    for (int j = 0; j < 4; ++j) { v2u o; o.x = q4c((f32x4){hlo(wa[j].x), hhi(wa[j].x), hlo(wa[j].y), hhi(wa[j].y)}, qa); o.y = q4c((f32x4){hlo(wa[j].z), hhi(wa[j].z), hlo(wa[j].w), hhi(wa[j].w)}, qa); da[64 * j] = o; }
#pragma unroll
    for (int j = 0; j < 4; ++j) { v2u o; o.x = q4c((f32x4){hlo(wb[j].x), hhi(wb[j].x), hlo(wb[j].y), hhi(wb[j].y)}, qb); o.y = q4c((f32x4){hlo(wb[j].z), hhi(wb[j].z), hlo(wb[j].w), hhi(wb[j].w)}, qb); db[64 * j] = o; }
}
__device__ __forceinline__ void quant_ffrow(const bf16* src, const float* pmx, unsigned char* dst, float* rq, int lane) {
    float mx = __builtin_fmaxf(pmx[lane], pmx[64 + lane]); mx = __builtin_fmaxf(wave_max(mx), 1e-20f);
    const float q = 127.0f / mx;
    const GAS v4u* s = (const GAS v4u*)src + lane; GAS v2u* d = (GAS v2u*)dst + lane;
#pragma unroll
    for (int j = 0; j < DFF / 512; ++j) { const v4u w = s[64 * j]; v2u o;
        o.x = q4c((f32x4){bflo(w.x), bfhi(w.x), bflo(w.y), bfhi(w.y)}, q); o.y = q4c((f32x4){bflo(w.z), bfhi(w.z), bflo(w.w), bfhi(w.w)}, q); d[64 * j] = o; }
    if (lane == 0) *rq = mx * (1.0f / 127.0f);
}
__device__ __forceinline__ void colmax_block(const float* W, int N, const float* gain, unsigned* cmax, int nrow0, LAS float* scr, int nb, int kb0, int nkb, int lane) {
    const int n0 = 32 * nb; float mx = 0.f; LAS float* gs = scr + 64 * 33;
    for (int kb = kb0; kb < kb0 + nkb; ++kb) { const int k0 = 64 * kb;
        gs[lane] = gain[k0 + lane]; LDS_WAIT(); asm volatile("" ::: "memory");
#pragma unroll 8
        for (int i = 0; i < 32; ++i) { const int kk = 2 * i + (lane >> 5); mx = __builtin_fmaxf(mx, __builtin_fabsf(W[(size_t)(k0 + kk) * N + n0 + (lane & 31)] * gs[kk])); }
        LDS_WAIT(); asm volatile("" ::: "memory"); }
    mx = __builtin_fmaxf(mx, __shfl_xor(mx, 32)) * CMAX_SAFETY;
    const int nr = (nrow0 >= 0 ? nrow0 : n0) + (lane & 31);
    if (lane < 32) __hip_atomic_fetch_max(cmax + nr, __builtin_bit_cast(unsigned, mx), __ATOMIC_RELAXED, __HIP_MEMORY_SCOPE_AGENT);
}
__device__ __forceinline__ void quant_transpose_item(const float* W, int N, const float* gain, const float* cmax, unsigned char* WQ, int K, int nrow0, LAS float* scr, int item, int lane) {
    const int nblk = N / 32, kb = item / nblk, nb = item % nblk, k0 = 64 * kb, n0 = 32 * nb;
    LAS float* gs = scr + 64 * 33; gs[lane] = gain[k0 + lane];
#pragma unroll 8
    for (int i = 0; i < 32; ++i) { const int kk = 2 * i + (lane >> 5); scr[kk * 33 + (lane & 31)] = W[(size_t)(k0 + kk) * N + n0 + (lane & 31)]; }
    LDS_WAIT(); asm volatile("" ::: "memory");
    const int n = lane >> 1, hf = lane & 1;
    const int nr = (nrow0 >= 0 ? nrow0 : n0) + n;
    const float q = 127.0f / __builtin_fmaxf(cmax[nr], 1e-30f);
    const LAS float* s = scr + (32 * hf) * 33 + n;
    v4u o[2];
#pragma unroll
    for (int h2 = 0; h2 < 2; ++h2)
#pragma unroll
        for (int w = 0; w < 4; ++w) { const int kq = 16 * h2 + 4 * w; const LAS float* p = s + kq * 33; const LAS float* g = gs + 32 * hf + kq; o[h2][w] = q4c((f32x4){p[0] * g[0], p[33] * g[1], p[66] * g[2], p[99] * g[3]}, q); }
    GAS v4u* dst = (GAS v4u*)(WQ + (size_t)nr * K + k0 + 32 * hf);
    dst[0] = o[0]; dst[1] = o[1];
    LDS_WAIT(); asm volatile("" ::: "memory");
}

__device__ __forceinline__ void pool_unit(LAS unsigned char* lds, const bf16* proj, const bf16* poolT, const float* pscale, bf16* Y, int tb, int g, int tid, int lane, int wid, Stopwatch& sw) {
    asm volatile("" : "+v"(tid)); lane = tid & 63;
    TS_BEG(sw, 76);
    const int win = 2 << g, hi = lane >> 5, r32 = lane & 31;
    const int t0 = tb * 128;
    bf16x8 bfr[16];
    { const bf16* bp = poolT + ((size_t)g * 256 + 32 * wid + r32) * 256 + 8 * hi;
#pragma unroll
      for (int s = 0; s < 16; ++s) bfr[s] = *(const GAS bf16x8*)(bp + 16 * s); }
    { const int cc = tid & 31, tsb = tid >> 5;
      const bf16* up = proj + (size_t)t0 * LDP + C_POOL + g * 256 + cc * 8;
      const int pos0 = (t0 & (SEQ - 1)) + tsb * 8;
      float aw[8];
#pragma unroll
      for (int e = 0; e < 8; ++e) aw[e] = 0.f;
      { v4u pre[15];
#pragma unroll
        for (int j = 1; j < 16; ++j) { const v4u z0 = {0u, 0u, 0u, 0u}; pre[j - 1] = (j < win && pos0 - j >= 0) ? *(const GAS v4u*)(up + (long)(tsb * 8 - j) * LDP) : z0; }
#pragma unroll
        for (int j = 1; j < 16; ++j) { const v4u w = pre[j - 1];
          aw[0] += bflo(w.x); aw[1] += bfhi(w.x); aw[2] += bflo(w.y); aw[3] += bfhi(w.y); aw[4] += bflo(w.z); aw[5] += bfhi(w.z); aw[6] += bflo(w.w); aw[7] += bfhi(w.w); } }
      v4u ww[8], zz[8];
#pragma unroll
      for (int tt = 0; tt < 8; ++tt) ww[tt] = *(const GAS v4u*)(up + (long)(tsb * 8 + tt) * LDP);
#pragma unroll
      for (int tt = 0; tt < 8; ++tt) { const v4u z0 = {0u, 0u, 0u, 0u}; zz[tt] = (pos0 + tt - (win - 1) >= 0) ? *(const GAS v4u*)(up + (long)(tsb * 8 + tt - (win - 1)) * LDP) : z0; }
#pragma unroll
      for (int tt = 0; tt < 8; ++tt) {
          const int pos = pos0 + tt; const v4u w = ww[tt];
          float cu[8] = {bflo(w.x), bfhi(w.x), bflo(w.y), bfhi(w.y), bflo(w.z), bfhi(w.z), bflo(w.w), bfhi(w.w)};
#pragma unroll
          for (int e = 0; e < 8; ++e) aw[e] += cu[e];
          const float inv = 1.f / (float)(pos + 1 < win ? pos + 1 : win);
          v4u o; o.x = pk2(aw[0] * inv - cu[0], aw[1] * inv - cu[1]); o.y = pk2(aw[2] * inv - cu[2], aw[3] * inv - cu[3]); o.z = pk2(aw[4] * inv - cu[4], aw[5] * inv - cu[5]); o.w = pk2(aw[6] * inv - cu[6], aw[7] * inv - cu[7]);
          *(LAS v4u*)(lds + cc * 2048 + (tsb * 8 + tt) * 16) = o;
          { const v4u z = zz[tt];
              aw[0] -= bflo(z.x); aw[1] -= bfhi(z.x); aw[2] -= bflo(z.y); aw[3] -= bfhi(z.y); aw[4] -= bflo(z.z); aw[5] -= bfhi(z.z); aw[6] -= bflo(z.w); aw[7] -= bfhi(z.w); }
      } }
    WG_BAR();
    TS_END(sw, 76); TS_BEG(sw, 77);
    f32x16 acc[4];
#pragma unroll
    for (int k = 0; k < 4; ++k) acc[k] = splat16(0.f);
#pragma unroll
    for (int s = 0; s < 16; ++s)
#pragma unroll
        for (int k = 0; k < 4; ++k) { const bf16x8 a = *(const LAS bf16x8*)(lds + (2 * s + hi) * 2048 + (32 * k + r32) * 16); acc[k] = MFMA32(a, bfr[s], acc[k]); }
    TS_END(sw, 77); TS_BEG(sw, 78);
    const int oc = g * 256 + 32 * wid + r32; const float ps = pscale[oc];
#pragma unroll
    for (int k = 0; k < 4; ++k)
#pragma unroll
        for (int r = 0; r < 16; ++r) { const int tok = 32 * k + crow(r, hi); Y[(size_t)(t0 + tok) * LDY + oc] = (bf16)(pk2(acc[k][r] * ps, 0.f) & 0xffffu); }
    WG_BAR();
    TS_END(sw, 78);
}

#ifndef ATT_UNROLL2
#define ATT_UNROLL2 0
#endif
__device__ __forceinline__ void attn_unit(LAS unsigned char* lds, const bf16* proj, bf16* Y, const float* relb, const float* hgain, float lam, float oscale, int b, int h, int qb, int tid, int lane, int wid, Stopwatch& sw) {
    asm volatile("" : "+v"(tid)); lane = tid & 63;
    TS_BEG(sw, 7); TS_BEG(sw, 8);
    const int r32 = lane & 31, hi = lane >> 5, mp = wid >> 2, wq = wid & 3;
    const int q0 = qb * 128, qw = q0 + 32 * wq;
    const size_t rowbase = (size_t)b * SEQ;
    LAS float* tab = (LAS float*)(lds + 98304);
    if (tid < 129) tab[tid] = relb[t5_bucket(tid) * 8 + h] * LOG2E;
    const float bias31 = relb[31 * 8 + h] * LOG2E;
    LAS unsigned char* qlds = lds + 100352 + wid * 4096 + hi * 512 + r32 * 16;
    { const bf16* qp = proj + (rowbase + qw + r32) * LDP + C_QD + h * 128 + mp * 64 + hi * 8;
#pragma unroll
      for (int d0 = 0; d0 < 4; ++d0) *(LAS bf16x8*)(qlds + d0 * 1024) = *(const GAS bf16x8*)(qp + d0 * 16); }
    const bf16* k0src = proj + (rowbase + (lane & 32) + swap23(r32)) * LDP + C_KD + h * 128 + wid * 8;
    const bf16* k1src = k0src + 64;
    const bf16* vsrc[2];
#pragma unroll
    for (int i = 0; i < 2; ++i) { const int vrow = 8 * wid + 4 * i + (lane >> 4); const int ch = (lane & 15) ^ (((vrow & 3) << 2) | ((vrow >> 2) & 3)); vsrc[i] = proj + (rowbase + vrow) * LDP + C_VD + h * 128 + ch * 8; }
#define ATT_DMA(t, sb_) do { const size_t ko_ = (size_t)(t) * 64 * LDP; \
        glds16_asm(k0src + ko_, (sb_) + wid * 1024); glds16_asm(k1src + ko_, (sb_) + 8192 + wid * 1024); glds16_asm(vsrc[0] + ko_, (sb_) + 16384 + wid * 2048); glds16_asm(vsrc[1] + ko_, (sb_) + 16384 + wid * 2048 + 1024); } while (0)
    unsigned va[4][2];
#pragma unroll
    for (int c = 0; c < 4; ++c) { va[c][0] = 16384u + tr_off(lane, c, 0); va[c][1] = 16384u + tr_off(lane, c, 1); }
    const unsigned kboff = mp * 8192 + hi * 1024 + r32 * 16;
    const int NT = 2 * qb + 2;
    ATT_DMA(0, lds); ATT_DMA(1, lds + 32768);
    float m_run = -1e30f, l_run = 0.f;
    f32x16 o[4];
#pragma unroll
    for (int c = 0; c < 4; ++c) o[c] = splat16(0.f);
    const int qi = qw + r32;
#define ATT_QK(S0, S1, sbp, cin) do { S0 = splat16(cin); S1 = S0; \
        _Pragma("unroll") for (int d0 = 0; d0 < 4; ++d0) { const bf16x8 kf0_ = *(const LAS bf16x8*)((sbp) + kboff + d0 * 2048), kf1_ = *(const LAS bf16x8*)((sbp) + kboff + d0 * 2048 + 512), q_ = *(const LAS bf16x8*)(qlds + d0 * 1024); \
            S0 = MFMA32(kf0_, q_, S0); S1 = MFMA32(kf1_, q_, S1); } } while (0)
    WG_BAR();
    TS_END(sw, 8);
    f32x16 sA0, sA1, sB0, sB1;
    typedef __bf16 bf2_t_ __attribute__((ext_vector_type(2)));
    const bf2_t_ one2 = __builtin_bit_cast(bf2_t_, 0x3F803F80u);
    { const bool far0 = (63 + 128 <= qw); ATT_QK(sA0, sA1, lds, far0 ? bias31 : 0.f);
      if (!far0) {
#pragma unroll
          for (int r = 0; r < 16; ++r) { const int key = 16 * (r >> 3) + 8 * hi + (r & 7); const int d0_ = qi - key, d1_ = d0_ - 32;
              const float b0 = tab[d0_ < 0 ? 0 : (d0_ > 128 ? 128 : d0_)], b1 = tab[d1_ < 0 ? 0 : (d1_ > 128 ? 128 : d1_)];
              sA0[r] = d0_ < 0 ? -1e30f : sA0[r] + b0; sA1[r] = d1_ < 0 ? -1e30f : sA1[r] + b1; } }
      float mt = __builtin_fmaxf(sA0[0], sA1[0]);
#pragma unroll
      for (int r = 1; r < 16; ++r) mt = __builtin_fmaxf(mt, __builtin_fmaxf(sA0[r], sA1[r]));
      mt = half_swap_max(mt); m_run = mt;
#pragma unroll
      for (int r = 0; r < 16; ++r) { sA0[r] -= mt; sA1[r] -= mt; } }
    int sc = 0, sn = 32768, sn2 = 65536;
#define SB() __builtin_amdgcn_sched_barrier(0)
#define EX2(P, i) do { P[i] = __builtin_amdgcn_exp2f(P[i]); P[(i) + 1] = __builtin_amdgcn_exp2f(P[(i) + 1]); } while (0)
#define MX4(P, i) __builtin_fmaxf(__builtin_fmaxf(P[i], P[(i) + 1]), __builtin_fmaxf(P[(i) + 2], P[(i) + 3]))
#define PK8(P, i) ({ v4u w_; w_.x = pk2(P[i], P[(i) + 1]); w_.y = pk2(P[(i) + 2], P[(i) + 3]); w_.z = pk2(P[(i) + 4], P[(i) + 5]); w_.w = pk2(P[(i) + 6], P[(i) + 7]); __builtin_bit_cast(bf16x8, w_); })
#define VRD(dst, ks) do { _Pragma("unroll") for (int c_ = 0; c_ < 4; ++c_) dst[c_] = trfrag(sb, va[c_][0] + 4096u * (ks), va[c_][1] + 4096u * (ks)); } while (0)
#define PVM(vf_, pk_) do { _Pragma("unroll") for (int c_ = 0; c_ < 4; ++c_) o[c_] = MFMA32(vf_[c_], pk_, o[c_]); } while (0)
#define PVMX(vf_, pk_, N_, i_) do { o[0] = MFMA32(vf_[0], pk_, o[0]); EX2(N_, (i_)); SB(); o[1] = MFMA32(vf_[1], pk_, o[1]); EX2(N_, (i_) + 2); SB(); \
                                    o[2] = MFMA32(vf_[2], pk_, o[2]); EX2(N_, (i_) + 4); SB(); o[3] = MFMA32(vf_[3], pk_, o[3]); EX2(N_, (i_) + 6); SB(); } while (0)
    bf16x8 qreg[4];
#pragma unroll
    for (int d0 = 0; d0 < 4; ++d0) qreg[d0] = *(const LAS bf16x8*)(qlds + d0 * 1024);
    bf16x8 pw0, pw1, pw2, pw3;
    {
#pragma unroll
      for (int r = 0; r < 16; r += 2) { EX2(sA0, r); EX2(sA1, r); }
      float sm_ = 0.f;
#pragma unroll
      for (int r = 0; r < 16; ++r) sm_ += sA0[r] + sA1[r];
      l_run += sm_; pw0 = PK8(sA0, 0); pw1 = PK8(sA0, 8); pw2 = PK8(sA1, 0); pw3 = PK8(sA1, 8); }
#define ATT_TILE(T) do { \
        if ((T) + 2 < NT) ATT_DMA((T) + 2, lds + sn2); \
        const int k0 = 64 * (T); const bool actT = (k0 <= qw + 31), actN = ((T) + 1 < NT) && (k0 + 64 <= qw + 31); \
        LAS unsigned char* sb = lds + sc; LAS unsigned char* sbn = lds + sn; \
        const bool farn = (k0 + 64 + 63 + 128 <= qw); const float cin = (farn ? bias31 : 0.f) - m_run; \
        f32x16 N0 = splat16(cin), N1 = N0; bf16x8 vfA[4], vfB[4]; \
        if (actN) { \
            bf16x8 kf[4], qf[2]; \
            SB(); \
            _Pragma("unroll") for (int d0 = 0; d0 < 2; ++d0) { kf[2 * d0] = *(const LAS bf16x8*)(sbn + kboff + d0 * 2048); kf[2 * d0 + 1] = *(const LAS bf16x8*)(sbn + kboff + d0 * 2048 + 512); qf[d0] = qreg[d0]; } \
            SB(); \
            N0 = MFMA32(kf[0], qf[0], N0); N1 = MFMA32(kf[1], qf[0], N1); N0 = MFMA32(kf[2], qf[1], N0); N1 = MFMA32(kf[3], qf[1], N1); SB(); \
            _Pragma("unroll") for (int d0 = 0; d0 < 2; ++d0) { kf[2 * d0] = *(const LAS bf16x8*)(sbn + kboff + (d0 + 2) * 2048); kf[2 * d0 + 1] = *(const LAS bf16x8*)(sbn + kboff + (d0 + 2) * 2048 + 512); qf[d0] = qreg[d0 + 2]; } \
            SB(); \
            N0 = MFMA32(kf[0], qf[0], N0); N1 = MFMA32(kf[1], qf[0], N1); N0 = MFMA32(kf[2], qf[1], N0); N1 = MFMA32(kf[3], qf[1], N1); SB(); \
            if (!farn) { const int k1 = k0 + 64; \
                _Pragma("unroll") for (int r = 0; r < 16; ++r) { const int key = k1 + 16 * (r >> 3) + 8 * hi + (r & 7); const int d0_ = qi - key, d1_ = d0_ - 32; \
                    const float b0 = tab[d0_ < 0 ? 0 : (d0_ > 128 ? 128 : d0_)], b1 = tab[d1_ < 0 ? 0 : (d1_ > 128 ? 128 : d1_)]; \
                    N0[r] = d0_ < 0 ? -1e30f : N0[r] + b0; N1[r] = d1_ < 0 ? -1e30f : N1[r] + b1; } } \
        } \
        if (actT) {                                                               \
            SB(); VRD(vfA, 0); VRD(vfB, 1); SB(); \
            PVMX(vfA, pw0, N0, 0); VRD(vfA, 2); SB(); \
            PVMX(vfB, pw1, N0, 8); VRD(vfB, 3); SB(); \
            PVMX(vfA, pw2, N1, 0); \
            PVMX(vfB, pw3, N1, 8); \
        } \
        if (actN) {                                                               \
            float sm_ = 0.f; _Pragma("unroll") for (int r = 0; r < 16; ++r) sm_ += N0[r] + N1[r]; \
            if (__any(!(sm_ <= 8192.f))) {                                        \
                float mx = __builtin_fmaxf(__builtin_fmaxf(__builtin_fmaxf(MX4(N0, 0), MX4(N0, 4)), __builtin_fmaxf(MX4(N0, 8), MX4(N0, 12))), __builtin_fmaxf(__builtin_fmaxf(MX4(N1, 0), MX4(N1, 4)), __builtin_fmaxf(MX4(N1, 8), MX4(N1, 12)))); \
                mx = half_swap_max(mx); const float big = __builtin_fmaxf(mx, 1.f); const float dl = __builtin_amdgcn_logf(big), f = __builtin_amdgcn_rcpf(big); m_run += dl; \
                _Pragma("unroll") for (int c = 0; c < 4; ++c) _Pragma("unroll") for (int r = 0; r < 16; ++r) o[c][r] *= f; \
                l_run *= f; sm_ *= f; _Pragma("unroll") for (int r = 0; r < 16; ++r) { N0[r] *= f; N1[r] *= f; } } \
            l_run += sm_; \
            pw0 = PK8(N0, 0); pw1 = PK8(N0, 8); pw2 = PK8(N1, 0); pw3 = PK8(N1, 8); } \
        { const int tmp = sc; sc = sn; sn = sn2; sn2 = tmp; } \
        WG_BAR(); } while (0)
    for (int t = 0; t < NT; ++t) ATT_TILE(t);
#undef ATT_TILE
#undef PVMX
#undef SB
#undef EX2
#undef MX4
#undef PK8
#undef VRD
#undef PVM
#undef DSUM
#undef ATT_DMA
#undef ATT_QK
    TS_BEG(sw, 9);
    l_run = half_swap_sum(l_run);
    const float inv = 1.f / l_run;
    LAS float* xch = (LAS float*)lds;
    if (mp == 1) {
#pragma unroll
        for (int c = 0; c < 4; ++c)
#pragma unroll
            for (int r = 0; r < 16; ++r) xch[((wq * 64 + c * 16 + r) << 6) + lane] = o[c][r] * inv;
    }
    WG_BAR();
    if (mp == 0) {
        float ss = 0.f;
#pragma unroll
        for (int c = 0; c < 4; ++c)
#pragma unroll
            for (int r = 0; r < 16; ++r) { const float d = o[c][r] * inv - lam * xch[((wq * 64 + c * 16 + r) << 6) + lane]; o[c][r] = d; ss += d * d; }
        ss = half_swap_sum(ss);
        const float rs = oscale / sqrtf(ss * (1.f / 128.f) + NORM_EPS);
        bf16* yp = Y + (rowbase + qi) * LDY + 1024 + h * 128;
#pragma unroll
        for (int c = 0; c < 4; ++c)
#pragma unroll
            for (int r4 = 0; r4 < 4; ++r4) { const int dv = 32 * c + 8 * r4 + 4 * hi; const f32x4 g = *(const GAS f32x4*)(hgain + dv);
                v2u w; w.x = pk2(o[c][4 * r4] * rs * g.x, o[c][4 * r4 + 1] * rs * g.y); w.y = pk2(o[c][4 * r4 + 2] * rs * g.z, o[c][4 * r4 + 3] * rs * g.w);
                *(GAS v2u*)(yp + dv) = w; }
    }
    WG_BAR();
    TS_END(sw, 9); TS_END(sw, 7);
}

template <int MODE  > __device__ __forceinline__ void ret_stage_rot(LAS unsigned char* tile, const bf16* src  , const f32x2* rot  , float sc, float l2g, int tid) {
#pragma unroll
    for (int i = 0; i < 2; ++i) { const int item = tid + 512 * i, j = item >> 3, cc = item & 7;
        const v4u lo = *(const GAS v4u*)(src + (size_t)j * LDP + 8 * cc), hh = *(const GAS v4u*)(src + (size_t)j * LDP + 64 + 8 * cc);
        const GAS f32x4* rp = (const GAS f32x4*)(rot + (size_t)j * 64 + 8 * cc);
        const f32x4 c0 = rp[0], c1 = rp[1], c2 = rp[2], c3 = rp[3];
        const float cs[8] = {c0.x, c0.z, c1.x, c1.z, c2.x, c2.z, c3.x, c3.z}, sn[8] = {c0.y, c0.w, c1.y, c1.w, c2.y, c2.w, c3.y, c3.w};
        const float a[8] = {bflo(lo.x), bfhi(lo.x), bflo(lo.y), bfhi(lo.y), bflo(lo.z), bfhi(lo.z), bflo(lo.w), bfhi(lo.w)};
        const float bb[8] = {bflo(hh.x), bfhi(hh.x), bflo(hh.y), bfhi(hh.y), bflo(hh.z), bfhi(hh.z), bflo(hh.w), bfhi(hh.w)};
        const float s = MODE == 1 ? sc * __builtin_amdgcn_exp2f((float)(127 - j) * l2g) : sc;
        float o1[8], o2[8];
#pragma unroll
        for (int e = 0; e < 8; ++e) { o1[e] = (a[e] * cs[e] - bb[e] * sn[e]) * s; o2[e] = (bb[e] * cs[e] + a[e] * sn[e]) * s; }
        v4u w; w.x = pk2(o1[0], o1[1]); w.y = pk2(o1[2], o1[3]); w.z = pk2(o1[4], o1[5]); w.w = pk2(o1[6], o1[7]); *(LAS v4u*)(tile + offb(j, cc)) = w;
        w.x = pk2(o2[0], o2[1]); w.y = pk2(o2[2], o2[3]); w.z = pk2(o2[4], o2[5]); w.w = pk2(o2[6], o2[7]); *(LAS v4u*)(tile + offb(j, cc + 8)) = w; }
}
__device__ __forceinline__ void ret_stage_plain(LAS unsigned char* tile, const bf16* src, int ld, int tid) {
#pragma unroll
    for (int i = 0; i < 4; ++i) { const int item = tid + 512 * i, row = item >> 4, ch = item & 15; *(LAS v4u*)(tile + offb(row, ch)) = *(const GAS v4u*)(src + (size_t)row * ld + 8 * ch); }
}
__device__ __forceinline__ void retA_unit(LAS unsigned char* lds, const bf16* proj, const f32x2* rot, float* KV, int u, int tid, int lane, int wid) {
    asm volatile("" : "+v"(tid)); lane = tid & 63;
    const int bh = u >> 5, c = u & 31, b = bh >> 3, h = bh & 7, hi = lane >> 5, r32 = lane & 31;
    const size_t t0 = (size_t)b * SEQ + c * 128; const float l2g = kLog2Gamma[h];
    ret_stage_rot<1>(lds, proj + t0 * LDP + C_KR + h * 128, rot + (size_t)c * 128 * 64, RET_KSCALE, l2g, tid);
    ret_stage_plain(lds + 32768, proj + t0 * LDP + C_VR + h * 128, LDP, tid);
    WG_BAR();
    const int db = wid & 3, eb0 = 2 * (wid >> 2);
    const unsigned a0 = tr_off(lane, db, 0), a1 = tr_off(lane, db, 1);
    unsigned b0[2], b1[2];
#pragma unroll
    for (int k = 0; k < 2; ++k) { b0[k] = 32768u + tr_off(lane, eb0 + k, 0); b1[k] = 32768u + tr_off(lane, eb0 + k, 1); }
    f32x16 acc[2] = {splat16(0.f), splat16(0.f)};
#pragma unroll
    for (int ks = 0; ks < 8; ++ks) { const bf16x8 A = trfrag(lds, a0 + 4096u * ks, a1 + 4096u * ks);
#pragma unroll
        for (int k = 0; k < 2; ++k) { const bf16x8 B = trfrag(lds, b0[k] + 4096u * ks, b1[k] + 4096u * ks); acc[k] = MFMA32(A, B, acc[k]); } }
    float* kvp = KV + (size_t)u * 16384;
#pragma unroll
    for (int k = 0; k < 2; ++k)
#pragma unroll
        for (int r = 0; r < 16; ++r) kvp[(32 * db + crow(r, hi)) * 128 + 32 * (eb0 + k) + r32] = acc[k][r];
    WG_BAR();
}
__device__ __forceinline__ void retA_unit2(LAS unsigned char* lds, const bf16* proj, const f32x2* rot, float* KV, int uA, int uB, int tid, int lane, int wid) {
    asm volatile("" : "+v"(tid)); lane = tid & 63;
    const int hi = lane >> 5, r32 = lane & 31;
#pragma unroll
    for (int s = 0; s < 2; ++s) { const int u = s ? uB : uA; const int bh = u >> 5, c = u & 31, b = bh >> 3, h = bh & 7; const size_t t0 = (size_t)b * SEQ + c * 128;
        ret_stage_rot<1>(lds + s * 65536, proj + t0 * LDP + C_KR + h * 128, rot + (size_t)c * 128 * 64, RET_KSCALE, kLog2Gamma[h], tid);
        ret_stage_plain(lds + s * 65536 + 32768, proj + t0 * LDP + C_VR + h * 128, LDP, tid); }
    WG_BAR();
    const int half = wid >> 2, db = wid & 3, u = half ? uB : uA;
    LAS unsigned char* base = lds + half * 65536;
    const unsigned a0 = tr_off(lane, db, 0), a1 = tr_off(lane, db, 1);
    unsigned b0[4], b1[4];
#pragma unroll
    for (int k = 0; k < 4; ++k) { b0[k] = 32768u + tr_off(lane, k, 0); b1[k] = 32768u + tr_off(lane, k, 1); }
    f32x16 acc[4] = {splat16(0.f), splat16(0.f), splat16(0.f), splat16(0.f)};
#pragma unroll
    for (int ks = 0; ks < 8; ++ks) { const bf16x8 A = trfrag(base, a0 + 4096u * ks, a1 + 4096u * ks);
#pragma unroll
        for (int k = 0; k < 4; ++k) { const bf16x8 B = trfrag(base, b0[k] + 4096u * ks, b1[k] + 4096u * ks); acc[k] = MFMA32(A, B, acc[k]); } }
    float* kvp = KV + (size_t)u * 16384;
#pragma unroll
    for (int k = 0; k < 4; ++k)
#pragma unroll
        for (int r = 0; r < 16; ++r) kvp[(32 * db + crow(r, hi)) * 128 + 32 * k + r32] = acc[k][r];
    WG_BAR();
}
struct RetCPre { v4u q[4], k[4], v[4], s[4]; };
__device__ __forceinline__ void retC_load(RetCPre& P, const bf16* proj, const bf16* SST, int u, int tid) {
    const int bh = u >> 5, c = u & 31, b = bh >> 3, h = bh & 7; const size_t t0 = (size_t)b * SEQ + c * 128;
    const bf16* qs = proj + t0 * LDP + C_QR + h * 128; const bf16* ks = proj + t0 * LDP + C_KR + h * 128; const bf16* vs = proj + t0 * LDP + C_VR + h * 128; const bf16* ss = SST + (size_t)u * 16384;
#pragma unroll
    for (int i = 0; i < 2; ++i) { const int item = tid + 512 * i, j = item >> 3, cc = item & 7;
        P.q[2 * i] = *(const GAS v4u*)(qs + (size_t)j * LDP + 8 * cc); P.q[2 * i + 1] = *(const GAS v4u*)(qs + (size_t)j * LDP + 64 + 8 * cc);
        P.k[2 * i] = *(const GAS v4u*)(ks + (size_t)j * LDP + 8 * cc); P.k[2 * i + 1] = *(const GAS v4u*)(ks + (size_t)j * LDP + 64 + 8 * cc); }
#pragma unroll
    for (int i = 0; i < 4; ++i) { const int item = tid + 512 * i, row = item >> 4, ch = item & 15; P.v[i] = *(const GAS v4u*)(vs + (size_t)row * LDP + 8 * ch); if (c > 0) P.s[i] = *(const GAS v4u*)(ss + (size_t)row * 128 + 8 * ch); }
}
__device__ __forceinline__ void ret_rot_store1(LAS unsigned char* tile, const v4u lo, const v4u hh, const float (&cs)[8], const float (&sn)[8], int j, int cc, float s) {
    const float a[8] = {bflo(lo.x), bfhi(lo.x), bflo(lo.y), bfhi(lo.y), bflo(lo.z), bfhi(lo.z), bflo(lo.w), bfhi(lo.w)};
    const float bb[8] = {bflo(hh.x), bfhi(hh.x), bflo(hh.y), bfhi(hh.y), bflo(hh.z), bfhi(hh.z), bflo(hh.w), bfhi(hh.w)};
    float o1[8], o2[8];
#pragma unroll
    for (int e = 0; e < 8; ++e) { o1[e] = (a[e] * cs[e] - bb[e] * sn[e]) * s; o2[e] = (bb[e] * cs[e] + a[e] * sn[e]) * s; }
    v4u w; w.x = pk2(o1[0], o1[1]); w.y = pk2(o1[2], o1[3]); w.z = pk2(o1[4], o1[5]); w.w = pk2(o1[6], o1[7]); *(LAS v4u*)(tile + offb(j, cc)) = w;
    w.x = pk2(o2[0], o2[1]); w.y = pk2(o2[2], o2[3]); w.z = pk2(o2[4], o2[5]); w.w = pk2(o2[6], o2[7]); *(LAS v4u*)(tile + offb(j, cc + 8)) = w;
}
__device__ __forceinline__ void retC_unit(LAS unsigned char* lds, const bf16* proj, const f32x2* rot, const bf16* SST, bf16* Y, int u, int tid, int lane, int wid, Stopwatch& sw) {
    asm volatile("" : "+v"(tid)); lane = tid & 63;
    TS_BEG(sw, 1); TS_BEG(sw, 2);
    RetCPre P; retC_load(P, proj, SST, u, tid);
    const int bh = u >> 5, c = u & 31, b = bh >> 3, h = bh & 7, hi = lane >> 5, r32 = lane & 31;
    const size_t t0 = (size_t)b * SEQ + c * 128; const float l2g = kLog2Gamma[h];
#pragma unroll
    for (int i = 0; i < 2; ++i) { const int item = tid + 512 * i, j = item >> 3, cc = item & 7;
        const GAS f32x4* rp = (const GAS f32x4*)(rot + ((size_t)c * 128 + j) * 64 + 8 * cc); const f32x4 c0 = rp[0], c1 = rp[1], c2 = rp[2], c3 = rp[3];
        const float cs[8] = {c0.x, c0.z, c1.x, c1.z, c2.x, c2.z, c3.x, c3.z}, sn[8] = {c0.y, c0.w, c1.y, c1.w, c2.y, c2.w, c3.y, c3.w};
        ret_rot_store1(lds, P.q[2 * i], P.q[2 * i + 1], cs, sn, j, cc, 1.f); ret_rot_store1(lds + 32768, P.k[2 * i], P.k[2 * i + 1], cs, sn, j, cc, RET_KSCALE);
        asm volatile("" ::: "memory"); }
#pragma unroll
    for (int i = 0; i < 4; ++i) { const int item = tid + 512 * i, row = item >> 4, ch = item & 15; *(LAS v4u*)(lds + 65536 + offb(row, ch)) = P.v[i]; if (c > 0) *(LAS v4u*)(lds + 98304 + offb(row, ch)) = P.s[i]; }
    TS_BEG(sw, 5); WG_BAR(); TS_END(sw, 5);
    TS_END(sw, 2); TS_BEG(sw, 3);
    const int eh = wid >> 2, ib = eh ? 3 - (wid & 3) : (wid & 3), il = 32 * ib + r32;
    v2u gw_[2][4];
    { const bf16* gp_ = proj + (t0 + il) * LDP + C_GR + h * 128;
#pragma unroll
      for (int k = 0; k < 2; ++k)
#pragma unroll
          for (int r4 = 0; r4 < 4; ++r4) gw_[k][r4] = *(const GAS v2u*)(gp_ + 32 * (2 * eh + k) + 8 * r4 + 4 * hi); }
    bf16x8 qf[8];
#pragma unroll
    for (int ks = 0; ks < 8; ++ks) qf[ks] = *(const LAS bf16x8*)(lds + offb(il, 2 * ks + hi));
    unsigned v0[2], v1[2];
#pragma unroll
    for (int k = 0; k < 2; ++k) { v0[k] = tr_off(lane, 2 * eh + k, 0); v1[k] = tr_off(lane, 2 * eh + k, 1); }
    f32x16 acc[2] = {splat16(0.f), splat16(0.f)};
    if (c > 0) {
#pragma unroll
        for (int ks = 0; ks < 8; ++ks)
#pragma unroll
            for (int k = 0; k < 2; ++k) { const bf16x8 A = trfrag(lds + 98304, v0[k] + 4096u * ks, v1[k] + 4096u * ks); acc[k] = MFMA32(A, qf[ks], acc[k]); }
        const float qd = __builtin_amdgcn_exp2f((float)(il + 1) * l2g);
#pragma unroll
        for (int k = 0; k < 2; ++k)
#pragma unroll
            for (int r = 0; r < 16; ++r) acc[k][r] *= qd;
    }
    for (int jb = 0; jb <= ib; ++jb) {
        f32x16 sc = splat16(0.f);
        const int krow = 32 * jb + swap23(r32);
#pragma unroll
        for (int ks = 0; ks < 8; ++ks) { const bf16x8 A = *(const LAS bf16x8*)(lds + 32768 + offb(krow, 2 * ks + hi)); sc = MFMA32(A, qf[ks], sc); }
#pragma unroll
        for (int r = 0; r < 16; ++r) { const int j = 32 * jb + 16 * (r >> 3) + 8 * hi + (r & 7); const int dj = il - j; sc[r] = dj >= 0 ? sc[r] * __builtin_amdgcn_exp2f((float)dj * l2g) : 0.f; }
        bf16x8 pk[2];
        { v4u w; w.x = pk2(sc[0], sc[1]); w.y = pk2(sc[2], sc[3]); w.z = pk2(sc[4], sc[5]); w.w = pk2(sc[6], sc[7]); pk[0] = __builtin_bit_cast(bf16x8, w);
          w.x = pk2(sc[8], sc[9]); w.y = pk2(sc[10], sc[11]); w.z = pk2(sc[12], sc[13]); w.w = pk2(sc[14], sc[15]); pk[1] = __builtin_bit_cast(bf16x8, w); }
#pragma unroll
        for (int s = 0; s < 2; ++s)
#pragma unroll
            for (int k = 0; k < 2; ++k) { const unsigned ko = 4096u * (unsigned)(2 * jb + s); const bf16x8 A = trfrag(lds + 65536, v0[k] + ko, v1[k] + ko); acc[k] = MFMA32(A, pk[s], acc[k]); }
    }
    TS_END(sw, 3); TS_BEG(sw, 4);
    float ss = 0.f;
#pragma unroll
    for (int k = 0; k < 2; ++k)
#pragma unroll
        for (int r = 0; r < 16; ++r) ss += acc[k][r] * acc[k][r];
    ss = half_swap_sum(ss);
    LAS float* xs = (LAS float*)(lds + 131072);
    if (hi == 0) xs[eh * 128 + il] = ss;
    WG_BAR();
    const float rs = 1.f / sqrtf((xs[il] + xs[128 + il]) * (1.f / 128.f) + NORM_EPS);
    const bf16* gp = proj + (t0 + il) * LDP + C_GR + h * 128; bf16* yp = Y + (t0 + il) * LDY + 2048 + h * 128;
#pragma unroll
    for (int k = 0; k < 2; ++k)
#pragma unroll
        for (int r4 = 0; r4 < 4; ++r4) { const int e = 32 * (2 * eh + k) + 8 * r4 + 4 * hi; const v2u gw = gw_[k][r4];
            v2u w; w.x = pk2(acc[k][4 * r4] * rs * bflo(gw.x), acc[k][4 * r4 + 1] * rs * bfhi(gw.x)); w.y = pk2(acc[k][4 * r4 + 2] * rs * bflo(gw.y), acc[k][4 * r4 + 3] * rs * bfhi(gw.y));
            *(GAS v2u*)(yp + e) = w; }
    WG_BAR();
    TS_END(sw, 4); TS_END(sw, 1);
}
#define XB_TMO      128
#define XB_XCNT(j)  (256  + 64 * (j))
#define XB_XSUB(j)  (1280 + 64 * (j))
#define XB_XGEN(j)  (2304 + 64 * (j))
#define XB_TOP      3328
#define XB_TOPGEN   3392
#define XL_RANK(j)  (3456 + 64 * (j))
#define XL_CNT(j)   (4480 + 64 * (j))
#define XP_XSUB(j)  (5504 + 64 * (j))
#define XP_XGEN(j)  (6528 + 64 * (j))
#define XP_TOP(p)   (7552 + 64 * (p))
#define XP_TOPGEN(p) (8064 + 64 * (p))
#define XCD_BAR_WORDS 8576
#define XB_SPIN_CAP (1u << 18)

__device__ __forceinline__ unsigned xb_ld(unsigned* p)              { return __hip_atomic_load(p, __ATOMIC_RELAXED, __HIP_MEMORY_SCOPE_AGENT); }
__device__ __forceinline__ unsigned xb_add(unsigned* p, unsigned v) { return __hip_atomic_fetch_add(p, v, __ATOMIC_RELAXED, __HIP_MEMORY_SCOPE_AGENT); }
__device__ __forceinline__ unsigned xb_xcc_id() { return (unsigned)__builtin_amdgcn_s_getreg((3 << 11) | 20) & 0xFu; }
#define XB_SPIN(cond, bar) do { unsigned _sp = 0; while (cond) { __builtin_amdgcn_s_sleep(1); \
    if ((++_sp & 255u) == 0u) { if (xb_ld(&(bar)[XB_TMO])) break; if (_sp > XB_SPIN_CAP) { atomicAdd(&(bar)[XB_TMO], 1u); break; } } } } while (0)

struct XcdBarrier {
    unsigned* bar; unsigned x;
    volatile LAS unsigned* st;
};

__device__ __forceinline__ XcdBarrier xcd_barrier_post(unsigned* bar, volatile LAS unsigned* st) {
    XcdBarrier b; b.bar = bar; b.x = xb_xcc_id(); b.st = st;
    if (threadIdx.x == 0) (void)xb_add(&bar[XB_XCNT(b.x)], 1u);
    return b;
}
__device__ __forceinline__ void xcd_barrier_complete(unsigned* bar, unsigned x, unsigned& nloc, unsigned& nx) {
    const unsigned G = gridDim.x * gridDim.y * gridDim.z;
    unsigned sum, cnt, mine, sp = 0u;
    for (;;) {
        sum = 0u; cnt = 0u; mine = 0u;
#pragma unroll
        for (unsigned j = 0; j < 16; ++j) { const unsigned c = xb_ld(&bar[XB_XCNT(j)]); sum += c; cnt += (c > 0u) ? 1u : 0u; mine = (j == x) ? c : mine; }
        if (sum == G) break;
        __builtin_amdgcn_s_sleep(1);
        if ((++sp & 255u) == 0u) { if (xb_ld(&bar[XB_TMO])) break; if (sp > XB_SPIN_CAP) { atomicAdd(&bar[XB_TMO], 1u); break; } }
    }
    nloc = mine > 0u ? mine : 1u; nx = cnt > 0u ? cnt : 1u;
}

__device__ __forceinline__ void xcd_barrier(const XcdBarrier& b) {
    asm volatile("s_waitcnt vmcnt(0)" ::: "memory");
    __syncthreads();
    if (threadIdx.x == 0) {
        unsigned* bar = b.bar;
        __builtin_amdgcn_s_waitcnt(0);
        unsigned nloc = b.st[0], nx = b.st[1];
        if (nloc == 0u) { xcd_barrier_complete(bar, b.x, nloc, nx); b.st[0] = nloc; b.st[1] = nx; }
        const unsigned old = xb_add(&bar[XB_XSUB(b.x)], 1u);
        const unsigned gen = old / nloc;
        if (old + 1u == (gen + 1u) * nloc) {
            __builtin_amdgcn_fence(__ATOMIC_RELEASE, "agent");
            asm volatile("s_waitcnt vmcnt(0)" ::: "memory");
            const unsigned og = xb_add(&bar[XB_TOP], 1u);
            const unsigned tg = og / nx;
            if (og + 1u == (tg + 1u) * nx) xb_add(&bar[XB_TOPGEN], 1u);
            else XB_SPIN(xb_ld(&bar[XB_TOPGEN]) == tg, bar);
            __builtin_amdgcn_fence(__ATOMIC_ACQUIRE, "agent");
            xb_add(&bar[XB_XGEN(b.x)], 1u);
            asm volatile("s_waitcnt vmcnt(0)" ::: "memory");
        } else {
            XB_SPIN(xb_ld(&bar[XB_XGEN(b.x)]) == gen, bar);
            __builtin_amdgcn_fence(__ATOMIC_ACQUIRE, "agent");
            asm volatile("s_waitcnt vmcnt(0)" ::: "memory");
        }
    }
    __syncthreads();
}

__device__ __forceinline__ void xl_barrier(unsigned* bar, unsigned* xl, unsigned target) {
    asm volatile("s_waitcnt vmcnt(0)" ::: "memory");
    __syncthreads();
    if (threadIdx.x == 0) {
        __builtin_amdgcn_s_waitcnt(0);
        (void)xb_add(xl, 1u);
        XB_SPIN(xb_ld(xl) < target, bar);
        __builtin_amdgcn_fence(__ATOMIC_ACQUIRE, "agent");
        asm volatile("s_waitcnt vmcnt(0)" ::: "memory");
    }
    __syncthreads();
}

__device__ __forceinline__ void pair_barrier(unsigned* bar, unsigned x) {
    asm volatile("s_waitcnt vmcnt(0)" ::: "memory");
    __syncthreads();
    if (threadIdx.x == 0) {
        __builtin_amdgcn_s_waitcnt(0);
        const unsigned nloc = 32u, nx = 2u, p = x >> 1;
        const unsigned old = xb_add(&bar[XP_XSUB(x)], 1u);
        const unsigned gen = old / nloc;
        if (old + 1u == (gen + 1u) * nloc) {
            __builtin_amdgcn_fence(__ATOMIC_RELEASE, "agent");
            asm volatile("s_waitcnt vmcnt(0)" ::: "memory");
            const unsigned og = xb_add(&bar[XP_TOP(p)], 1u);
            const unsigned tg = og / nx;
            if (og + 1u == (tg + 1u) * nx) xb_add(&bar[XP_TOPGEN(p)], 1u);
            else XB_SPIN(xb_ld(&bar[XP_TOPGEN(p)]) == tg, bar);
            __builtin_amdgcn_fence(__ATOMIC_ACQUIRE, "agent");
            xb_add(&bar[XP_XGEN(x)], 1u);
            asm volatile("s_waitcnt vmcnt(0)" ::: "memory");
        } else {
            XB_SPIN(xb_ld(&bar[XP_XGEN(x)]) == gen, bar);
            __builtin_amdgcn_fence(__ATOMIC_ACQUIRE, "agent");
            asm volatile("s_waitcnt vmcnt(0)" ::: "memory");
        }
    }
    __syncthreads();
}
#ifndef NAIVE
#define NAIVE 0
#endif
__device__ __forceinline__ void naive_pool(LAS unsigned char* lds, const bf16* proj, const float* poolw  , const float* pscale, bf16* Y, int vcu, int G, int tid) {
    LAS float* dl = (LAS float*)lds; LAS float* part = dl + 256;
    for (int it = vcu; it < M * 4; it += G) { const int t = it >> 2, g = it & 3, win = 2 << g, pos = t & (SEQ - 1);
        if (tid < 256) { const int lo = pos + 1 - win < 0 ? 0 : pos + 1 - win; float s = 0.f;
            for (int p = lo; p <= pos; ++p) s += bflo((unsigned)proj[(size_t)(t - (pos - p)) * LDP + C_POOL + g * 256 + tid]);
            const float cur = bflo((unsigned)proj[(size_t)t * LDP + C_POOL + g * 256 + tid]);
            dl[tid] = s / (float)(pos + 1 - lo) - cur; }
        __syncthreads();
        const int o = tid & 255, hf = tid >> 8; float a = 0.f;
        for (int c = hf * 128; c < hf * 128 + 128; ++c) a += dl[c] * poolw[((size_t)g * 256 + c) * 256 + o];
        if (hf) part[o] = a;
        __syncthreads();
        if (!hf) Y[(size_t)t * LDY + g * 256 + o] = (bf16)(pk2((a + part[o]) * pscale[g * 256 + o], 0.f) & 0xffffu);
        __syncthreads(); }
}
__device__ __forceinline__ void naive_ret(LAS unsigned char* lds, const bf16* proj, bf16* Y, int vcu, int G, int tid) {
    LAS float* qs = (LAS float*)lds; LAS float* ks = qs + 128; LAS float* vs = ks + 128; LAS float* po = vs + 128; LAS float* red = po + 512;
    for (int bh = vcu; bh < 32; bh += G) { const int b = bh >> 3, h = bh & 7; const float gam = 1.0f - exp2f(-5.0f - (float)h);
        float S[32];
#pragma unroll
        for (int i = 0; i < 32; ++i) S[i] = 0.f;
        const int e = tid & 127, dg = tid >> 7;
        for (int pos = 0; pos < SEQ; ++pos) { const size_t row = (size_t)b * SEQ + pos; const bf16* pr = proj + row * LDP + h * 128;
            if (tid < 128) { const int i = tid & 63; const float invf = exp2f(-((float)i / 63.0f) * 13.287712379549449f); const float ang = (float)pos * invf;
                const double rev = (double)ang * 0.15915494309189535; const float fr = (float)(rev - __builtin_rint(rev)); const float cs = __builtin_amdgcn_cosf(fr), sn = __builtin_amdgcn_sinf(fr);
                const float q1 = bflo((unsigned)pr[C_QR + i]), q2 = bflo((unsigned)pr[C_QR + 64 + i]), k1 = bflo((unsigned)pr[C_KR + i]), k2 = bflo((unsigned)pr[C_KR + 64 + i]);
                if (tid < 64) { qs[i] = q1 * cs - q2 * sn; ks[i] = (k1 * cs - k2 * sn) * RET_KSCALE; } else { qs[64 + i] = q2 * cs + q1 * sn; ks[64 + i] = (k2 * cs + k1 * sn) * RET_KSCALE; }
                vs[tid] = bflo((unsigned)pr[C_VR + tid]); }
            __syncthreads();
            float a = 0.f; const float ve = vs[e];
#pragma unroll
            for (int i = 0; i < 32; ++i) { const int d = dg * 32 + i; S[i] = gam * S[i] + ks[d] * ve; a += qs[d] * S[i]; }
            po[dg * 128 + e] = a;
            __syncthreads();
            if (tid < 128) { const float o = po[e] + po[128 + e] + po[256 + e] + po[384 + e]; const float s2 = wave_sum(o * o); if ((tid & 63) == 0) red[tid >> 6] = s2; po[e] = o; }
            __syncthreads();
            if (tid < 128) { const float rs = 1.0f / sqrtf((red[0] + red[1]) * (1.f / 128.f) + NORM_EPS); const float gt = bflo((unsigned)pr[C_GR + e]);
                Y[row * LDY + 2048 + h * 128 + e] = (bf16)(pk2(po[e] * rs * gt, 0.f) & 0xffffu); }
            __syncthreads(); } }
}
__device__ __forceinline__ void naive_attn(const bf16* proj, bf16* Y, const float* relb, const float* hgain, float lam, float oscale, int gw, int NGW, int lane) {
    for (int it = gw; it < 32 * SEQ; it += NGW) { const int bh = it / SEQ, q = it % SEQ, b = bh >> 3, h = bh & 7; const size_t rowbase = (size_t)b * SEQ;
        const bf16* qp = proj + (rowbase + q) * LDP + C_QD + h * 128;
        const float qa = bflo((unsigned)qp[lane]), qb = bflo((unsigned)qp[64 + lane]);
        float mx0 = -1e30f, mx1 = -1e30f;
        const int nkb = q / 64 + 1;
        for (int pass = 0; pass < 2; ++pass) {
            float l0 = 0.f, l1 = 0.f, o0a = 0.f, o0b = 0.f, o1a = 0.f, o1b = 0.f;
            for (int kb = 0; kb < nkb; ++kb) { const int key = kb * 64 + lane; const bool valid = key <= q; const int kc = valid ? key : q;
                const bf16* kp = proj + (rowbase + kc) * LDP + C_KD + h * 128; float s0 = 0.f, s1 = 0.f;
#pragma unroll
                for (int d8 = 0; d8 < 8; ++d8) { const v4u w0 = *(const GAS v4u*)(kp + 8 * d8), w1 = *(const GAS v4u*)(kp + 64 + 8 * d8);
#pragma unroll
                    for (int j = 0; j < 4; ++j) { const int d = 8 * d8 + 2 * j;
                        const float q0a = __builtin_bit_cast(float, __builtin_amdgcn_readlane(__builtin_bit_cast(int, qa), d)), q0b = __builtin_bit_cast(float, __builtin_amdgcn_readlane(__builtin_bit_cast(int, qa), d + 1));
                        const float q1a = __builtin_bit_cast(float, __builtin_amdgcn_readlane(__builtin_bit_cast(int, qb), d)), q1b = __builtin_bit_cast(float, __builtin_amdgcn_readlane(__builtin_bit_cast(int, qb), d + 1));
                        s0 += q0a * bflo(w0[j]) + q0b * bfhi(w0[j]); s1 += q1a * bflo(w1[j]) + q1b * bfhi(w1[j]); } }
                const float bs = relb[t5_bucket(q - kc) * 8 + h] * LOG2E; s0 += bs; s1 += bs;
                if (pass == 0) { if (valid) { mx0 = fmaxf(mx0, s0); mx1 = fmaxf(mx1, s1); } }
                else { const float p0 = valid ? exp2f(s0 - mx0) : 0.f, p1 = valid ? exp2f(s1 - mx1) : 0.f; l0 += p0; l1 += p1;
                    for (int kk = 0; kk < 64; ++kk) { const int k2 = kb * 64 + kk; if (k2 > q) break; const float a0 = __shfl(p0, kk), a1 = __shfl(p1, kk);
                        const bf16* vp = proj + (rowbase + k2) * LDP + C_VD + h * 128; const float va = bflo((unsigned)vp[lane]), vb = bflo((unsigned)vp[64 + lane]);
                        o0a += a0 * va; o0b += a0 * vb; o1a += a1 * va; o1b += a1 * vb; } } }
            if (pass == 0) {
#pragma unroll
                for (int o = 1; o < 64; o <<= 1) { mx0 = fmaxf(mx0, __shfl_xor(mx0, o)); mx1 = fmaxf(mx1, __shfl_xor(mx1, o)); } }
            else { l0 = wave_sum(l0); l1 = wave_sum(l1);
                const float da = o0a / l0 - lam * o1a / l1, db = o0b / l0 - lam * o1b / l1; const float ss = wave_sum(da * da + db * db);
                const float rs = oscale / sqrtf(ss * (1.f / 128.f) + NORM_EPS); bf16* yp = Y + (rowbase + q) * LDY + 1024 + h * 128;
                yp[lane] = (bf16)(pk2(da * rs * hgain[lane], 0.f) & 0xffffu); yp[64 + lane] = (bf16)(pk2(db * rs * hgain[64 + lane], 0.f) & 0xffffu); } } }
}
constexpr int NPH_LAYER = 10, NPH = 1 + DEPTH * NPH_LAYER;
struct Args { const float* in[15]; float* out; unsigned char* ws; int p_lo, p_hi; };
__global__ void __launch_bounds__(NWAVES * 64, 2) fwd(Args args) {
    extern __shared__ __attribute__((aligned(16))) unsigned char lds_raw[];
    LAS unsigned char* lds = (LAS unsigned char*)lds_raw;
#define LTID() ({ int t_ = threadIdx.x; asm volatile("" : "+v"(t_)); t_; })
    const int tid0 = threadIdx.x, wave = __builtin_amdgcn_readfirstlane(tid0 >> 6);
    const int G = gridDim.x; const int bx = blockIdx.x; const int vcu = (G % 8 == 0) ? (bx % 8) * (G / 8) + bx / 8 : bx;
    unsigned char* ws = args.ws;
    gu32* ctl = (gu32*)(ws + WS_CTL);
    for (int u = tid0; u < (LDS_BYTES - LDSCTL_OFF) / 4; u += NWAVES * 64) ((LAS unsigned*)(lds + LDSCTL_OFF))[u] = 0u;
    __syncthreads();
    volatile LAS unsigned* MISC = (volatile LAS unsigned*)(lds + MISC_OFF);
    XcdBarrier bar; bar.bar = (unsigned*)(ctl + CW_BAR); bar.x = 0; bar.st = nullptr;
    if (SINGLE_LAUNCH) bar = xcd_barrier_post((unsigned*)(ctl + CW_BAR), MISC + 8);
#ifndef LOCAL_SEAMS
#define LOCAL_SEAMS 1
#endif
    if (SINGLE_LAUNCH && LOCAL_SEAMS && tid0 == 0) MISC[10] = xb_add((unsigned*)(ctl + CW_BAR) + XL_RANK(bar.x), 1u);
    int cix = bx, lvcu = vcu; bool local_ok = false; unsigned xl_target = 0u;
    const int lo = args.p_lo, hi_ph = args.p_hi;
#define IN(k) (lo <= (k) && (k) < hi_ph)
#ifndef PHMASK
#define PHMASK 0xffff
#endif
#define PHM(i) (((PHMASK) >> (i)) & 1)
#ifndef UMASK
#define UMASK 7
#endif
#define UEN(i) (((UMASK) >> (i)) & 1)
#ifndef DUPMASK
#define DUPMASK 0
#endif
#define REPS(i) ((((DUPMASK) >> (i)) & 1) ? 2 : 1)
#define SEAM(k) do { if (SINGLE_LAUNCH && IN(k) && IN((k) + 1)) { const int j_ = ((k) - 1 + NPH_LAYER) % NPH_LAYER; \
        if (local_ok && (k) >= 1 && (j_ >= 4 || j_ == 1 || j_ == 2)) { xl_target += 32u; xl_barrier(bar.bar, bar.bar + XL_CNT(bar.x), xl_target); }        \
        else if (local_ok && (k) >= 1) pair_barrier(bar.bar, bar.x);        \
        else xcd_barrier(bar); } } while (0)
#ifndef DOWN_INT8
#define DOWN_INT8 0
#endif
#ifndef UP_INT8
#define UP_INT8 1
#endif
#ifndef STAGGER_US
#define STAGGER_US 0
#endif
#define STAGGER() do { if (STAGGER_US > 0) { const unsigned long long t0_ = __builtin_amdgcn_s_memrealtime(); const unsigned long long dt_ = (unsigned long long)(STAGGER_US * 100) * (unsigned)((bx >> 3) & 3); \
        while (__builtin_amdgcn_s_memrealtime() - t0_ < dt_) __builtin_amdgcn_s_sleep(8); } } while (0)
#ifndef FUSE_THIN
#define FUSE_THIN 0
#endif
    const bool fuse_thin = FUSE_THIN && SINGLE_LAUNCH && (G == 256);
    constexpr int CW_PANEL = 16384;
#define PANEL_TAIL(S_, TI, GPOST, FOUT) do { \
        pg8::Unit u0_; (void)(S_).next(0, u0_); \
        gu32* cnt_ = ctl + CW_PANEL + ((TI) * 64 + u0_.pm) * 64; \
        if (tid0 == 0) { __builtin_amdgcn_fence(__ATOMIC_RELEASE, "agent"); asm volatile("s_waitcnt vmcnt(0)" ::: "memory"); (void)__hip_atomic_fetch_add(cnt_, 1u, RLX_AGENT); \
            unsigned sp_ = 0; while (__hip_atomic_load(cnt_, RLX_AGENT) < 4u) { __builtin_amdgcn_s_sleep(1); if (++sp_ > (1u << 21)) break; } \
            __builtin_amdgcn_fence(__ATOMIC_ACQUIRE, "agent"); asm volatile("s_waitcnt vmcnt(0)" ::: "memory"); } \
        __syncthreads(); \
        { const int lane_ = LTID() & 63; const int r0_ = u0_.pm * 256 + (u0_.pn & 3) * 64; float* fo_ = (FOUT); \
          for (int r_ = wave; r_ < 64; r_ += NWAVES) { const size_t m_ = (size_t)(r0_ + r_); resid_row(XN + m_ * DM, MIX + m_ * DM, STAT + m_ * 32, (GPOST), RS + m_, RQ + m_, fo_ ? fo_ + m_ * DM : (float*)nullptr, lane_, XQ + m_ * DM); } } \
    } while (0)

    const float* x_in = args.in[0]; const float* rel_bias = args.in[1];
    const float* g_pre_mix = args.in[2]; const float* g_post_mix = args.in[3]; const float* g_pre_mlp = args.in[4]; const float* g_post_mlp = args.in[5];
    const float* w_in = args.in[6]; const float* pool_w = args.in[7]; const float* pool_scale = args.in[8]; const float* diff_lambda = args.in[9]; const float* diff_hn = args.in[10];
    const float* w_branch = args.in[11]; const float* w_out = args.in[12]; const float* w_up = args.in[13]; const float* w_down = args.in[14];
    float* xres = args.out;
    bf16* WIN = (bf16*)(ws + WS_WIN); bf16* WB = (bf16*)(ws + WS_WB); bf16* WO = (bf16*)(ws + WS_WO); bf16* WUP = (bf16*)(ws + WS_WUP); bf16* WDN = (bf16*)(ws + WS_WDN); bf16* POOLT = (bf16*)(ws + WS_POOLT);
    bf16* XN = (bf16*)(ws + WS_XN); bf16* MRG = (bf16*)(ws + WS_MRG); bf16* MIX = (bf16*)(ws + WS_MIX); bf16* Y = (bf16*)(ws + WS_Y); bf16* PROJ = (bf16*)(ws + WS_PROJ); bf16* FF = (bf16*)(ws + WS_FF);
    unsigned char* XQ = ws + WS_XQ; unsigned char* WQIN = ws + WS_WIN; unsigned char* WQUP = ws + WS_WIN + 160 * MiB; bf16* WTMP_IN = (bf16*)(ws + WS_PROJ); bf16* WTMP_UP = (bf16*)(ws + WS_PROJ + 224 * MiB);     bf16* WINB = (bf16*)(ws + WS_WUP);     float* CMIN = (float*)(ws + WS_CTL + CTL_CMAX_IN); float* CMUP = (float*)(ws + WS_CTL + CTL_CMAX_UP);
    bf16* WTMP_DN = (bf16*)(ws + WS_WDN);     unsigned char* WQDN = ws + WS_WQDN;     float* CMDN = (float*)(ws + WS_CTL + CTL_CMAX_DN);
    float* PMAX = (float*)(ws + WS_KV);     unsigned char* FFQ = ws + WS_PROJ + 256 * MiB;     float* RQF = (float*)(ws + WS_RQ + 65536);
    float* RS = (float*)(ws + WS_RS); float* RQ = (float*)(ws + WS_RQ); float* KV = (float*)(ws + WS_KV); bf16* SST = (bf16*)(ws + WS_SST); float* STAT = (float*)(ws + WS_STAT); f32x2* ROT = (f32x2*)(ws + WS_ROT);
    const int gw = vcu * NWAVES + wave, NGW = G * NWAVES;
    Stopwatch sw_; sw_.t0 = 0ull; sw_.acc = 0ull; sw_.on = 1;
#ifndef TSPH
#define TSPH 0
#endif
#define TS_PHASE(p) do { sw_.on = (TSPH == 0 || TSPH == (p)); } while (0)

#ifdef UBENCH
    {
        f32x16 oo[4]; f32x16 nn[2];
#pragma unroll
        for (int c = 0; c < 4; ++c) oo[c] = splat16(0.f);
        nn[0] = splat16(-1.0f + 1e-3f * (float)(threadIdx.x & 63)); nn[1] = splat16(-0.5f);
        bf16x8 fa = {1, 2, 3, 4, 5, 6, 7, 8}, fb = {8, 7, 6, 5, 4, 3, 2, 1};
        asm volatile("" : "+v"(fa), "+v"(fb));
        TS_BEG(sw_, 50);
        for (int it = 0; it < 1000; ++it) {
#pragma unroll
            for (int g = 0; g < 4; ++g)
#pragma unroll
                for (int c = 0; c < 4; ++c) {
                    if (UBENCH & 1) oo[c] = MFMA32(fa, fb, oo[c]);
                    if (UBENCH & 2) { const int i = 2 * (4 * (g & 1) + c); nn[g >> 1][i] = __builtin_amdgcn_exp2f(nn[g >> 1][i]); nn[g >> 1][i + 1] = __builtin_amdgcn_exp2f(nn[g >> 1][i + 1]); }
                    __builtin_amdgcn_sched_barrier(0); }
            asm volatile("" : "+v"(nn[0]), "+v"(nn[1])); }
        TS_END(sw_, 50);
        float chk = 0.f;
#pragma unroll
        for (int c = 0; c < 4; ++c) chk += oo[c][0] + oo[c][15];
        chk += nn[0][0] + nn[1][15];
        if (chk == 123.456f) ((volatile float*)ws)[1 << 20] = chk;
    }
#endif
    if (PHM(0) && IN(0)) for (int rep_ = 0; rep_ < REPS(0); ++rep_) {
        const int tid = LTID(), lane = tid & 63;
        TS_BEG(sw_, 75);
        LAS float* scr = (LAS float*)(lds + wave * 16384);
        constexpr int I_IN = (DM / 64) * (INC / 32), I_B = (MIXW / 64) * (DM / 32), I_O = (DM / 64) * (DM / 32), I_UP = (DM / 64) * (DFF / 32), I_DN = (DFF / 64) * (DM / 32), I_P = (256 / 64) * (256 / 32);
        constexpr int I_LAYER = I_IN + 3 * I_B + I_O + I_UP + I_DN + 4 * I_P;
        static_assert(!DOWN_INT8, "this prologue builds no int8 w_down copy");
        static_assert(C_GATE + 6144 <= PROJ_NS, "the branch gates (stored as u8 by the int8 projection epilogue) must be in the int8 part");
        { constexpr int NS_IN = PROJ_NS / 32, NS_UP = UP_INT8 ? DFF / 32 : 0, NS_LAYER = NS_IN + NS_UP, NS_ALL = DEPTH * NS_LAYER;
#define STRIP_RESOLVE(S, W_, N_, N0_, GAIN_, DST_, CM_) do { const int l = (S) / NS_LAYER; int r = (S) - l * NS_LAYER; \
            if (r < NS_IN) { W_ = w_in + (size_t)l * DM * INC; N_ = INC; N0_ = proj_oldcol(32 * r); GAIN_ = g_pre_mix + l * DM; DST_ = WQIN + ((size_t)l * PROJ_NS + 32 * r) * DM; CM_ = CMIN + l * INC + 32 * r; } \
            else { r -= NS_IN; W_ = w_up + (size_t)l * DM * DFF; N_ = DFF; N0_ = 32 * r; GAIN_ = g_pre_mlp + l * DM; DST_ = WQUP + ((size_t)l * DFF + 32 * r) * DM; CM_ = CMUP + l * DFF + 32 * r; } } while (0)
          float v_[4][32]; int s = vcu; const float* cw_ = nullptr; int cn_ = 0, c0_ = 0; const float* cg_ = nullptr; unsigned char* cd_ = nullptr; float* cc_ = nullptr;
          if (s < NS_ALL) { STRIP_RESOLVE(s, cw_, cn_, c0_, cg_, cd_, cc_); strip_load(cw_, cn_, c0_, wave, lane, v_); }
          while (s < NS_ALL) {
              strip_stage(lds, cg_, wave, lane, v_);
              __syncthreads();
              const int nx_ = s + G; unsigned char* nd_ = nullptr; float* nc_ = nullptr; const float* ng_ = nullptr;
              if (nx_ < NS_ALL) { STRIP_RESOLVE(nx_, cw_, cn_, c0_, ng_, nd_, nc_); strip_load(cw_, cn_, c0_, wave, lane, v_); }
              strip_quant(lds, cd_, cc_, wave, lane);
              __syncthreads();
              cg_ = ng_; cd_ = nd_; cc_ = nc_; s = nx_; }
#undef STRIP_RESOLVE
        }
        constexpr int NBB = (INC - PROJ_NS) / 32, NBB1 = NBB > 0 ? NBB : 1, I_INB = (DM / 64) * NBB, I_UPW = UP_INT8 ? 0 : I_UP, I_LAYERW = I_INB + 3 * I_B + I_O + I_UPW + I_DN + 4 * I_P;
#define P0_RESOLVE(IT, P) do { const int l = (IT) / I_LAYERW; int r = (IT) - l * I_LAYERW; \
            if (r < I_INB) { const int kb = r / NBB1, sc = PROJ_NS + 32 * (r - kb * NBB1), n0 = proj_oldcol(sc);             \
                P = P0Item{w_in + (size_t)l * DM * INC, INC, WINB + (size_t)l * (INC - PROJ_NS) * DM, DM, 0, g_pre_mix + l * DM, sc - PROJ_NS, (unsigned*)nullptr, kb * (INC / 32) + (n0 >> 5)}; break; } r -= I_INB; \
            if (r < 3 * I_B) { const int n = r / I_B; r -= n * I_B; P = P0Item{w_branch + ((size_t)l * 3 + n) * MIXW * DM, DM, WB + (size_t)l * DM * 3072, 3072, n * MIXW, (const float*)nullptr, -1, (unsigned*)nullptr, r}; break; } r -= 3 * I_B; \
            if (r < I_O) { P = P0Item{w_out + (size_t)l * DM * DM, DM, WO + (size_t)l * DM * DM, DM, 0, (const float*)nullptr, -1, (unsigned*)nullptr, r}; break; } r -= I_O; \
            if (r < I_UPW) { P = P0Item{w_up + (size_t)l * DM * DFF, DFF, WUP + (size_t)l * DFF * DM, DM, 0, g_pre_mlp + l * DM, -1, (unsigned*)nullptr, r}; break; } r -= I_UPW; \
            if (r < I_DN) { P = P0Item{w_down + (size_t)l * DFF * DM, DM, WDN + (size_t)l * DM * DFF, DFF, 0, (const float*)nullptr, -1, (unsigned*)nullptr, r}; break; } r -= I_DN; \
            { const int g = r / I_P; r -= g * I_P; P = P0Item{pool_w + ((size_t)l * 4 + g) * 65536, 256, POOLT + ((size_t)l * 4 + g) * 65536, 256, 0, (const float*)nullptr, -1, (unsigned*)nullptr, r}; } } while (0)
        { float v_[32]; P0Item cur_, nxt_; int it = gw;
          if (it < DEPTH * I_LAYERW) { P0_RESOLVE(it, cur_); p0_load(cur_, lane, v_); }
          while (it < DEPTH * I_LAYERW) {
              p0_stage(scr, lane, v_);
              const int nx_ = it + NGW;
              if (nx_ < DEPTH * I_LAYERW) { P0_RESOLVE(nx_, nxt_); p0_load(nxt_, lane, v_); }
              p0_emit(cur_, scr, lane);
              cur_ = nxt_; it = nx_; } }
#undef P0_RESOLVE
        for (int i = vcu * 512 + tid; i < SEQ * 64; i += G * 512) { const int pos = i >> 6, f = i & 63;
            const float invf = __builtin_amdgcn_exp2f(-(float)f * (13.287712379549449f / 63.0f));
            const float ang = (float)pos * invf; const double rev = (double)ang * 0.15915494309189535; const float fr = (float)(rev - __builtin_rint(rev));
            ROT[i] = (f32x2){__builtin_amdgcn_cosf(fr), __builtin_amdgcn_sinf(fr)}; }
        prep_rows(x_in, XN, XQ, RS, RQ, gw, NGW, lane);
        TS_END(sw_, 75);
    }
    SEAM(0);
    if (SINGLE_LAUNCH && LOCAL_SEAMS && IN(0) && IN(1)) {
        if (tid0 == 0) { unsigned ok = (G == 256) ? 1u : 0u;
            for (int j = 0; j < 16; ++j) { const unsigned cj = xb_ld((unsigned*)(ctl + CW_BAR) + XB_XCNT(j)); ok &= (cj == 0u || cj == 32u) ? 1u : 0u; }
            ok &= (bar.x < 8u && MISC[10] < 32u) ? 1u : 0u; MISC[11] = ok; }
        __syncthreads();
        local_ok = MISC[11] != 0u;
        if (local_ok) { const int rk = (int)MISC[10]; cix = rk * 8 + (int)bar.x; lvcu = (int)bar.x * 32 + rk; } }

    for (int l = 0; l < DEPTH; ++l) {
        const int pb = 1 + l * NPH_LAYER;
        const float lambda_init = 0.8f - 0.6f * __expf(-0.3f * (float)l);
#ifndef GREP1
#define GREP1 1
#endif
        for (int gr_ = 0; gr_ < GREP1; ++gr_) {
        if (PHM(1) && IN(pb + 0)) for (int rep_ = 0; rep_ < REPS(1); ++rep_) {
            TS_PHASE(1);
            if (PROJ_NS > 0) {
                pg8::Gemm g{(const bf16*)XQ, (const bf16*)(WQIN + (size_t)l * PROJ_NS * DM), M, PROJ_NS, DM / 2}; pg8::StaticOrder S; S.init(M, PROJ_NS, G, cix);
                pg8::EpiProjQ E{PROJ, LDP, QSCALE, RQ, CMIN + l * INC, 0, PROJ_MODEW, C_GATE};
                pg8::gemm_phase<pg8::EpiProjQ, pg8::StaticOrder, GEMM_ALIGN, GEMM_SP2>(lds, g, S, E, sw_); }
            if (PROJ_NS < INC) {
                pg8::Gemm g{XN, WINB + (size_t)l * (INC - PROJ_NS) * DM, M, INC - PROJ_NS, DM}; pg8::StaticOrder S; S.init(M, INC - PROJ_NS, G, cix);
                pg8::EpiProj E{PROJ, LDP, QSCALE, RS, PROJ_NS / 256, PROJ_MODEW};
                pg8::gemm_phase<pg8::EpiProj, pg8::StaticOrder, GEMM_ALIGN, GEMM_SP2>(lds, g, S, E, sw_); }
#ifdef DUPBAR
            if (rep_ + 1 < REPS(1)) xcd_barrier(bar);
#endif
        }
        SEAM(pb + 0);
        if (PHM(2) && IN(pb + 1)) for (int rep_ = 0; rep_ < REPS(2); ++rep_) {
            const int tid = LTID(), lane = tid & 63;
            TS_BEG(sw_, 70);
            if (NAIVE & 1) naive_pool(lds, PROJ, pool_w + (size_t)l * 4 * 65536, pool_scale + l * MIXW, Y, vcu, G, tid);
            else if (UEN(0)) for (int r2_ = 0; r2_ < REPS(11); ++r2_) for (int q_ = 0; q_ < 2; ++q_) { const int u = local_ok ? ((lvcu >> 6) * 128 + q_ * 64 + (lvcu & 63)) : (vcu + q_ * G); if (u >= 512) break; pool_unit(lds, PROJ, POOLT + (size_t)l * 4 * 65536, pool_scale + l * MIXW, Y, u >> 2, q_ ? 3 - (u & 3) : (u & 3), tid, lane, wave, sw_); }
            TS_END(sw_, 70);
            TS_BEG(sw_, 71);
            if (NAIVE & 4) naive_ret(lds, PROJ, Y, vcu, G, tid);
            else if (UEN(1)) for (int r2_ = 0; r2_ < REPS(12); ++r2_) { if (local_ok) { const int ub_ = ((lvcu >> 5) * 4) * 32 + (lvcu & 31);
                        retA_unit2(lds, PROJ, ROT, KV, ub_, ub_ + 32, tid, lane, wave); retA_unit2(lds, PROJ, ROT, KV, ub_ + 64, ub_ + 96, tid, lane, wave); }
                   else if ((1024 % (2 * G)) == 0) { for (int u = vcu; u < 1024; u += 2 * G) retA_unit2(lds, PROJ, ROT, KV, u, u + G, tid, lane, wave); }
                   else for (int u = vcu; u < 1024; u += G) retA_unit(lds, PROJ, ROT, KV, u, tid, lane, wave); }
            TS_END(sw_, 71);
            if (UEN(2)) { const float* lp = diff_lambda + l * 256;
              const float s1 = wave_sum(lp[lane] * lp[64 + lane]), s2 = wave_sum(lp[128 + lane] * lp[192 + lane]);
              const float lam = __expf(s1) - __expf(s2) + lambda_init;
              if (NAIVE & 2) naive_attn(PROJ, Y, rel_bias, diff_hn + l * 128, lam, 1.f - lambda_init, gw, NGW, lane);
              else for (int r2_ = 0; r2_ < REPS(13); ++r2_) for (int i = 0; i < 4 * ((256 + G - 1) / G); ++i) { const int v = (local_ok ? lvcu : vcu) + (i >> 2) * G; if (v >= 256) break;
                  const int bh = v >> 3, s = v & 7, k = i & 3; const int qb = (k == 0) ? 31 - s : (k == 1) ? 16 + s : (k == 2) ? 15 - s : s;
                  attn_unit(lds, PROJ, Y, rel_bias, diff_hn + l * 128, lam, 1.f - lambda_init, bh >> 3, bh & 7, qb, tid, lane, wave, sw_); } }
        }
        SEAM(pb + 1);
        if (!(NAIVE & 4) && PHM(3) && IN(pb + 2)) for (int rep_ = 0; rep_ < REPS(3); ++rep_) {
            const int tid = LTID();
            TS_BEG(sw_, 72);
            const int lg_ = (lvcu & 31) * 512 + tid;
            for (int gid = local_ok ? ((((lvcu >> 5) * 4 + (lg_ >> 12)) << 12) + (lg_ & 4095)) : vcu * 512 + tid; gid < 32 * 4096; gid += G * 512) { const int bh = gid >> 12, i4 = gid & 4095; const float dec = __builtin_amdgcn_exp2f(128.f * kLog2Gamma[bh & 7]);
                f32x4 S = {0.f, 0.f, 0.f, 0.f};
                const GAS f32x4* kp = (const GAS f32x4*)(KV + (size_t)bh * 32 * 16384) + i4; GAS v2u* sp = (GAS v2u*)(SST + (size_t)bh * 32 * 16384) + i4;
                f32x4 kc[8], kn[8];
#pragma unroll
                for (int i = 0; i < 8; ++i) kc[i] = kp[(size_t)i * 4096];
#pragma unroll
                for (int r = 0; r < 4; ++r) {
                    if (r < 3) {
#pragma unroll
                        for (int i = 0; i < 8; ++i) if (8 * (r + 1) + i < 31) kn[i] = kp[(size_t)(8 * (r + 1) + i) * 4096]; }
#pragma unroll
                    for (int i = 0; i < 8; ++i) if (8 * r + i < 31) { S = S * dec + kc[i]; v2u w; w.x = pk2(S.x, S.y); w.y = pk2(S.z, S.w); sp[(size_t)(8 * r + i + 1) * 4096] = w; }
#pragma unroll
                    for (int i = 0; i < 8; ++i) kc[i] = kn[i]; } }
            TS_END(sw_, 72);
        }
        SEAM(pb + 2);
        if (!(NAIVE & 4) && PHM(4) && IN(pb + 3)) for (int rep_ = 0; rep_ < REPS(4); ++rep_) { const int tid = LTID(), lane = tid & 63; if (local_ok) { const int ub_ = ((lvcu >> 5) * 4) * 32 + (lvcu & 31); for (int i_ = 0; i_ < 4; ++i_) retC_unit(lds, PROJ, ROT, SST, Y, ub_ + 32 * i_, tid, lane, wave, sw_); }
            else for (int u = vcu; u < 1024; u += G) retC_unit(lds, PROJ, ROT, SST, Y, u, tid, lane, wave, sw_); }
        SEAM(pb + 3);
        if (PHM(5) && IN(pb + 4)) for (int rep_ = 0; rep_ < REPS(5); ++rep_) {
            TS_PHASE(2); pg8::Gemm g{Y, WB + (size_t)l * DM * 3072, M, DM, 3072}; pg8::StaticOrder S; S.init(M, DM, G, cix);
            pg8::EpiWiden E{MRG, DM, (const unsigned char*)(PROJ + C_GATE), LDP * 2};
            pg8::gemm_phase<pg8::EpiWiden, pg8::StaticOrder, GEMM_ALIGN, GEMM_SP2>(lds, g, S, E, sw_);
        }
        SEAM(pb + 4);
        if (PHM(6) && IN(pb + 5)) for (int rep_ = 0; rep_ < REPS(6); ++rep_) {
            TS_PHASE(3); pg8::Gemm g{MRG, WO + (size_t)l * DM * DM, M, DM, DM}; pg8::StaticOrder S; S.init(M, DM, G, cix);
            pg8::EpiSq E{MIX, DM, STAT};
            pg8::gemm_phase<pg8::EpiSq, pg8::StaticOrder, GEMM_ALIGN, GEMM_SP2>(lds, g, S, E, sw_);
            if (fuse_thin && GREP1 == 1 && REPS(6) == 1) PANEL_TAIL(S, l * 2, g_post_mix + l * DM, (float*)nullptr);
        }
        if (gr_ + 1 < GREP1) xcd_barrier(bar);
        }
        SEAM(pb + 5);
        if (!(fuse_thin && GREP1 == 1 && REPS(6) == 1)) {
        if (PHM(7) && IN(pb + 6)) {
            const int lane = LTID() & 63;
            if (local_ok) resid_rows(XN, MIX, STAT, g_post_mix + l * DM, RS, RQ, (float*)nullptr, XQ, (lvcu >> 5) * 2048 + (lvcu & 31) * NWAVES + wave, 256, lane, (lvcu >> 5) * 2048 + 2048);
            else resid_rows(XN, MIX, STAT, g_post_mix + l * DM, RS, RQ, (float*)nullptr, XQ, gw, NGW, lane);
        }
        SEAM(pb + 6);
        }
#ifndef MLP_HALVES
#define MLP_HALVES 0
#endif
#if MLP_HALVES
        if (PHM(8) && IN(pb + 7)) {
            constexpr int MH = M / 2;
            for (int st_ = 0; st_ < 3; ++st_) {
                if (st_ >= 1) { const int h_ = st_ - 1;
                    pg8::Gemm g{FF + (size_t)h_ * MH * DFF, WDN + (size_t)l * DM * DFF, MH, DM, DFF}; pg8::StaticOrder S; S.init(MH, DM, G, cix);
                    pg8::EpiSq E{MIX + (size_t)h_ * MH * DM, DM, STAT + (size_t)h_ * MH * 32};
                    pg8::gemm_phase<pg8::EpiSq, pg8::StaticOrder, GEMM_ALIGN, GEMM_SP2>(lds, g, S, E, sw_); }
                if (st_ <= 1) { const int h_ = st_;
                    pg8::Gemm g{XN + (size_t)h_ * MH * DM, WUP + (size_t)l * DFF * DM, MH, DFF, DM}; pg8::StaticOrder S; S.init(MH, DFF, G, cix);
                    pg8::EpiRelu2 E{FF + (size_t)h_ * MH * DFF, DFF, RS + (size_t)h_ * MH};
                    pg8::gemm_phase<pg8::EpiRelu2, pg8::StaticOrder, GEMM_ALIGN, GEMM_SP2>(lds, g, S, E, sw_); }
                if (st_ < 2 && SINGLE_LAUNCH) xcd_barrier(bar);
            }
        }
        SEAM(pb + 8);
#else
#ifndef GREP2
#define GREP2 1
#endif
        for (int gr2_ = 0; gr2_ < GREP2; ++gr2_) {
        if (PHM(8) && IN(pb + 7)) for (int rep_ = 0; rep_ < REPS(8); ++rep_) {
#if UP_INT8
            TS_PHASE(4); pg8::Gemm g{(const bf16*)XQ, (const bf16*)(WQUP + (size_t)l * DFF * DM), M, DFF, DM / 2}; pg8::StaticOrder S; S.init(M, DFF, G, cix);
            pg8::EpiRelu2Q E{FF, DFF, RQ, CMUP + l * DFF};
            pg8::gemm_phase<pg8::EpiRelu2Q, pg8::StaticOrder, GEMM_ALIGN, GEMM_SP2>(lds, g, S, E, sw_);
#else
            pg8::Gemm g{XN, WUP + (size_t)l * DFF * DM, M, DFF, DM}; pg8::StaticOrder S; S.init(M, DFF, G, cix);
            pg8::EpiRelu2 E{FF, DFF, RS};
            STAGGER();
            pg8::gemm_phase<pg8::EpiRelu2, pg8::StaticOrder, GEMM_ALIGN, GEMM_SP2>(lds, g, S, E, sw_);
#endif
        }
        SEAM(pb + 7);
        if (PHM(9) && IN(pb + 8)) for (int rep_ = 0; rep_ < REPS(9); ++rep_) {
#if DOWN_INT8
            { const int lane = LTID() & 63;
              for (int m = gw; m < M; m += NGW) quant_ffrow(FF + (size_t)m * DFF, PMAX + (size_t)m * 128, FFQ + (size_t)m * DFF, RQF + m, lane); }
            if (SINGLE_LAUNCH) xcd_barrier(bar);
            pg8::Gemm g{(const bf16*)FFQ, (const bf16*)(WQDN + (size_t)l * DM * DFF), M, DM, DFF / 2}; pg8::StaticOrder S; S.init(M, DM, G, cix);
            pg8::EpiSqQ E{MIX, DM, STAT, RQF, CMDN + l * DM};
            pg8::gemm_phase<pg8::EpiSqQ, pg8::StaticOrder, GEMM_ALIGN, GEMM_SP2>(lds, g, S, E, sw_);
#else
            TS_PHASE(5); pg8::Gemm g{FF, WDN + (size_t)l * DM * DFF, M, DM, DFF}; pg8::StaticOrder S; S.init(M, DM, G, cix);
            pg8::EpiSq E{MIX, DM, STAT};
            pg8::gemm_phase<pg8::EpiSq, pg8::StaticOrder, GEMM_ALIGN, GEMM_SP2>(lds, g, S, E, sw_);
#endif
            if (fuse_thin && REPS(9) == 1) PANEL_TAIL(S, l * 2 + 1, g_post_mlp + l * DM, (l == DEPTH - 1) ? xres : (float*)nullptr);
        }
        if (gr2_ + 1 < GREP2) xcd_barrier(bar);
        }
        SEAM(pb + 8);
#endif
        if (!(fuse_thin && REPS(9) == 1)) {
        if (PHM(10) && IN(pb + 9)) {
            const int lane = LTID() & 63;
            const bool lastl = (l == DEPTH - 1);
            if (local_ok) resid_rows(XN, MIX, STAT, g_post_mlp + l * DM, RS, RQ, lastl ? xres : (float*)nullptr, XQ, (lvcu >> 5) * 2048 + (lvcu & 31) * NWAVES + wave, 256, lane, (lvcu >> 5) * 2048 + 2048);
            else resid_rows(XN, MIX, STAT, g_post_mlp + l * DM, RS, RQ, lastl ? xres : (float*)nullptr, XQ, gw, NGW, lane);
        }
        SEAM(pb + 9);
        }
    }
#ifdef TSSEL
    { const unsigned long long t0_ = __builtin_amdgcn_s_memrealtime();
#ifdef TSWAVE
      if (wave != TSWAVE) sw_.acc = 0ull;
#endif
#ifdef TSMIN
      const unsigned long long dt_ = (unsigned long long)TSMIN > sw_.acc * (unsigned long long)TSAMP ? (unsigned long long)TSMIN - sw_.acc * (unsigned long long)TSAMP : 0ull;
#else
      const unsigned long long dt_ = sw_.acc * (unsigned long long)TSAMP;
#endif
      while (__builtin_amdgcn_s_memrealtime() - t0_ < dt_) __builtin_amdgcn_s_sleep(16); }
#endif
#undef IN
#undef SEAM
}

extern "C" void kernel_launch(void* const* d_in, const int* in_sizes, int n_in, void* d_out, int out_size, void* d_ws, size_t ws_size, hipStream_t stream) {
    static int grid = 0;
    if (grid == 0) {
        if (n_in != 15 || in_sizes[0] != M * DM || out_size != M * DM || ws_size < WS_END) { fprintf(stderr, "kernel_launch: unexpected shapes / workspace (n_in %d, ws %zu, need %zu); nothing launched\n", n_in, ws_size, (size_t)WS_END); grid = -1; return; }
        int dev = 0, cus = 0, per_cu = 0;
        if (hipGetDevice(&dev) != hipSuccess || hipDeviceGetAttribute(&cus, hipDeviceAttributeMultiprocessorCount, dev) != hipSuccess) { grid = -1; return; }
        if (hipFuncSetAttribute((const void*)fwd, hipFuncAttributeMaxDynamicSharedMemorySize, LDS_BYTES) != hipSuccess) { fprintf(stderr, "kernel_launch: hipFuncSetAttribute failed\n"); grid = -1; return; }
        if (hipOccupancyMaxActiveBlocksPerMultiprocessor(&per_cu, (const void*)fwd, NWAVES * 64, LDS_BYTES) != hipSuccess || per_cu < 1) fprintf(stderr, "kernel_launch: note: occupancy query reports %d workgroups per CU\n", per_cu);
        (void)hipGetLastError();
        grid = cus;
    }
    if (grid < 0) return;
    if (hipMemsetAsync((char*)d_ws + WS_CTL, 0, CTL_ZERO_BYTES, stream) != hipSuccess) return;
    Args a{};
    for (int i = 0; i < 15; ++i) a.in[i] = (const float*)d_in[i];
    a.out = (float*)d_out; a.ws = (unsigned char*)d_ws;
    if (SINGLE_LAUNCH) {
        a.p_lo = 0; a.p_hi = NPH;
        hipLaunchKernelGGL(fwd, dim3(grid), dim3(NWAVES * 64), LDS_BYTES, stream, a);
    } else {
        for (int p = 0; p < NPH; ++p) { a.p_lo = p; a.p_hi = p + 1; hipLaunchKernelGGL(fwd, dim3(grid), dim3(NWAVES * 64), LDS_BYTES, stream, a); }
    }
    const hipError_t le = hipPeekAtLastError();
    if (le != hipSuccess) fprintf(stderr, "kernel_launch: launch failed: %s\n", hipGetErrorName(le));
}
```
